# Optimizing an MI355X kernel written in HIP

```python
import jax, jax.numpy as jnp
from jax import lax
import numpy as np

D_MODEL = 1024
BATCH = 8
SEQ = 4096
DEPTH = 2

EPS = 1e-6
ROPE_THETA = 10000.0
Q_BLOCK = 128

LRU_WIDTH = 1024
LRU_BLOCKS = 8
LRU_BLOCK_W = LRU_WIDTH // LRU_BLOCKS
CONV_WIDTH = 4
LRU_C = 8.0

MLA_HEADS = 8
MLA_NOPE = 64
MLA_ROPE = 32
MLA_QK = MLA_NOPE + MLA_ROPE
MLA_V = 64
Q_LORA = 256
KV_LORA = 128
MLA_WIDTH = MLA_HEADS * MLA_V

DIL_GROUPS = ((128, 1), (512, 4), (2048, 16))
DIL_HEADS = 8
DIL_HD = 64
DIL_QKV = len(DIL_GROUPS) * DIL_HEADS * DIL_HD
DIL_WIDTH = DIL_HEADS * DIL_HD

N_BRANCH = 3
SPLITS = (LRU_WIDTH, LRU_WIDTH, Q_LORA, KV_LORA, MLA_ROPE, MLA_WIDTH,
          DIL_QKV, DIL_QKV, DIL_QKV, DIL_WIDTH, N_BRANCH * D_MODEL)
IN_WIDTH = (2 * LRU_WIDTH + Q_LORA + KV_LORA + MLA_ROPE + MLA_WIDTH
            + 3 * DIL_QKV + DIL_WIDTH + N_BRANCH * D_MODEL)

kernel_name = 'hybrid_rglru_mla_dilated_swa'


def rms_norm(x, g):
    xf = x.astype(jnp.float32)
    y = xf * lax.rsqrt(jnp.mean(xf * xf, axis=-1, keepdims=True) + EPS)
    return (y * g.astype(jnp.float32)).astype(x.dtype)


def rotary(x, pos):
    d = x.shape[-1]
    inv = ROPE_THETA ** (-jnp.arange(0, d, 2, dtype=jnp.float32) / d)
    ang = pos.astype(jnp.float32)[..., None] * inv
    cos = jnp.cos(ang)[:, :, None, :]
    sin = jnp.sin(ang)[:, :, None, :]
    xf = x.astype(jnp.float32)
    x1, x2 = xf[..., : d // 2], xf[..., d // 2:]
    return jnp.concatenate([x1 * cos - x2 * sin, x2 * cos + x1 * sin], axis=-1).astype(x.dtype)


def rg_lru_branch(xb, conv_w, conv_b, w_gx, b_gx, w_ga, b_ga, lam):
    B, S, _ = xb.shape
    xp = jnp.pad(xb, ((0, 0), (CONV_WIDTH - 1, 0), (0, 0)))
    xc = conv_b
    for k in range(CONV_WIDTH):
        xc = xc + xp[:, k:k + S] * conv_w[k]
    xblk = xc.reshape(B, S, LRU_BLOCKS, LRU_BLOCK_W)
    gx = jax.nn.sigmoid(jnp.einsum('bsnc,ncd->bsnd', xblk, w_gx) + b_gx).reshape(B, S, LRU_WIDTH)
    ga = jax.nn.sigmoid(jnp.einsum('bsnc,ncd->bsnd', xblk, w_ga) + b_ga).reshape(B, S, LRU_WIDTH)
    log_a = -LRU_C * ga.astype(jnp.float32) * jax.nn.softplus(-lam.astype(jnp.float32))
    a = jnp.exp(log_a)
    mult = jnp.sqrt(-jnp.expm1(2.0 * log_a))
    b = mult * (gx * xc).astype(jnp.float32)

    def combine(left, right):
        a1, b1 = left
        a2, b2 = right
        return a1 * a2, a2 * b1 + b2

    _, h = lax.associative_scan(combine, (a, b), axis=1)
    return h.astype(xb.dtype)


def causal_attention(q, k, v, scale):
    B, S, H, dk = q.shape
    nb = S // Q_BLOCK
    qb = q.reshape(B, nb, Q_BLOCK, H, dk).transpose(1, 0, 3, 2, 4)
    kt = k.transpose(0, 2, 1, 3)
    vt = v.transpose(0, 2, 1, 3)
    kpos = jnp.arange(S)

    def one_block(args):
        qi, i = args
        s = jnp.einsum('bhqd,bhkd->bhqk', qi, kt).astype(jnp.float32) * scale
        qpos = i * Q_BLOCK + jnp.arange(Q_BLOCK)
        s = jnp.where(kpos[None, :] <= qpos[:, None], s, -jnp.inf)
        p = jax.nn.softmax(s, axis=-1)
        return jnp.einsum('bhqk,bhkd->bhqd', p.astype(vt.dtype), vt)

    o = lax.map(one_block, (qb, jnp.arange(nb)))
    return o.transpose(1, 0, 3, 2, 4).reshape(B, S, H, -1)


def mla_branch(cq, ckv, kr, pos, g_cq, g_ckv, w_uq, w_ukv, g_qn, g_kn):
    B, S, _ = cq.shape
    q = (rms_norm(cq, g_cq) @ w_uq).reshape(B, S, MLA_HEADS, MLA_QK)
    kv = (rms_norm(ckv, g_ckv) @ w_ukv).reshape(B, S, MLA_HEADS, MLA_NOPE + MLA_V)
    k_nope, v = kv[..., :MLA_NOPE], kv[..., MLA_NOPE:]
    k_rope = jnp.broadcast_to(kr[:, :, None, :], (B, S, MLA_HEADS, MLA_ROPE))
    k = jnp.concatenate([k_nope, k_rope], axis=-1)
    q = rms_norm(q, g_qn)
    k = rms_norm(k, g_kn)
    q = jnp.concatenate([q[..., :MLA_NOPE], rotary(q[..., MLA_NOPE:], pos)], axis=-1)
    k = jnp.concatenate([k[..., :MLA_NOPE], rotary(k[..., MLA_NOPE:], pos)], axis=-1)
    o = causal_attention(q, k, v, MLA_QK ** -0.5)
    return o.reshape(B, S, MLA_WIDTH)


def dilated_group(q, k, v, window, dilation):
    B, S, H, d = q.shape
    nk = window // dilation
    span = dilation * nk
    s_pad = -(-S // span) * span
    M = s_pad // dilation
    nb = M // nk

    def to_strided(t):
        t = jnp.pad(t, ((0, 0), (0, s_pad - S), (0, 0), (0, 0))).reshape(B, M, dilation, H, d)
        return t.transpose(0, 2, 3, 1, 4).reshape(B, dilation, H, nb, nk, d)

    qb, kb, vb = to_strided(q), to_strided(k), to_strided(v)

    def prev(t):
        return jnp.pad(t, ((0, 0), (0, 0), (0, 0), (1, 0), (0, 0), (0, 0)))[:, :, :, :-1]

    kw = jnp.concatenate([prev(kb), kb], axis=4)
    vw = jnp.concatenate([prev(vb), vb], axis=4)
    s = jnp.einsum('brhnqd,brhnkd->brhnqk', qb, kw).astype(jnp.float32) * (DIL_HD ** -0.5)
    qi = jnp.arange(nk)[:, None]
    ki = jnp.arange(2 * nk)[None, :]
    band = (ki >= qi) & (ki <= qi + nk)
    not_first = jnp.arange(nb)[:, None, None] > 0
    mask = band[None] & (not_first | (ki >= nk)[None])
    s = jnp.where(mask, s, -jnp.inf)
    m = jnp.max(s, axis=-1, keepdims=True)
    e = jnp.exp(s - m)
    den = jnp.sum(e, axis=-1, keepdims=True)
    o = jnp.einsum('brhnqk,brhnkd->brhnqd', (e / den).astype(vw.dtype), vw)
    lse = (m + jnp.log(den))[..., 0]
    o = o.reshape(B, dilation, H, M, d).transpose(0, 3, 1, 2, 4).reshape(B, s_pad, H, d)[:, :S]
    lse = lse.reshape(B, dilation, H, M).transpose(0, 3, 1, 2).reshape(B, s_pad, H)[:, :S]
    return o, lse


def dilated_branch(q, k, v, pos, g_qn, g_kn):
    B, S, _ = q.shape
    nh = len(DIL_GROUPS) * DIL_HEADS
    q = rotary(rms_norm(q.reshape(B, S, nh, DIL_HD), g_qn), pos)
    k = rotary(rms_norm(k.reshape(B, S, nh, DIL_HD), g_kn), pos)
    v = v.reshape(B, S, nh, DIL_HD)
    outs, lses = [], []
    for gi, (window, dilation) in enumerate(DIL_GROUPS):
        sl = slice(gi * DIL_HEADS, (gi + 1) * DIL_HEADS)
        o, l = dilated_group(q[:, :, sl], k[:, :, sl], v[:, :, sl], window, dilation)
        outs.append(o)
        lses.append(l)
    wts = jax.nn.softmax(jnp.stack(lses, axis=0), axis=0)
    o = jnp.sum(wts[..., None].astype(v.dtype) * jnp.stack(outs, axis=0), axis=0)
    return o.reshape(B, S, DIL_WIDTH)


def hybrid_layer(x, pos, norm_g, w_in, conv_w, conv_b, w_gx, b_gx, w_ga, b_ga, lam, w_lru_o,
                 g_cq, g_ckv, w_uq, w_ukv, g_mqn, g_mkn, w_mla_o, g_dqn, g_dkn, w_dil_o,
                 b_merge, w_out):
    B, S, _ = x.shape
    h = rms_norm(x, norm_g)
    z = h @ w_in
    idx = np.cumsum(SPLITS)[:-1].tolist()
    (lru_x, lru_g, cq, ckv, kr, mla_g, dq, dk, dv, dil_g, merge) = jnp.split(z, idx, axis=-1)
    y_lru = rg_lru_branch(lru_x, conv_w, conv_b, w_gx, b_gx, w_ga, b_ga, lam) * jax.nn.silu(lru_g)
    y_mla = mla_branch(cq, ckv, kr, pos, g_cq, g_ckv, w_uq, w_ukv, g_mqn, g_mkn) * jax.nn.silu(mla_g)
    y_dil = dilated_branch(dq, dk, dv, pos, g_dqn, g_dkn) * jax.nn.silu(dil_g)
    gates = jax.nn.sigmoid(merge + b_merge).reshape(B, S, N_BRANCH, D_MODEL)
    merged = (gates[:, :, 0] * (y_lru @ w_lru_o)
              + gates[:, :, 1] * (y_mla @ w_mla_o)
              + gates[:, :, 2] * (y_dil @ w_dil_o))
    return x + merged @ w_out


def setup_inputs(seed: int = 0) -> dict:
    key = jax.random.key(seed)
    ks = jax.random.split(key, 24)

    def nrm(k, shape, scale):
        return jax.random.normal(k, shape, jnp.float32) * scale

    def gain(k, shape):
        return 1.0 + 0.05 * jax.random.normal(k, shape, jnp.float32)

    x = nrm(ks[0], (BATCH, SEQ, D_MODEL), 1.0)
    offsets = jax.random.randint(ks[1], (BATCH, 1), 0, 1024, dtype=jnp.int32)
    positions = offsets + jnp.arange(SEQ, dtype=jnp.int32)[None, :]
    a0 = jax.random.uniform(ks[8], (DEPTH, LRU_WIDTH), jnp.float32, 0.9, 0.999)
    return {
        'x': x,
        'positions': positions,
        'norm_g': gain(ks[2], (DEPTH, D_MODEL)),
        'w_in': nrm(ks[3], (DEPTH, D_MODEL, IN_WIDTH), D_MODEL ** -0.5),
        'conv_w': nrm(ks[4], (DEPTH, CONV_WIDTH, LRU_WIDTH), CONV_WIDTH ** -0.5),
        'conv_b': nrm(ks[5], (DEPTH, LRU_WIDTH), 0.02),
        'w_gate_x': nrm(ks[6], (DEPTH, LRU_BLOCKS, LRU_BLOCK_W, LRU_BLOCK_W), LRU_BLOCK_W ** -0.5),
        'b_gate_x': nrm(ks[7], (DEPTH, LRU_BLOCKS, LRU_BLOCK_W), 0.1),
        'w_gate_a': nrm(ks[9], (DEPTH, LRU_BLOCKS, LRU_BLOCK_W, LRU_BLOCK_W), LRU_BLOCK_W ** -0.5),
        'b_gate_a': nrm(ks[10], (DEPTH, LRU_BLOCKS, LRU_BLOCK_W), 0.1),
        'lru_lambda': jnp.log(a0) - jnp.log1p(-a0),
        'w_lru_o': nrm(ks[11], (DEPTH, LRU_WIDTH, D_MODEL), LRU_WIDTH ** -0.5),
        'cq_norm_g': gain(ks[12], (DEPTH, Q_LORA)),
        'ckv_norm_g': gain(ks[13], (DEPTH, KV_LORA)),
        'w_uq': nrm(ks[14], (DEPTH, Q_LORA, MLA_HEADS * MLA_QK), Q_LORA ** -0.5),
        'w_ukv': nrm(ks[15], (DEPTH, KV_LORA, MLA_HEADS * (MLA_NOPE + MLA_V)), KV_LORA ** -0.5),
        'mla_q_norm_g': gain(ks[16], (DEPTH, MLA_QK)),
        'mla_k_norm_g': gain(ks[17], (DEPTH, MLA_QK)),
        'w_mla_o': nrm(ks[18], (DEPTH, MLA_WIDTH, D_MODEL), MLA_WIDTH ** -0.5),
        'dil_q_norm_g': gain(ks[19], (DEPTH, DIL_HD)),
        'dil_k_norm_g': gain(ks[20], (DEPTH, DIL_HD)),
        'w_dil_o': nrm(ks[21], (DEPTH, DIL_WIDTH, D_MODEL), DIL_WIDTH ** -0.5),
        'b_merge': nrm(ks[22], (DEPTH, N_BRANCH * D_MODEL), 0.1),
        'w_out': nrm(ks[23], (DEPTH, D_MODEL, D_MODEL), D_MODEL ** -0.5),
    }


def reference(x, positions, norm_g, w_in, conv_w, conv_b, w_gate_x, b_gate_x, w_gate_a, b_gate_a,
              lru_lambda, w_lru_o, cq_norm_g, ckv_norm_g, w_uq, w_ukv, mla_q_norm_g, mla_k_norm_g,
              w_mla_o, dil_q_norm_g, dil_k_norm_g, w_dil_o, b_merge, w_out):
    for l in range(DEPTH):
        x = hybrid_layer(x, positions, norm_g[l], w_in[l], conv_w[l], conv_b[l],
                         w_gate_x[l], b_gate_x[l], w_gate_a[l], b_gate_a[l], lru_lambda[l],
                         w_lru_o[l], cq_norm_g[l], ckv_norm_g[l], w_uq[l], w_ukv[l],
                         mla_q_norm_g[l], mla_k_norm_g[l], w_mla_o[l], dil_q_norm_g[l],
                         dil_k_norm_g[l], w_dil_o[l], b_merge[l], w_out[l])
    return x
```

```cpp
#include <hip/hip_runtime.h>
#include <hip/hip_cooperative_groups.h>
#include <cstdio>
#include <cstdint>
namespace cg = cooperative_groups;
__device__ __forceinline__ int otid() { int t = threadIdx.x; asm volatile("" : "+v"(t)); return t; }
__device__ __forceinline__ int obid() { int b = blockIdx.x; asm volatile("" : "+s"(b)); return b; }
namespace pg8 {
#define PG8_LAS __attribute__((address_space(3)))
typedef unsigned short bf16_t;
typedef short bf16x8 __attribute__((ext_vector_type(8)));
typedef float f32x4 __attribute__((ext_vector_type(4)));
typedef unsigned u32x4 __attribute__((ext_vector_type(4)));
constexpr int BM = 256, BK = 64, HALF = 128, HTB = HALF * BK * 2  , STAGE_BYTES = 8 * HTB, NXCD = 8, WGM = 8;

__host__ __device__ __forceinline__ int lds_byte(int r, int c) { const int st = (r >> 4) * 2 + (c >> 5), rr = r & 15, cc = c & 31, ob = rr * 64 + cc * 2; return st * 1024 + (ob ^ (((ob >> 9) & 1) << 5)); }
__host__ __device__ __forceinline__ void stage_rc(int b, int& R, int& C) { const int st = b / 1024, sb = b % 1024, swz = sb ^ (((sb >> 9) & 1) << 5); R = (st >> 1) * 16 + swz / 64; C = (st & 1) * 32 + (swz % 64) / 2; }
__host__ __device__ __forceinline__ int perm32(int rho) { const int n = rho >> 4, i = rho & 15; return 8 * (i >> 2) + 4 * n + (i & 3); }

struct Unit { int pm, pn; };
struct Gemm { const bf16_t* A; const bf16_t* Bt; int M, N, K, lda; };

struct StaticOrder {
    int nM, nN, nwg, G, c;
    __host__ __device__ void init(int M, int N, int G_, int c_) { nM = M / BM; nN = N / BM; nwg = nM * nN; G = G_; c = c_; }
    __host__ __device__ bool next(int i, Unit& u) const {
        const long L = (long)i * G + c; if (L >= nwg) return false;
        int wgid = (int)L; { const int q = nwg / NXCD, r = nwg % NXCD, xcd = wgid % NXCD, off = wgid / NXCD; wgid = (xcd < r ? xcd * (q + 1) : r * (q + 1) + (xcd - r) * q) + off; }
        const int nig = WGM * nN, gid = wgid / nig, fm = gid * WGM, gsz = (nM - fm) < WGM ? (nM - fm) : WGM;
        u.pm = fm + ((wgid % nig) % gsz); u.pn = (wgid % nig) / gsz; return true;
    }
    __device__ __forceinline__ void a_ready(const Unit&) const {}
    __device__ __forceinline__ void done(const Unit&) const {}
};
__device__ __forceinline__ unsigned cvt_pk_bf16(float lo, float hi) { unsigned r; asm volatile("v_cvt_pk_bf16_f32 %0, %1, %2" : "=v"(r) : "v"(lo), "v"(hi)); return r; }
template <class Epi, class Sched, bool ALIGN_EPI = false, bool SP2 = false>
__device__ __forceinline__ void gemm_phase(PG8_LAS unsigned char* lds, const Gemm g, const Sched& S, const Epi& E) {
    const int tid = otid(), wid = __builtin_amdgcn_readfirstlane(tid >> 6), lane = tid & 63, wr = wid >> 2, wc = wid & 3, fr = lane & 15, fq = lane >> 4;
    const int K = g.K, nt = K / BK;
    unsigned voffA[2], voffB[2];
#pragma unroll
    for (int i = 0; i < 2; ++i) { int R, C; stage_rc(tid * 16 + i * 8192, R, C); const int Rb = Epi::PERM ? ((R & ~31) + perm32(R & 31)) : R;
        voffA[i] = (unsigned)(R * g.lda + C) * 2u; voffB[i] = (unsigned)(Rb * K + C) * 2u; }
    const size_t kstep = (size_t)(BK * 2);
    const size_t hstepA = (size_t)HALF * g.lda * 2, hstepB = (size_t)HALF * K * 2;
    const size_t tstepA = 2 * hstepA, tstepB = 2 * hstepB;
    const unsigned ldsw = (unsigned)wid * 1024u;
    const int aoff = lds_byte(wr * 64 + fr, fq * 8), boff = lds_byte(wc * 32 + fr, fq * 8);
#define PG8_SA(b, h) (((b) * 2 + (h)) * HTB)
#define PG8_SB(b, h) ((4 + (b) * 2 + (h)) * HTB)
#define PG8_STAGE(bufoff, gbase, voff) do { _Pragma("unroll") for (int _i = 0; _i < 2; ++_i) \
        __builtin_amdgcn_global_load_lds((const unsigned*)((const char*)(gbase) + (voff)[_i]), (PG8_LAS unsigned*)(lds + (bufoff) + ldsw + _i * 8192), 16, 0, 0); } while (0)
#define PG8_LDA(dst, b, h) do { _Pragma("unroll") for (int m = 0; m < 4; ++m) _Pragma("unroll") for (int k = 0; k < 2; ++k) dst[m][k] = *(const PG8_LAS bf16x8*)(lds + PG8_SA(b, h) + aoff + m * 2048 + k * 1024); } while (0)
#define PG8_LDB(dst, b, h) do { _Pragma("unroll") for (int n = 0; n < 2; ++n) _Pragma("unroll") for (int k = 0; k < 2; ++k) dst[n][k] = *(const PG8_LAS bf16x8*)(lds + PG8_SB(b, h) + boff + n * 2048 + k * 1024); } while (0)
#define PG8_MMA(ai, bj, At, Bt) do { __builtin_amdgcn_s_setprio(1); _Pragma("unroll") for (int m = 0; m < 4; ++m) _Pragma("unroll") for (int n = 0; n < 2; ++n) _Pragma("unroll") for (int k = 0; k < 2; ++k) \
        acc[ai][bj][m][n] = __builtin_amdgcn_mfma_f32_16x16x32_bf16(Bt[n][k], At[m][k], acc[ai][bj][m][n], 0, 0, 0); __builtin_amdgcn_s_setprio(0); } while (0)
#define PG8_WAIT_V(n) asm volatile("s_waitcnt vmcnt(" #n ")" ::: "memory")
#define PG8_WAIT_L(n) asm volatile("s_waitcnt lgkmcnt(" #n ")" ::: "memory")
#define PG8_BAR __builtin_amdgcn_s_barrier()
#define PG8_SCHED __builtin_amdgcn_sched_barrier(0)
    Unit cur, nxt; int ui = 0;
    if (!S.next(0, cur)) return;
    f32x4 acc[2][2][4][2];
#pragma unroll
    for (int a = 0; a < 2; ++a)
#pragma unroll
        for (int b = 0; b < 2; ++b)
#pragma unroll
            for (int m = 0; m < 4; ++m)
#pragma unroll
                for (int n = 0; n < 2; ++n) acc[a][b][m][n] = (f32x4){0.f, 0.f, 0.f, 0.f};
    bf16x8 At[4][2], B0[2][2], B1[2][2];
    const char* cA = (const char*)g.A + (size_t)cur.pm * tstepA; const char* cB = (const char*)g.Bt + (size_t)cur.pn * tstepB;
    S.a_ready(cur);
    if constexpr (SP2) {
        PG8_STAGE(PG8_SB(0, 0), cB, voffB); PG8_STAGE(PG8_SB(0, 1), cB + hstepB, voffB); PG8_STAGE(PG8_SA(0, 0), cA, voffA); PG8_STAGE(PG8_SA(0, 1), cA + hstepA, voffA);
        if (wr == 1) PG8_BAR;
        PG8_WAIT_V(2); PG8_BAR;
        PG8_STAGE(PG8_SB(1, 0), cB + kstep, voffB); PG8_STAGE(PG8_SA(1, 0), cA + kstep, voffA); PG8_STAGE(PG8_SB(1, 1), cB + hstepB + kstep, voffB);
        PG8_WAIT_V(6); PG8_BAR;
    } else {
        PG8_STAGE(PG8_SB(0, 0), cB, voffB); PG8_STAGE(PG8_SA(0, 0), cA, voffA); PG8_STAGE(PG8_SB(0, 1), cB + hstepB, voffB); PG8_STAGE(PG8_SA(0, 1), cA + hstepA, voffA);
        if (wr == 1) PG8_BAR;
        PG8_WAIT_V(4); PG8_BAR;
        PG8_STAGE(PG8_SB(1, 0), cB + kstep, voffB); PG8_STAGE(PG8_SA(1, 0), cA + kstep, voffA); PG8_STAGE(PG8_SB(1, 1), cB + hstepB + kstep, voffB);
        PG8_WAIT_V(6); PG8_BAR;
    }
    for (;;) {
        const bool has_next = S.next(ui + 1, nxt);
        const char* nA = has_next ? (const char*)g.A + (size_t)nxt.pm * tstepA : cA; const char* nB = has_next ? (const char*)g.Bt + (size_t)nxt.pn * tstepB : cB;
        for (int t = 0; t < nt; t += 2) {
            const bool last = (t == nt - 2);
            const char* a1 = cA + (size_t)(t + 1) * kstep;
            const char* a2 = last ? nA : cA + (size_t)(t + 2) * kstep; const char* b2 = last ? nB : cB + (size_t)(t + 2) * kstep;
            const char* a3 = a2 + kstep; const char* b3 = b2 + kstep;
            if (last && has_next) S.a_ready(nxt);
            if constexpr (SP2) {
            PG8_LDB(B0, 0, 0); PG8_LDB(B1, 0, 1); PG8_SCHED; PG8_LDA(At, 0, 0); PG8_STAGE(PG8_SA(1, 1), a1 + hstepA, voffA);
            PG8_WAIT_V(8); PG8_WAIT_L(0); PG8_BAR; PG8_MMA(0, 0, At, B0); PG8_MMA(0, 1, At, B1); PG8_BAR; PG8_SCHED;
            PG8_LDA(At, 0, 1); PG8_STAGE(PG8_SB(0, 0), b2, voffB); PG8_STAGE(PG8_SB(0, 1), b2 + hstepB, voffB); PG8_STAGE(PG8_SA(0, 0), a2, voffA);
            PG8_WAIT_V(8); PG8_WAIT_L(0); PG8_BAR; PG8_MMA(1, 0, At, B0); PG8_MMA(1, 1, At, B1); PG8_BAR; PG8_SCHED;
            PG8_LDB(B0, 1, 0); PG8_LDB(B1, 1, 1); PG8_SCHED; PG8_LDA(At, 1, 0); PG8_STAGE(PG8_SA(0, 1), a2 + hstepA, voffA);
            PG8_WAIT_V(8); PG8_WAIT_L(0); PG8_BAR; PG8_MMA(0, 0, At, B0); PG8_MMA(0, 1, At, B1); PG8_BAR; PG8_SCHED;
            PG8_LDA(At, 1, 1); PG8_STAGE(PG8_SB(1, 0), b3, voffB); PG8_STAGE(PG8_SB(1, 1), b3 + hstepB, voffB); PG8_STAGE(PG8_SA(1, 0), a3, voffA);
            PG8_WAIT_V(8); PG8_WAIT_L(0); PG8_BAR; PG8_MMA(1, 0, At, B0); PG8_MMA(1, 1, At, B1); PG8_BAR; PG8_SCHED;
            } else {
            PG8_LDB(B0, 0, 0); PG8_SCHED; PG8_LDA(At, 0, 0); PG8_STAGE(PG8_SA(1, 1), a1 + hstepA, voffA);
            PG8_WAIT_L(8); PG8_BAR; PG8_WAIT_L(0); PG8_MMA(0, 0, At, B0); PG8_BAR; PG8_SCHED;
            PG8_LDB(B1, 0, 1); PG8_STAGE(PG8_SB(0, 0), b2, voffB);
            PG8_BAR; PG8_WAIT_L(0); PG8_MMA(0, 1, At, B1); PG8_BAR;
            PG8_LDA(At, 0, 1); PG8_STAGE(PG8_SA(0, 0), a2, voffA);
            PG8_BAR; PG8_WAIT_L(0); PG8_MMA(1, 0, At, B0); PG8_BAR; PG8_SCHED;
            PG8_STAGE(PG8_SB(0, 1), b2 + hstepB, voffB);
            PG8_WAIT_V(6); PG8_BAR; PG8_MMA(1, 1, At, B1); PG8_BAR;
            PG8_LDB(B0, 1, 0); PG8_SCHED; PG8_LDA(At, 1, 0); PG8_STAGE(PG8_SA(0, 1), a2 + hstepA, voffA);
            PG8_WAIT_L(8); PG8_BAR; PG8_WAIT_L(0); PG8_MMA(0, 0, At, B0); PG8_BAR; PG8_SCHED;
            PG8_LDB(B1, 1, 1); PG8_STAGE(PG8_SB(1, 0), b3, voffB);
            PG8_BAR; PG8_WAIT_L(0); PG8_MMA(0, 1, At, B1); PG8_BAR;
            PG8_LDA(At, 1, 1); PG8_STAGE(PG8_SA(1, 0), a3, voffA);
            PG8_BAR; PG8_WAIT_L(0); PG8_MMA(1, 0, At, B0); PG8_BAR; PG8_SCHED;
            PG8_STAGE(PG8_SB(1, 1), b3 + hstepB, voffB);
            PG8_WAIT_V(6); PG8_BAR; PG8_MMA(1, 1, At, B1); PG8_BAR;
            }
        }
        if constexpr (ALIGN_EPI) { if (wr == 0) PG8_BAR; }
        if constexpr (!Epi::AFTER_DRAIN) { E(acc, cur, wr, wc, fr, fq); S.done(cur); }
        if (!has_next) break;
#pragma unroll
        for (int a = 0; a < 2; ++a)
#pragma unroll
            for (int b = 0; b < 2; ++b)
#pragma unroll
                for (int m = 0; m < 4; ++m)
#pragma unroll
                    for (int n = 0; n < 2; ++n) acc[a][b][m][n] = (f32x4){0.f, 0.f, 0.f, 0.f};
        cur = nxt; cA = nA; cB = nB; ++ui;
        if constexpr (ALIGN_EPI) { if (wr == 1) PG8_BAR; }
    }
    PG8_WAIT_V(0);
    if constexpr (!ALIGN_EPI) { if (wr == 0) PG8_BAR; }
    PG8_BAR;
    if constexpr (Epi::AFTER_DRAIN) { E.fused(acc, cur, wr, wc, fr, fq, lds, wid, lane); S.done(cur); }
#undef PG8_SA
#undef PG8_SB
#undef PG8_STAGE
#undef PG8_LDA
#undef PG8_LDB
#undef PG8_MMA
#undef PG8_WAIT_V
#undef PG8_WAIT_L
#undef PG8_BAR
#undef PG8_SCHED
}
}

typedef unsigned short bf16_t;
using pg8::bf16x8; using pg8::f32x4; using pg8::u32x4;
typedef float f32x16 __attribute__((ext_vector_type(16)));
typedef unsigned u32x2 __attribute__((ext_vector_type(2)));
#define DI __device__ __forceinline__
#define MFMA32(a, b, c) __builtin_amdgcn_mfma_f32_32x32x16_bf16((a), (b), (c), 0, 0, 0)

constexpr int SEQ = 4096, BATCH = 8, DM = 1024, DEPTH = 2;
constexpr int NB = 4, TC = NB * SEQ, NCHUNK = BATCH / NB;
constexpr int INW = 11168, LDZ = 11168, NZP = 11264;
constexpr int C_LRUX = 0, C_LRUG = 1024, C_MLAG = 2048, C_DILG = 2560, C_DQ = 3072, C_DK = 4608, C_DV = 6144, C_MERGE = 7680, C_CQ = 10752, C_CKV = 11008, C_KR = 11136;
constexpr float EPS = 1e-6f, LOG2E = 1.4426950408889634f, LN2 = 0.6931471805599453f, LOG2_THETA = 13.287712379549449f;
constexpr int NUP = 1792, KUP = 384;

constexpr size_t W_IN_B = (size_t)NZP * DM * 2, W_UP_B = (size_t)NUP * KUP * 2, W_SQ_B = (size_t)DM * DM * 2, W_HF_B = (size_t)DM * 512 * 2, W_G_B = (size_t)8 * 128 * 128 * 2;
constexpr size_t WL_IN = 0, WL_UP = WL_IN + W_IN_B, WL_PLRU = WL_UP + W_UP_B, WL_PMLA = WL_PLRU + W_SQ_B, WL_PDIL = WL_PMLA + W_HF_B, WL_OUT = WL_PDIL + W_HF_B,
                 WL_GX = WL_OUT + W_SQ_B, WL_GA = WL_GX + W_G_B, WL_SIZE = WL_GA + W_G_B;
constexpr size_t WS_W = 0, WS_Z = WS_W + 2 * WL_SIZE, WS_S = WS_Z + (size_t)TC * LDZ * 2;
constexpr size_t S_XN = 0;
constexpr int LDQ = 1792;
constexpr size_t S_QF = 0, S_KF = S_QF + (size_t)TC * LDQ * 2, S_AGG = S_KF + (size_t)TC * 768 * 2,
                 S_LSE = S_AGG + (size_t)(TC / 64) * 1024 * 8, S_P23_END = S_LSE + (size_t)3 * TC * 8 * 4;
constexpr size_t S_MRG = 0, S_MB = S_MRG + (size_t)TC * DM * 4, S_END = S_MB + (size_t)TC * DM * 2;
static_assert(S_P23_END <= S_END, "scratch");
constexpr size_t WS_NEED = WS_S + S_END;
static_assert(WS_NEED <= 536870912ull, "workspace");
static_assert(WS_Z % 256 == 0 && WS_S % 256 == 0 && WL_SIZE % 256 == 0, "align");
constexpr int LDS_BYTES = 135168;

DI float bflo(unsigned w) { return __uint_as_float(w << 16); }
DI float bfhi(unsigned w) { return __uint_as_float(w & 0xffff0000u); }
DI unsigned pk2(float lo, float hi) { typedef float f2_t __attribute__((ext_vector_type(2))); typedef __bf16 b2_t __attribute__((ext_vector_type(2)));
    f2_t v = {lo, hi}; b2_t b = __builtin_convertvector(v, b2_t); return __builtin_bit_cast(unsigned, b); }
DI float sigmoidf_(float x) { return 1.f / (1.f + __expf(-x)); }
DI float siluf_(float x) { return x / (1.f + __expf(-x)); }
DI float wave_sum(float v) {
#pragma unroll
    for (int m = 1; m < 64; m <<= 1) v += __shfl_xor(v, m);
    return v; }
DI int crow(int i, int h) { return (i & 3) + 8 * (i >> 2) + 4 * h; }
DI void sincos_rev(float ang, float& s, float& c) { float rev = ang * 0.15915494309189535f; rev = rev - floorf(rev); s = __builtin_amdgcn_sinf(rev); c = __builtin_amdgcn_cosf(rev); }

struct Args { const float* in[24]; float* out; unsigned char* ws; };

DI void wconv_job(float* tl, const float* __restrict__ src, int lds_, int n0s, int nrows, int ncols, bf16_t* dst, int ldd, int n0d, int k0d, const float* __restrict__ scale) {
    const int tid = otid(), ntn = ncols / 32, ntk = nrows / 128, nt = ntn * ntk;
    for (int t = obid(); t < nt; t += gridDim.x) {
        const int tn = t % ntn, tk = t / ntn, k0 = tk * 128;
#pragma unroll
        for (int i = 0; i < 8; ++i) { const int kk = i * 16 + (tid >> 5), nn = tid & 31;
            float v = src[(size_t)(k0 + kk) * lds_ + n0s + tn * 32 + nn]; if (scale) v *= scale[k0 + kk]; tl[kk * 33 + nn] = v; }
        __syncthreads();
        { const int n = tid >> 4, kq = tid & 15; u32x4 w;
          w.x = pk2(tl[(kq * 8 + 0) * 33 + n], tl[(kq * 8 + 1) * 33 + n]); w.y = pk2(tl[(kq * 8 + 2) * 33 + n], tl[(kq * 8 + 3) * 33 + n]);
          w.z = pk2(tl[(kq * 8 + 4) * 33 + n], tl[(kq * 8 + 5) * 33 + n]); w.w = pk2(tl[(kq * 8 + 6) * 33 + n], tl[(kq * 8 + 7) * 33 + n]);
          *(u32x4*)(dst + (size_t)(n0d + tn * 32 + n) * ldd + k0d + k0 + kq * 8) = w; }
        __syncthreads();
    }
}
DI void zero_rect(bf16_t* dst, int ldd, int n0, int nn, int k0, int nk) {
    const int per = nk / 8, tot = nn * per;
    for (int i = obid() * 512 + otid(); i < tot; i += gridDim.x * 512) { const int n = i / per, c = i % per;
        *(u32x4*)(dst + (size_t)(n0 + n) * ldd + k0 + c * 8) = (u32x4){0u, 0u, 0u, 0u}; }
}
DI void prologue_weights(const Args& a, unsigned char* lds) {
    float* tl = (float*)lds;
    for (int l = 0; l < DEPTH; ++l) {
        unsigned char* wl = a.ws + WS_W + (size_t)l * WL_SIZE;
        bf16_t* win = (bf16_t*)(wl + WL_IN); const float* w_in = a.in[3] + (size_t)l * DM * INW;
        wconv_job(tl, w_in, INW, 0,    1024, 2048, win, DM, C_LRUX, 0, nullptr);
        wconv_job(tl, w_in, INW, 2464, 1024, 512,  win, DM, C_MLAG, 0, nullptr);
        wconv_job(tl, w_in, INW, 7584, 1024, 512,  win, DM, C_DILG, 0, nullptr);
        wconv_job(tl, w_in, INW, 2976, 1024, 4608, win, DM, C_DQ, 0, nullptr);
        wconv_job(tl, w_in, INW, 8096, 1024, 3072, win, DM, C_MERGE, 0, nullptr);
        wconv_job(tl, w_in, INW, 2048, 1024, 416,  win, DM, C_CQ, 0, nullptr);
        zero_rect(win, DM, INW, NZP - INW, 0, DM);
        bf16_t* wup = (bf16_t*)(wl + WL_UP);
        wconv_job(tl, a.in[14] + (size_t)l * 256 * 768, 768, 0, 256, 768, wup, KUP, 0, 0, a.in[12] + l * 256);
        wconv_job(tl, a.in[15] + (size_t)l * 128 * 1024, 1024, 0, 128, 1024, wup, KUP, 768, 256, a.in[13] + l * 128);
        zero_rect(wup, KUP, 0, 768, 256, 128); zero_rect(wup, KUP, 768, 1024, 0, 256);
        wconv_job(tl, a.in[11] + (size_t)l * DM * DM, DM, 0, 1024, 1024, (bf16_t*)(wl + WL_PLRU), 1024, 0, 0, nullptr);
        wconv_job(tl, a.in[18] + (size_t)l * 512 * DM, DM, 0, 512, 1024, (bf16_t*)(wl + WL_PMLA), 512, 0, 0, nullptr);
        wconv_job(tl, a.in[21] + (size_t)l * 512 * DM, DM, 0, 512, 1024, (bf16_t*)(wl + WL_PDIL), 512, 0, 0, nullptr);
        wconv_job(tl, a.in[23] + (size_t)l * DM * DM, DM, 0, 1024, 1024, (bf16_t*)(wl + WL_OUT), 1024, 0, 0, nullptr);
        for (int nb = 0; nb < 8; ++nb) {
            wconv_job(tl, a.in[6] + ((size_t)l * 8 + nb) * 128 * 128, 128, 0, 128, 128, (bf16_t*)(wl + WL_GX) + nb * 128 * 128, 128, 0, 0, nullptr);
            wconv_job(tl, a.in[8] + ((size_t)l * 8 + nb) * 128 * 128, 128, 0, 128, 128, (bf16_t*)(wl + WL_GA) + nb * 128 * 128, 128, 0, 0, nullptr);
        }
    }
}

DI void p0_rmsnorm(const float* __restrict__ x, const float* __restrict__ g, bf16_t* xn) {
    const int tid = otid(), lane = tid & 63, gw = obid() * 8 + (tid >> 6), nw = gridDim.x * 8;
    f32x4 gv[4];
#pragma unroll
    for (int i = 0; i < 4; ++i) gv[i] = *(const f32x4*)(g + i * 256 + lane * 4);
    for (int row = gw; row < TC; row += nw) {
        const float* xr = x + (size_t)row * DM; f32x4 v[4]; float ss = 0.f;
#pragma unroll
        for (int i = 0; i < 4; ++i) { v[i] = *(const f32x4*)(xr + i * 256 + lane * 4); ss += v[i][0] * v[i][0] + v[i][1] * v[i][1] + v[i][2] * v[i][2] + v[i][3] * v[i][3]; }
        ss = wave_sum(ss); const float rs = rsqrtf(ss * (1.f / DM) + EPS);
#pragma unroll
        for (int i = 0; i < 4; ++i) { u32x2 w; w.x = pk2(v[i][0] * rs * gv[i][0], v[i][1] * rs * gv[i][1]); w.y = pk2(v[i][2] * rs * gv[i][2], v[i][3] * rs * gv[i][3]);
            *(u32x2*)(xn + (size_t)row * DM + i * 256 + lane * 4) = w; }
    }
}

struct EpiZ {
    static constexpr bool PERM = true, AFTER_DRAIN = false;
    bf16_t* O; int ldc; int ncols;
    DI void operator()(const f32x4 (&acc)[2][2][4][2], const pg8::Unit& u, int wr, int wc, int fr, int fq) const {
        const int row0 = u.pm * 256 + wr * 64 + fr, col0 = u.pn * 256 + wc * 32 + 8 * fq;
#pragma unroll
        for (int ai = 0; ai < 2; ++ai)
#pragma unroll
            for (int m = 0; m < 4; ++m) { bf16_t* rowp = O + (size_t)(row0 + ai * 128 + m * 16) * ldc;
#pragma unroll
                for (int bj = 0; bj < 2; ++bj) { const int c = col0 + bj * 128; if (c < ncols) { const f32x4 v0 = acc[ai][bj][m][0], v1 = acc[ai][bj][m][1];
                    u32x4 w; w.x = pk2(v0[0], v0[1]); w.y = pk2(v0[2], v0[3]); w.z = pk2(v1[0], v1[1]); w.w = pk2(v1[2], v1[3]); *(u32x4*)(rowp + c) = w; } } }
    }
};
template <int BR> struct EpiMerge {
    static constexpr bool PERM = true, AFTER_DRAIN = false;
    const bf16_t* Z; const float* bm; float* MRG; bf16_t* MB;
    DI void operator()(const f32x4 (&acc)[2][2][4][2], const pg8::Unit& u, int wr, int wc, int fr, int fq) const {
        const int row0 = u.pm * 256 + wr * 64 + fr, col0 = u.pn * 256 + wc * 32 + 8 * fq;
#pragma unroll
        for (int bj = 0; bj < 2; ++bj) { const int c = col0 + bj * 128;
            const f32x4 b0 = *(const f32x4*)(bm + BR * 1024 + c), b1 = *(const f32x4*)(bm + BR * 1024 + c + 4);
#pragma unroll
            for (int ai = 0; ai < 2; ++ai)
#pragma unroll
                for (int m = 0; m < 4; ++m) { const size_t row = (size_t)(row0 + ai * 128 + m * 16);
                    const u32x4 gz = *(const u32x4*)(Z + row * LDZ + C_MERGE + BR * 1024 + c);
                    f32x4 g0, g1; g0[0] = sigmoidf_(bflo(gz.x) + b0[0]); g0[1] = sigmoidf_(bfhi(gz.x) + b0[1]); g0[2] = sigmoidf_(bflo(gz.y) + b0[2]); g0[3] = sigmoidf_(bfhi(gz.y) + b0[3]);
                    g1[0] = sigmoidf_(bflo(gz.z) + b1[0]); g1[1] = sigmoidf_(bfhi(gz.z) + b1[1]); g1[2] = sigmoidf_(bflo(gz.w) + b1[2]); g1[3] = sigmoidf_(bfhi(gz.w) + b1[3]);
                    f32x4 v0 = g0 * acc[ai][bj][m][0], v1 = g1 * acc[ai][bj][m][1];
                    float* mp = MRG + row * DM + c;
                    if (BR > 0) { v0 += *(const f32x4*)mp; v1 += *(const f32x4*)(mp + 4); }
                    if (BR < 2) { *(f32x4*)mp = v0; *(f32x4*)(mp + 4) = v1; }
                    else { u32x4 w; w.x = pk2(v0[0], v0[1]); w.y = pk2(v0[2], v0[3]); w.z = pk2(v1[0], v1[1]); w.w = pk2(v1[2], v1[3]); *(u32x4*)(MB + row * DM + c) = w; }
                    asm volatile("" ::: "memory"); } }
    }
};
struct EpiOut {
    static constexpr bool PERM = false, AFTER_DRAIN = false;
    const float* X; float* O;
    DI void operator()(const f32x4 (&acc)[2][2][4][2], const pg8::Unit& u, int wr, int wc, int fr, int fq) const {
        const int row0 = u.pm * 256 + wr * 64 + fr, col0 = u.pn * 256 + wc * 32 + 4 * fq;
#pragma unroll
        for (int ai = 0; ai < 2; ++ai)
#pragma unroll
            for (int m = 0; m < 4; ++m) { const size_t ro = (size_t)(row0 + ai * 128 + m * 16) * DM + col0;
#pragma unroll
                for (int bj = 0; bj < 2; ++bj)
#pragma unroll
                    for (int n = 0; n < 2; ++n) { const f32x4 xv = *(const f32x4*)(X + ro + bj * 128 + n * 16); *(f32x4*)(O + ro + bj * 128 + n * 16) = xv + acc[ai][bj][m][n]; } }
    }
};

DI void dil_prep(bf16_t* z, const int* __restrict__ pos, const float* __restrict__ gq, const float* __restrict__ gk) {
    const int tot = TC * 48;
    for (int it = obid() * 512 + otid(); it < tot; it += gridDim.x * 512) {
        const int tok = it / 48, hh = it % 48; const bool isq = hh < 24;
        bf16_t* p = z + (size_t)tok * LDZ + (isq ? C_DQ + hh * 64 : C_DK + (hh - 24) * 64);
        const float* g = isq ? gq : gk;
        float v[64]; float ss = 0.f;
#pragma unroll
        for (int c = 0; c < 8; ++c) { const u32x4 w = *(const u32x4*)(p + c * 8);
            v[c * 8 + 0] = bflo(w.x); v[c * 8 + 1] = bfhi(w.x); v[c * 8 + 2] = bflo(w.y); v[c * 8 + 3] = bfhi(w.y); v[c * 8 + 4] = bflo(w.z); v[c * 8 + 5] = bfhi(w.z); v[c * 8 + 6] = bflo(w.w); v[c * 8 + 7] = bfhi(w.w); }
#pragma unroll
        for (int i = 0; i < 64; ++i) ss += v[i] * v[i];
        const float rs = rsqrtf(ss * (1.f / 64.f) + EPS) * (isq ? 0.125f * LOG2E : 1.f);
        const float fp = (float)pos[tok];
#pragma unroll
        for (int i = 0; i < 32; ++i) { const float inv = exp2f(-(float)i * (LOG2_THETA / 32.f)); float s, c; sincos_rev(fp * inv, s, c);
            const float x1 = v[i] * rs * g[i], x2 = v[i + 32] * rs * g[i + 32]; v[i] = x1 * c - x2 * s; v[i + 32] = x2 * c + x1 * s; }
#pragma unroll
        for (int c = 0; c < 8; ++c) { u32x4 w; w.x = pk2(v[c * 8 + 0], v[c * 8 + 1]); w.y = pk2(v[c * 8 + 2], v[c * 8 + 3]); w.z = pk2(v[c * 8 + 4], v[c * 8 + 5]); w.w = pk2(v[c * 8 + 6], v[c * 8 + 7]);
            *(u32x4*)(p + c * 8) = w; }
    }
}

#define UNPK8(w, d, o, sc_) { d[o + 0] = bflo(w.x) * (sc_); d[o + 1] = bfhi(w.x) * (sc_); d[o + 2] = bflo(w.y) * (sc_); d[o + 3] = bfhi(w.y) * (sc_); d[o + 4] = bflo(w.z) * (sc_); d[o + 5] = bfhi(w.z) * (sc_); d[o + 6] = bflo(w.w) * (sc_); d[o + 7] = bfhi(w.w) * (sc_); }
DI float ssq8(u32x4 w) { return bflo(w.x) * bflo(w.x) + bfhi(w.x) * bfhi(w.x) + bflo(w.y) * bflo(w.y) + bfhi(w.y) * bfhi(w.y) + bflo(w.z) * bflo(w.z) + bfhi(w.z) * bfhi(w.z) + bflo(w.w) * bflo(w.w) + bfhi(w.w) * bfhi(w.w); }
DI u32x4 scale8(u32x4 w, float s, const float* __restrict__ g) { u32x4 o; o.x = pk2(bflo(w.x) * s * g[0], bfhi(w.x) * s * g[1]); o.y = pk2(bflo(w.y) * s * g[2], bfhi(w.y) * s * g[3]);
    o.z = pk2(bflo(w.z) * s * g[4], bfhi(w.z) * s * g[5]); o.w = pk2(bflo(w.w) * s * g[6], bfhi(w.w) * s * g[7]); return o; }
DI void mla_finalize(unsigned char* lds, const bf16_t* z, bf16_t* qf, bf16_t* kvr, bf16_t* kf, const int* __restrict__ pos, const float* __restrict__ gqn, const float* __restrict__ gkn) {
    float* rst = (float*)lds;
    const int tid = otid(), lane = tid & 63, wid = tid >> 6;
    for (int grp = obid(); grp < TC / 64; grp += gridDim.x) {
        const int t0 = grp * 64;
        __syncthreads();
        for (int i = 0; i < 8; ++i) { const int tok = t0 + wid * 8 + i; const bf16_t* zr = z + (size_t)tok * LDZ;
            const u32x2 a = *(const u32x2*)(zr + C_CQ + lane * 4); const unsigned b = *(const unsigned*)(zr + C_CKV + lane * 2);
            float s1 = bflo(a.x) * bflo(a.x) + bfhi(a.x) * bfhi(a.x) + bflo(a.y) * bflo(a.y) + bfhi(a.y) * bfhi(a.y), s2 = bflo(b) * bflo(b) + bfhi(b) * bfhi(b);
            s1 = wave_sum(s1); s2 = wave_sum(s2);
            if (lane == 0) { rst[(wid * 8 + i) * 2] = rsqrtf(s1 * (1.f / 256.f) + EPS); rst[(wid * 8 + i) * 2 + 1] = rsqrtf(s2 * (1.f / 128.f) + EPS); } }
        __syncthreads();
        const int tl_ = tid >> 3, hd = tid & 7, tok = t0 + tl_; const float rcq = rst[tl_ * 2], rckv = rst[tl_ * 2 + 1]; const float fp = (float)pos[tok];
        {
            bf16_t* p = qf + (size_t)tok * LDQ + hd * 96; float ss = 0.f;
#pragma unroll
            for (int c = 0; c < 12; ++c) ss += ssq8(*(const u32x4*)(p + c * 8));
            ss *= rcq * rcq;
            const float rs = rsqrtf(ss * (1.f / 96.f) + EPS) * rcq * (0.10206207261596575f * LOG2E);
#pragma unroll
            for (int c = 0; c < 8; ++c) { *(u32x4*)(p + c * 8) = scale8(*(const u32x4*)(p + c * 8), rs, gqn + c * 8); asm volatile("" ::: "memory"); }
            float v[32];
#pragma unroll
            for (int c = 0; c < 4; ++c) { const u32x4 w = *(const u32x4*)(p + 64 + c * 8); UNPK8(w, v, c * 8, rs) }
#pragma unroll
            for (int i = 0; i < 16; ++i) { const float inv = exp2f(-(float)i * (LOG2_THETA / 16.f)); float sn, cs; sincos_rev(fp * inv, sn, cs);
                const float x1 = v[i] * gqn[64 + i], x2 = v[16 + i] * gqn[80 + i]; v[i] = x1 * cs - x2 * sn; v[16 + i] = x2 * cs + x1 * sn; }
#pragma unroll
            for (int c = 0; c < 4; ++c) { u32x4 w; w.x = pk2(v[c * 8 + 0], v[c * 8 + 1]); w.y = pk2(v[c * 8 + 2], v[c * 8 + 3]); w.z = pk2(v[c * 8 + 4], v[c * 8 + 5]); w.w = pk2(v[c * 8 + 6], v[c * 8 + 7]);
                *(u32x4*)(p + 64 + c * 8) = w; }
        }
        asm volatile("" ::: "memory");
        {
            bf16_t* pkv = kvr + (size_t)tok * LDQ + hd * 128; const bf16_t* pkr = z + (size_t)tok * LDZ + C_KR; bf16_t* pk = kf + (size_t)tok * 768 + hd * 96; float ss = 0.f, sr = 0.f;
#pragma unroll
            for (int c = 0; c < 8; ++c) ss += ssq8(*(const u32x4*)(pkv + c * 8));
#pragma unroll
            for (int c = 0; c < 4; ++c) sr += ssq8(*(const u32x4*)(pkr + c * 8));
            ss = ss * rckv * rckv + sr;
            const float rs = rsqrtf(ss * (1.f / 96.f) + EPS);
#pragma unroll
            for (int c = 0; c < 8; ++c) { *(u32x4*)(pk + c * 8) = scale8(*(const u32x4*)(pkv + c * 8), rs * rckv, gkn + c * 8); asm volatile("" ::: "memory"); }
            float v[32];
#pragma unroll
            for (int c = 0; c < 4; ++c) { const u32x4 w = *(const u32x4*)(pkr + c * 8); UNPK8(w, v, c * 8, rs) }
#pragma unroll
            for (int i = 0; i < 16; ++i) { const float inv = exp2f(-(float)i * (LOG2_THETA / 16.f)); float sn, cs; sincos_rev(fp * inv, sn, cs);
                const float x1 = v[i] * gkn[64 + i], x2 = v[16 + i] * gkn[80 + i]; v[i] = x1 * cs - x2 * sn; v[16 + i] = x2 * cs + x1 * sn; }
#pragma unroll
            for (int c = 0; c < 4; ++c) { u32x4 w; w.x = pk2(v[c * 8 + 0], v[c * 8 + 1]); w.y = pk2(v[c * 8 + 2], v[c * 8 + 3]); w.z = pk2(v[c * 8 + 4], v[c * 8 + 5]); w.w = pk2(v[c * 8 + 6], v[c * 8 + 7]);
                *(u32x4*)(pk + 64 + c * 8) = w; }
#pragma unroll
            for (int c = 0; c < 8; ++c) { u32x4 w = *(const u32x4*)(pkv + 64 + c * 8);
                w.x = pk2(bflo(w.x) * rckv, bfhi(w.x) * rckv); w.y = pk2(bflo(w.y) * rckv, bfhi(w.y) * rckv); w.z = pk2(bflo(w.z) * rckv, bfhi(w.z) * rckv); w.w = pk2(bflo(w.w) * rckv, bfhi(w.w) * rckv);
                *(u32x4*)(pkv + 64 + c * 8) = w; }
        }
    }
}

DI void dil_combine(bf16_t* z, const float* __restrict__ lse) {
    const int tot = TC * 64;
    for (int it = obid() * 512 + otid(); it < tot; it += gridDim.x * 512) {
        const int tok = it >> 6, hd = (it >> 3) & 7, dc = it & 7;
        const float l0 = lse[(size_t)tok * 8 + hd], l1 = lse[(size_t)TC * 8 + (size_t)tok * 8 + hd], l2 = lse[(size_t)2 * TC * 8 + (size_t)tok * 8 + hd];
        const float mx = fmaxf(l0, fmaxf(l1, l2)); float w0 = __expf(l0 - mx), w1 = __expf(l1 - mx), w2 = __expf(l2 - mx); const float iw = 1.f / (w0 + w1 + w2); w0 *= iw; w1 *= iw; w2 *= iw;
        bf16_t* zr = z + (size_t)tok * LDZ;
        const u32x4 a = *(const u32x4*)(zr + C_DQ + (0 * 8 + hd) * 64 + dc * 8), b = *(const u32x4*)(zr + C_DQ + (1 * 8 + hd) * 64 + dc * 8), c = *(const u32x4*)(zr + C_DQ + (2 * 8 + hd) * 64 + dc * 8);
        bf16_t* gp = zr + C_DILG + hd * 64 + dc * 8; const u32x4 g = *(const u32x4*)gp; u32x4 o;
#define CMB(F) { const float e0 = (w0 * bflo(a.F) + w1 * bflo(b.F) + w2 * bflo(c.F)) * siluf_(bflo(g.F)), e1 = (w0 * bfhi(a.F) + w1 * bfhi(b.F) + w2 * bfhi(c.F)) * siluf_(bfhi(g.F)); o.F = pk2(e0, e1); }
        CMB(x) CMB(y) CMB(z) CMB(w)
#undef CMB
        *(u32x4*)gp = o;
    }
}

struct LruP { const float* conv_w; const float* conv_b; const float* b_gx; const float* b_ga; const float* lam; const bf16_t* wgx; const bf16_t* wga; };
constexpr int L_XS = 0, L_XCB = 18432, L_XC = L_XCB + 17408, L_A = L_XC + 32768, L_B = L_A + 32768, L_END = L_B + 32768;
static_assert(L_END <= LDS_BYTES, "lru lds");
template <bool FINAL> DI void lru_unit(unsigned char* lds, bf16_t* z, float* agg, const LruP& P, int bl, int j, int n) {
    const int tid = otid(), lane = tid & 63, wid = tid >> 6;
    bf16_t* xs = (bf16_t*)(lds + L_XS); bf16_t* xcb = (bf16_t*)(lds + L_XCB); float* xc = (float*)(lds + L_XC); float* as = (float*)(lds + L_A); float* bs = (float*)(lds + L_B);
    const size_t row0 = (size_t)bl * SEQ + (size_t)j * 64;
    __syncthreads();
    for (int c = tid; c < 67 * 16; c += 512) { const int i = c >> 4, cc = c & 15; const int p = j * 64 - 3 + i;
        u32x4 w = (u32x4){0u, 0u, 0u, 0u}; if (p >= 0) w = *(const u32x4*)(z + ((size_t)bl * SEQ + p) * LDZ + C_LRUX + n * 128 + cc * 8);
        *(u32x4*)(xs + i * 136 + cc * 8) = w; }
    __syncthreads();
    {
        const int i = tid >> 3, c0 = (tid & 7) * 16, cg0 = n * 128 + c0; float acc[16];
#pragma unroll
        for (int q = 0; q < 4; ++q) { const f32x4 b = *(const f32x4*)(P.conv_b + cg0 + q * 4); acc[q * 4] = b[0]; acc[q * 4 + 1] = b[1]; acc[q * 4 + 2] = b[2]; acc[q * 4 + 3] = b[3]; }
#pragma unroll
        for (int k = 0; k < 4; ++k) {
            const u32x4 xa = *(const u32x4*)(xs + (i + k) * 136 + c0), xb = *(const u32x4*)(xs + (i + k) * 136 + c0 + 8);
            float xv[16] = {bflo(xa.x), bfhi(xa.x), bflo(xa.y), bfhi(xa.y), bflo(xa.z), bfhi(xa.z), bflo(xa.w), bfhi(xa.w), bflo(xb.x), bfhi(xb.x), bflo(xb.y), bfhi(xb.y), bflo(xb.z), bfhi(xb.z), bflo(xb.w), bfhi(xb.w)};
#pragma unroll
            for (int q = 0; q < 4; ++q) { const f32x4 w = *(const f32x4*)(P.conv_w + k * 1024 + cg0 + q * 4);
                acc[q * 4] += w[0] * xv[q * 4]; acc[q * 4 + 1] += w[1] * xv[q * 4 + 1]; acc[q * 4 + 2] += w[2] * xv[q * 4 + 2]; acc[q * 4 + 3] += w[3] * xv[q * 4 + 3]; } }
#pragma unroll
        for (int q = 0; q < 4; ++q) *(f32x4*)(xc + i * 128 + c0 + q * 4) = (f32x4){acc[q * 4], acc[q * 4 + 1], acc[q * 4 + 2], acc[q * 4 + 3]};
        u32x4 w0, w1; w0.x = pk2(acc[0], acc[1]); w0.y = pk2(acc[2], acc[3]); w0.z = pk2(acc[4], acc[5]); w0.w = pk2(acc[6], acc[7]);
        w1.x = pk2(acc[8], acc[9]); w1.y = pk2(acc[10], acc[11]); w1.z = pk2(acc[12], acc[13]); w1.w = pk2(acc[14], acc[15]);
        *(u32x4*)(xcb + i * 136 + c0) = w0; *(u32x4*)(xcb + i * 136 + c0 + 8) = w1;
    }
    __syncthreads();
    {
        const int r = lane & 31, h = lane >> 5, ct = wid & 3, rt = wid >> 2;
        f32x16 gx, ga;
#pragma unroll
        for (int i = 0; i < 16; ++i) { gx[i] = 0.f; ga[i] = 0.f; }
        const bf16_t* wx = P.wgx + (size_t)n * 16384 + (size_t)(ct * 32 + r) * 128 + 8 * h; const bf16_t* wa = P.wga + (size_t)n * 16384 + (size_t)(ct * 32 + r) * 128 + 8 * h;
#pragma unroll
        for (int s = 0; s < 8; ++s) { const bf16x8 a = *(const bf16x8*)(xcb + (rt * 32 + r) * 136 + 16 * s + 8 * h);
            const bf16x8 bx = *(const bf16x8*)(wx + 16 * s), ba = *(const bf16x8*)(wa + 16 * s);
            gx = MFMA32(a, bx, gx); ga = MFMA32(a, ba, ga); }
        const int ch = ct * 32 + r, chg = n * 128 + ch; const float bgx = P.b_gx[chg], bga = P.b_ga[chg], lm = P.lam[chg];
        const float sp = (lm > 15.f) ? __expf(-lm) : log1pf(__expf(-lm));
#pragma unroll
        for (int i = 0; i < 16; ++i) { const int tk = rt * 32 + crow(i, h);
            const float vgx = sigmoidf_(gx[i] + bgx), vga = sigmoidf_(ga[i] + bga); const float la = -8.f * vga * sp; const float av = __expf(la);
            const float mult = sqrtf(fmaxf(-expm1f(2.f * la), 0.f));
            as[tk * 128 + ch] = av; bs[tk * 128 + ch] = mult * vgx * xc[tk * 128 + ch]; }
    }
    __syncthreads();
    if (!FINAL) {
        if (tid < 128) { float hh = 0.f, A = 1.f;
#pragma unroll 8
            for (int i = 0; i < 64; ++i) { const float av = as[i * 128 + tid]; hh = av * hh + bs[i * 128 + tid]; A *= av; }
            *(float2*)(agg + ((size_t)(bl * 64 + j) * 1024 + n * 128 + tid) * 2) = make_float2(A, hh); }
    } else {
        if (tid < 128) { float hh = 0.f;
            for (int jj = 0; jj < j; ++jj) { const float2 ab = *(const float2*)(agg + ((size_t)(bl * 64 + jj) * 1024 + n * 128 + tid) * 2); hh = ab.x * hh + ab.y; }
#pragma unroll 8
            for (int i = 0; i < 64; ++i) { hh = as[i * 128 + tid] * hh + bs[i * 128 + tid]; as[i * 128 + tid] = hh; } }
        __syncthreads();
        for (int c = tid; c < 64 * 16; c += 512) { const int i = c >> 4, cc = c & 15; bf16_t* gp = z + (row0 + i) * LDZ + C_LRUG + n * 128 + cc * 8; const u32x4 g = *(const u32x4*)gp;
            const float* hp = as + i * 128 + cc * 8; u32x4 o;
            o.x = pk2(hp[0] * siluf_(bflo(g.x)), hp[1] * siluf_(bfhi(g.x))); o.y = pk2(hp[2] * siluf_(bflo(g.y)), hp[3] * siluf_(bfhi(g.y)));
            o.z = pk2(hp[4] * siluf_(bflo(g.z)), hp[5] * siluf_(bfhi(g.z))); o.w = pk2(hp[6] * siluf_(bflo(g.w)), hp[7] * siluf_(bfhi(g.w))); *(u32x4*)gp = o; }
    }
}

template <int DK, bool WIN, bool MLA>
DI void attn_unit(unsigned char* lds, const bf16_t* Qb, size_t qs, const bf16_t* Kb, size_t ks, const bf16_t* Vb, size_t vs, int q0, bf16_t* Ob, size_t os, float* lsep, size_t lses) {
    constexpr int DV = 64, KLD = DK + 8, VLD = 72, KC = DK / 8, KCH = 64 * KC;
    const int tid = otid(), lane = tid & 63, wid = tid >> 6, r = lane & 31, h = lane >> 5;
    bf16_t* Ks = (bf16_t*)lds; bf16_t* Vt = (bf16_t*)(lds + 64 * KLD * 2);
    const int qw = q0 + 32 * wid;
    bf16x8 qf[DK / 16];
    { const bf16_t* qrow = Qb + (size_t)(qw + r) * qs + 8 * h;
#pragma unroll
      for (int s = 0; s < DK / 16; ++s) qf[s] = *(const bf16x8*)(qrow + 16 * s); }
    f32x16 o[2];
#pragma unroll
    for (int i = 0; i < 16; ++i) { o[0][i] = 0.f; o[1][i] = 0.f; }
    float mrow = -1e30f, lrow = 0.f;
    const int kt_lo = WIN ? (q0 >= 128 ? (q0 - 128) / 64 : 0) : 0, kt_hi = (q0 + 255) / 64, ntile = kt_hi - kt_lo + 1;
    const int k0r = tid / KC, k0c = tid % KC, k1r = (tid + 512) / KC, k1c = (tid + 512) % KC; const bool k1v = (tid + 512) < KCH;
    const int vkey = tid >> 3, vdc = tid & 7;
    u32x4 kreg0, kreg1 = (u32x4){0u, 0u, 0u, 0u}, vreg;
    { const size_t kb = (size_t)kt_lo * 64;
      kreg0 = *(const u32x4*)(Kb + (kb + k0r) * ks + k0c * 8); if (k1v) kreg1 = *(const u32x4*)(Kb + (kb + k1r) * ks + k1c * 8);
      vreg = *(const u32x4*)(Vb + (kb + vkey) * vs + vdc * 8); }
    for (int it = 0; it < ntile; ++it) {
        const int kbase = (kt_lo + it) * 64;
        __syncthreads();
        *(u32x4*)(Ks + k0r * KLD + k0c * 8) = kreg0; if (k1v) *(u32x4*)(Ks + k1r * KLD + k1c * 8) = kreg1;
        { bf16_t* vp = Vt + (vdc * 8) * VLD + vkey;
          vp[0 * VLD] = (bf16_t)(vreg.x & 0xffffu); vp[1 * VLD] = (bf16_t)(vreg.x >> 16); vp[2 * VLD] = (bf16_t)(vreg.y & 0xffffu); vp[3 * VLD] = (bf16_t)(vreg.y >> 16);
          vp[4 * VLD] = (bf16_t)(vreg.z & 0xffffu); vp[5 * VLD] = (bf16_t)(vreg.z >> 16); vp[6 * VLD] = (bf16_t)(vreg.w & 0xffffu); vp[7 * VLD] = (bf16_t)(vreg.w >> 16); }
        __syncthreads();
        if (it + 1 < ntile) { const size_t kb = (size_t)kbase + 64;
            kreg0 = *(const u32x4*)(Kb + (kb + k0r) * ks + k0c * 8); if (k1v) kreg1 = *(const u32x4*)(Kb + (kb + k1r) * ks + k1c * 8);
            vreg = *(const u32x4*)(Vb + (kb + vkey) * vs + vdc * 8); }
        const bool active = (kbase <= qw + 31) && (!WIN || kbase + 63 >= qw - 128);
        if (active) {
            f32x16 x[2];
#pragma unroll
            for (int kt2 = 0; kt2 < 2; ++kt2) {
#pragma unroll
                for (int i = 0; i < 16; ++i) x[kt2][i] = 0.f;
#pragma unroll
                for (int s = 0; s < DK / 16; ++s) { const bf16x8 a = *(const bf16x8*)(Ks + (kt2 * 32 + r) * KLD + 16 * s + 8 * h); x[kt2] = MFMA32(a, qf[s], x[kt2]); } }
            const int qi = qw + r; float tmax = -INFINITY;
#pragma unroll
            for (int kt2 = 0; kt2 < 2; ++kt2)
#pragma unroll
                for (int i = 0; i < 16; ++i) { const int key = kbase + kt2 * 32 + crow(i, h); const bool ok = (key <= qi) && (!WIN || key >= qi - 128);
                    const float v = ok ? x[kt2][i] : -INFINITY; x[kt2][i] = v; tmax = fmaxf(tmax, v); }
            tmax = fmaxf(tmax, __shfl_xor(tmax, 32));
            const float mnew = fmaxf(mrow, tmax), alpha = __builtin_amdgcn_exp2f(mrow - mnew); float rsum = 0.f;
#pragma unroll
            for (int kt2 = 0; kt2 < 2; ++kt2)
#pragma unroll
                for (int i = 0; i < 16; ++i) { const float p = __builtin_amdgcn_exp2f(x[kt2][i] - mnew); x[kt2][i] = p; rsum += p; }
            rsum += __shfl_xor(rsum, 32);
            lrow = lrow * alpha + rsum; mrow = mnew;
#pragma unroll
            for (int i = 0; i < 16; ++i) { o[0][i] *= alpha; o[1][i] *= alpha; }
#pragma unroll
            for (int kt2 = 0; kt2 < 2; ++kt2)
#pragma unroll
                for (int s = 0; s < 2; ++s) {
                    u32x4 pw; pw.x = pk2(x[kt2][8 * s + 0], x[kt2][8 * s + 1]); pw.y = pk2(x[kt2][8 * s + 2], x[kt2][8 * s + 3]); pw.z = pk2(x[kt2][8 * s + 4], x[kt2][8 * s + 5]); pw.w = pk2(x[kt2][8 * s + 6], x[kt2][8 * s + 7]);
                    const bf16x8 pb = __builtin_bit_cast(bf16x8, pw);
#pragma unroll
                    for (int n = 0; n < 2; ++n) { const bf16_t* vp = Vt + (n * 32 + r) * VLD + kt2 * 32 + 16 * s + 4 * h;
                        const u32x2 lo = *(const u32x2*)vp, hi = *(const u32x2*)(vp + 8); const u32x4 av = (u32x4){lo.x, lo.y, hi.x, hi.y};
                        o[n] = MFMA32(__builtin_bit_cast(bf16x8, av), pb, o[n]); } }
        }
    }
    const float inv = 1.f / lrow; const size_t orow = (size_t)(qw + r) * os;
#pragma unroll
    for (int n = 0; n < 2; ++n)
#pragma unroll
        for (int g4 = 0; g4 < 4; ++g4) { const int dv = n * 32 + g4 * 8 + 4 * h; bf16_t* op = Ob + orow + dv;
            float e0 = o[n][g4 * 4] * inv, e1 = o[n][g4 * 4 + 1] * inv, e2 = o[n][g4 * 4 + 2] * inv, e3 = o[n][g4 * 4 + 3] * inv;
            if (MLA) { const u32x2 g = *(const u32x2*)op; e0 *= siluf_(bflo(g.x)); e1 *= siluf_(bfhi(g.x)); e2 *= siluf_(bflo(g.y)); e3 *= siluf_(bfhi(g.y)); }
            u32x2 w; w.x = pk2(e0, e1); w.y = pk2(e2, e3); *(u32x2*)op = w; }
    if (!MLA) { if (h == 0) lsep[(size_t)(qw + r) * lses] = (mrow + __log2f(lrow)) * LN2; }
}

__global__ void __launch_bounds__(512, 2) hybrid_fwd(Args a) {
    extern __shared__ __attribute__((aligned(16))) unsigned char lds_raw[];
    cg::grid_group grid = cg::this_grid();
    unsigned char* lds = lds_raw; PG8_LAS unsigned char* ldsl = (PG8_LAS unsigned char*)lds_raw;
    const int G = gridDim.x;
#define bx obid()
    unsigned char* ws = a.ws;
    bf16_t* z = (bf16_t*)(ws + WS_Z); unsigned char* sc = ws + WS_S;
    bf16_t* xn = (bf16_t*)(sc + S_XN); bf16_t* qf = (bf16_t*)(sc + S_QF); bf16_t* kvr = qf + 768; bf16_t* kf = (bf16_t*)(sc + S_KF);
    float* agg = (float*)(sc + S_AGG); float* lse = (float*)(sc + S_LSE); float* mrg = (float*)(sc + S_MRG); bf16_t* mb = (bf16_t*)(sc + S_MB);
    const int* positions = (const int*)a.in[1];

    prologue_weights(a, lds);
#pragma unroll 1
    for (int l = 0; l < DEPTH; ++l) {
        const unsigned char* wl = ws + WS_W + (size_t)l * WL_SIZE;
#pragma unroll 1
        for (int c = 0; c < NCHUNK; ++c) {
            const size_t roff = (size_t)c * TC;
            const float* xin = (l == 0 ? a.in[0] : a.out) + roff * DM; float* xout = a.out + roff * DM; const int* pos = positions + roff;
            p0_rmsnorm(xin, a.in[2] + l * DM, xn);
            grid.sync();
            { pg8::Gemm g; g.A = xn; g.Bt = (const bf16_t*)(wl + WL_IN); g.M = TC; g.N = NZP; g.K = DM; g.lda = DM;
              pg8::StaticOrder S; S.init(TC, NZP, G, bx); EpiZ E; E.O = z; E.ldc = LDZ; E.ncols = INW;
              pg8::gemm_phase<EpiZ, pg8::StaticOrder, true, true>(ldsl, g, S, E); }
            grid.sync();
            { pg8::Gemm g; g.A = z + C_CQ; g.Bt = (const bf16_t*)(wl + WL_UP); g.M = TC; g.N = NUP; g.K = KUP; g.lda = LDZ;
              pg8::StaticOrder S; S.init(TC, NUP, G, bx); EpiZ E; E.O = qf; E.ldc = LDQ; E.ncols = NUP;
              pg8::gemm_phase<EpiZ, pg8::StaticOrder, true, true>(ldsl, g, S, E); }
            __syncthreads();
            dil_prep(z, pos, a.in[19] + l * 64, a.in[20] + l * 64);
            LruP lp; lp.conv_w = a.in[4] + (size_t)l * 4 * 1024; lp.conv_b = a.in[5] + l * 1024; lp.b_gx = a.in[7] + l * 1024; lp.b_ga = a.in[9] + l * 1024; lp.lam = a.in[10] + l * 1024;
            lp.wgx = (const bf16_t*)(wl + WL_GX); lp.wga = (const bf16_t*)(wl + WL_GA);
            for (int u = bx; u < NB * 512; u += G) lru_unit<false>(lds, z, agg, lp, u >> 9, (u & 511) >> 3, u & 7);
            grid.sync();
            mla_finalize(lds, z, qf, kvr, kf, pos, a.in[16] + l * 96, a.in[17] + l * 96);
            grid.sync();
            for (int u = bx; u < 512 + NB * 384; u += G) {
                if (u < 512) {
                    int qb, bh; if (u < 256) { qb = 15 - (u >> 5); bh = u & 31; } else { qb = (u - 256) >> 5; bh = (u - 256) & 31; }
                    const int bl = bh >> 3, hd = bh & 7; const size_t t0 = (size_t)bl * SEQ;
                    attn_unit<96, false, true>(lds, qf + t0 * LDQ + hd * 96, LDQ, kf + t0 * 768 + hd * 96, 768, kvr + t0 * LDQ + hd * 128 + 64, LDQ, qb * 256,
                                               z + t0 * LDZ + C_MLAG + hd * 64, LDZ, nullptr, 0);
                } else {
                    const int v = u - 512, bl = v / 384, w = v % 384, gi = w >> 7, w2 = w & 127, hd = w2 >> 4, rem = w2 & 15;
                    const int d = 1 << (2 * gi), npairs = 16 >> (2 * gi), r = rem / npairs, pair = rem % npairs, head = gi * 8 + hd;
                    const size_t brow = (size_t)bl * SEQ + r; bf16_t* zb = z + brow * LDZ + head * 64; const size_t st = (size_t)d * LDZ;
                    attn_unit<64, true, false>(lds, zb + C_DQ, st, zb + C_DK, st, zb + C_DV, st, pair * 256, zb + C_DQ, st, lse + (size_t)gi * TC * 8 + brow * 8 + hd, (size_t)d * 8);
                }
            }
            grid.sync();
            dil_combine(z, lse);
            for (int u = bx; u < NB * 512; u += G) lru_unit<true>(lds, z, agg, lp, u >> 9, (u & 511) >> 3, u & 7);
            grid.sync();
            { pg8::StaticOrder S; S.init(TC, DM, G, bx); const float* bm = a.in[22] + (size_t)l * 3072;
              { pg8::Gemm g; g.A = z + C_LRUG; g.Bt = (const bf16_t*)(wl + WL_PLRU); g.M = TC; g.N = DM; g.K = 1024; g.lda = LDZ;
                EpiMerge<0> E; E.Z = z; E.bm = bm; E.MRG = mrg; E.MB = mb; pg8::gemm_phase<EpiMerge<0>, pg8::StaticOrder, true, true>(ldsl, g, S, E); }
              { pg8::Gemm g; g.A = z + C_MLAG; g.Bt = (const bf16_t*)(wl + WL_PMLA); g.M = TC; g.N = DM; g.K = 512; g.lda = LDZ;
                EpiMerge<1> E; E.Z = z; E.bm = bm; E.MRG = mrg; E.MB = mb; pg8::gemm_phase<EpiMerge<1>, pg8::StaticOrder, true, true>(ldsl, g, S, E); }
              { pg8::Gemm g; g.A = z + C_DILG; g.Bt = (const bf16_t*)(wl + WL_PDIL); g.M = TC; g.N = DM; g.K = 512; g.lda = LDZ;
                EpiMerge<2> E; E.Z = z; E.bm = bm; E.MRG = mrg; E.MB = mb; pg8::gemm_phase<EpiMerge<2>, pg8::StaticOrder, true, true>(ldsl, g, S, E); } }
            grid.sync();
            { pg8::Gemm g; g.A = mb; g.Bt = (const bf16_t*)(wl + WL_OUT); g.M = TC; g.N = DM; g.K = DM; g.lda = DM;
              pg8::StaticOrder S; S.init(TC, DM, G, bx); EpiOut E; E.X = xin; E.O = xout;
              pg8::gemm_phase<EpiOut, pg8::StaticOrder, true, true>(ldsl, g, S, E); }
            __syncthreads();
        }
    }
}

extern "C" void kernel_launch(void* const* d_in, const int* in_sizes, int n_in, void* d_out, int out_size, void* d_ws, size_t ws_size, hipStream_t stream) {
    static int grid_blocks = 0;
    if (!grid_blocks) {
        int dev = 0, cus = 0, per_cu = 0;
        (void)hipGetDevice(&dev);
        (void)hipDeviceGetAttribute(&cus, hipDeviceAttributeMultiprocessorCount, dev);
        if (hipFuncSetAttribute((const void*)hybrid_fwd, hipFuncAttributeMaxDynamicSharedMemorySize, LDS_BYTES) != hipSuccess) fprintf(stderr, "hipFuncSetAttribute failed\n");
        if (hipOccupancyMaxActiveBlocksPerMultiprocessor(&per_cu, (const void*)hybrid_fwd, 512, LDS_BYTES) != hipSuccess || per_cu < 1) per_cu = 1;
        grid_blocks = cus * 1;
        if (ws_size < WS_NEED) fprintf(stderr, "workspace too small: %zu < %zu\n", ws_size, (size_t)WS_NEED);
    }
    if (ws_size < WS_NEED || n_in < 24) return;
    Args a{};
    for (int i = 0; i < 24; ++i) a.in[i] = (const float*)d_in[i];
    a.out = (float*)d_out; a.ws = (unsigned char*)d_ws;
    void* args[] = {&a};
    hipError_t e = hipLaunchCooperativeKernel((const void*)hybrid_fwd, dim3(grid_blocks), dim3(512), args, LDS_BYTES, stream);
    if (e != hipSuccess) fprintf(stderr, "cooperative launch failed: %s (grid %d)\n", hipGetErrorString(e), grid_blocks);
}
```

```cpp
#include <hip/hip_runtime.h>
#include <hip/hip_cooperative_groups.h>
#include <cstdio>
#include <cstdint>
namespace cg = cooperative_groups;
__device__ __forceinline__ int otid() { int t = threadIdx.x; asm volatile("" : "+v"(t)); return t; }
__device__ __forceinline__ int obid() { int b = blockIdx.x; asm volatile("" : "+s"(b)); return b; }
namespace pg8 {
#define PG8_LAS __attribute__((address_space(3)))
typedef unsigned short bf16_t;
typedef short bf16x8 __attribute__((ext_vector_type(8)));
typedef float f32x4 __attribute__((ext_vector_type(4)));
typedef unsigned u32x4 __attribute__((ext_vector_type(4)));
constexpr int BM = 256, BK = 64, HALF = 128, HTB = HALF * BK * 2  , STAGE_BYTES = 8 * HTB, NXCD = 8, WGM = 8;

__host__ __device__ __forceinline__ int lds_byte(int r, int c) { const int st = (r >> 4) * 2 + (c >> 5), rr = r & 15, cc = c & 31, ob = rr * 64 + cc * 2; return st * 1024 + (ob ^ (((ob >> 9) & 1) << 5)); }
__host__ __device__ __forceinline__ void stage_rc(int b, int& R, int& C) { const int st = b / 1024, sb = b % 1024, swz = sb ^ (((sb >> 9) & 1) << 5); R = (st >> 1) * 16 + swz / 64; C = (st & 1) * 32 + (swz % 64) / 2; }
__host__ __device__ __forceinline__ int perm32(int rho) { const int n = rho >> 4, i = rho & 15; return 8 * (i >> 2) + 4 * n + (i & 3); }

struct Unit { int pm, pn; };
struct Gemm { const bf16_t* A; const bf16_t* Bt; int M, N, K, lda; };

struct StaticOrder {
    int nM, nN, nwg, G, c;
    __host__ __device__ void init(int M, int N, int G_, int c_) { nM = M / BM; nN = N / BM; nwg = nM * nN; G = G_; c = c_; }
    __host__ __device__ bool next(int i, Unit& u) const {
        const long L = (long)i * G + c; if (L >= nwg) return false;
        int wgid = (int)L; { const int q = nwg / NXCD, r = nwg % NXCD, xcd = wgid % NXCD, off = wgid / NXCD; wgid = (xcd < r ? xcd * (q + 1) : r * (q + 1) + (xcd - r) * q) + off; }
        const int nig = WGM * nN, gid = wgid / nig, fm = gid * WGM, gsz = (nM - fm) < WGM ? (nM - fm) : WGM;
        u.pm = fm + ((wgid % nig) % gsz); u.pn = (wgid % nig) / gsz; return true;
    }
    __device__ __forceinline__ void a_ready(const Unit&) const {}
    __device__ __forceinline__ void done(const Unit&) const {}
};
__device__ __forceinline__ unsigned cvt_pk_bf16(float lo, float hi) { unsigned r; asm volatile("v_cvt_pk_bf16_f32 %0, %1, %2" : "=v"(r) : "v"(lo), "v"(hi)); return r; }
template <class Epi, class Sched, bool ALIGN_EPI = false, bool SP2 = false>
__device__ __forceinline__ void gemm_phase(PG8_LAS unsigned char* lds, const Gemm g, const Sched& S, const Epi& E) {
    const int tid = otid(), wid = __builtin_amdgcn_readfirstlane(tid >> 6), lane = tid & 63, wr = wid >> 2, wc = wid & 3, fr = lane & 15, fq = lane >> 4;
    const int K = g.K, nt = K / BK;
    unsigned voffA[2], voffB[2];
#pragma unroll
    for (int i = 0; i < 2; ++i) { int R, C; stage_rc(tid * 16 + i * 8192, R, C); const int Rb = Epi::PERM ? ((R & ~31) + perm32(R & 31)) : R;
        voffA[i] = (unsigned)(R * g.lda + C) * 2u; voffB[i] = (unsigned)(Rb * K + C) * 2u; }
    const size_t kstep = (size_t)(BK * 2);
    const size_t hstepA = (size_t)HALF * g.lda * 2, hstepB = (size_t)HALF * K * 2;
    const size_t tstepA = 2 * hstepA, tstepB = 2 * hstepB;
    const unsigned ldsw = (unsigned)wid * 1024u;
    const int aoff = lds_byte(wr * 64 + fr, fq * 8), boff = lds_byte(wc * 32 + fr, fq * 8);
#define PG8_SA(b, h) (((b) * 2 + (h)) * HTB)
#define PG8_SB(b, h) ((4 + (b) * 2 + (h)) * HTB)
#define PG8_STAGE(bufoff, gbase, voff) do { _Pragma("unroll") for (int _i = 0; _i < 2; ++_i) \
        __builtin_amdgcn_global_load_lds((const unsigned*)((const char*)(gbase) + (voff)[_i]), (PG8_LAS unsigned*)(lds + (bufoff) + ldsw + _i * 8192), 16, 0, 0); } while (0)
#define PG8_LDA(dst, b, h) do { _Pragma("unroll") for (int m = 0; m < 4; ++m) _Pragma("unroll") for (int k = 0; k < 2; ++k) dst[m][k] = *(const PG8_LAS bf16x8*)(lds + PG8_SA(b, h) + aoff + m * 2048 + k * 1024); } while (0)
#define PG8_LDB(dst, b, h) do { _Pragma("unroll") for (int n = 0; n < 2; ++n) _Pragma("unroll") for (int k = 0; k < 2; ++k) dst[n][k] = *(const PG8_LAS bf16x8*)(lds + PG8_SB(b, h) + boff + n * 2048 + k * 1024); } while (0)
#define PG8_MMA(ai, bj, At, Bt) do { __builtin_amdgcn_s_setprio(1); _Pragma("unroll") for (int m = 0; m < 4; ++m) _Pragma("unroll") for (int n = 0; n < 2; ++n) _Pragma("unroll") for (int k = 0; k < 2; ++k) \
        acc[ai][bj][m][n] = __builtin_amdgcn_mfma_f32_16x16x32_bf16(Bt[n][k], At[m][k], acc[ai][bj][m][n], 0, 0, 0); __builtin_amdgcn_s_setprio(0); } while (0)
#define PG8_WAIT_V(n) asm volatile("s_waitcnt vmcnt(" #n ")" ::: "memory")
#define PG8_WAIT_L(n) asm volatile("s_waitcnt lgkmcnt(" #n ")" ::: "memory")
#define PG8_BAR __builtin_amdgcn_s_barrier()
#define PG8_SCHED __builtin_amdgcn_sched_barrier(0)
    Unit cur, nxt; int ui = 0;
    if (!S.next(0, cur)) return;
    f32x4 acc[2][2][4][2];
#pragma unroll
    for (int a = 0; a < 2; ++a)
#pragma unroll
        for (int b = 0; b < 2; ++b)
#pragma unroll
            for (int m = 0; m < 4; ++m)
#pragma unroll
                for (int n = 0; n < 2; ++n) acc[a][b][m][n] = (f32x4){0.f, 0.f, 0.f, 0.f};
    bf16x8 At[4][2], B0[2][2], B1[2][2];
    const char* cA = (const char*)g.A + (size_t)cur.pm * tstepA; const char* cB = (const char*)g.Bt + (size_t)cur.pn * tstepB;
    S.a_ready(cur);
    if constexpr (SP2) {
        PG8_STAGE(PG8_SB(0, 0), cB, voffB); PG8_STAGE(PG8_SB(0, 1), cB + hstepB, voffB); PG8_STAGE(PG8_SA(0, 0), cA, voffA); PG8_STAGE(PG8_SA(0, 1), cA + hstepA, voffA);
        if (wr == 1) PG8_BAR;
        PG8_WAIT_V(2); PG8_BAR;
        PG8_STAGE(PG8_SB(1, 0), cB + kstep, voffB); PG8_STAGE(PG8_SA(1, 0), cA + kstep, voffA); PG8_STAGE(PG8_SB(1, 1), cB + hstepB + kstep, voffB);
        PG8_WAIT_V(6); PG8_BAR;
    } else {
        PG8_STAGE(PG8_SB(0, 0), cB, voffB); PG8_STAGE(PG8_SA(0, 0), cA, voffA); PG8_STAGE(PG8_SB(0, 1), cB + hstepB, voffB); PG8_STAGE(PG8_SA(0, 1), cA + hstepA, voffA);
        if (wr == 1) PG8_BAR;
        PG8_WAIT_V(4); PG8_BAR;
        PG8_STAGE(PG8_SB(1, 0), cB + kstep, voffB); PG8_STAGE(PG8_SA(1, 0), cA + kstep, voffA); PG8_STAGE(PG8_SB(1, 1), cB + hstepB + kstep, voffB);
        PG8_WAIT_V(6); PG8_BAR;
    }
    for (;;) {
        const bool has_next = S.next(ui + 1, nxt);
        const char* nA = has_next ? (const char*)g.A + (size_t)nxt.pm * tstepA : cA; const char* nB = has_next ? (const char*)g.Bt + (size_t)nxt.pn * tstepB : cB;
        for (int t = 0; t < nt; t += 2) {
            const bool last = (t == nt - 2);
            const char* a1 = cA + (size_t)(t + 1) * kstep;
            const char* a2 = last ? nA : cA + (size_t)(t + 2) * kstep; const char* b2 = last ? nB : cB + (size_t)(t + 2) * kstep;
            const char* a3 = a2 + kstep; const char* b3 = b2 + kstep;
            if (last && has_next) S.a_ready(nxt);
            if constexpr (SP2) {
            PG8_LDB(B0, 0, 0); PG8_LDB(B1, 0, 1); PG8_SCHED; PG8_LDA(At, 0, 0); PG8_STAGE(PG8_SA(1, 1), a1 + hstepA, voffA);
            PG8_WAIT_V(8); PG8_WAIT_L(0); PG8_BAR; PG8_MMA(0, 0, At, B0); PG8_MMA(0, 1, At, B1); PG8_BAR; PG8_SCHED;
            PG8_LDA(At, 0, 1); PG8_STAGE(PG8_SB(0, 0), b2, voffB); PG8_STAGE(PG8_SB(0, 1), b2 + hstepB, voffB); PG8_STAGE(PG8_SA(0, 0), a2, voffA);
            PG8_WAIT_V(8); PG8_WAIT_L(0); PG8_BAR; PG8_MMA(1, 0, At, B0); PG8_MMA(1, 1, At, B1); PG8_BAR; PG8_SCHED;
            PG8_LDB(B0, 1, 0); PG8_LDB(B1, 1, 1); PG8_SCHED; PG8_LDA(At, 1, 0); PG8_STAGE(PG8_SA(0, 1), a2 + hstepA, voffA);
            PG8_WAIT_V(8); PG8_WAIT_L(0); PG8_BAR; PG8_MMA(0, 0, At, B0); PG8_MMA(0, 1, At, B1); PG8_BAR; PG8_SCHED;
            PG8_LDA(At, 1, 1); PG8_STAGE(PG8_SB(1, 0), b3, voffB); PG8_STAGE(PG8_SB(1, 1), b3 + hstepB, voffB); PG8_STAGE(PG8_SA(1, 0), a3, voffA);
            PG8_WAIT_V(8); PG8_WAIT_L(0); PG8_BAR; PG8_MMA(1, 0, At, B0); PG8_MMA(1, 1, At, B1); PG8_BAR; PG8_SCHED;
            } else {
            PG8_LDB(B0, 0, 0); PG8_SCHED; PG8_LDA(At, 0, 0); PG8_STAGE(PG8_SA(1, 1), a1 + hstepA, voffA);
            PG8_WAIT_L(8); PG8_BAR; PG8_WAIT_L(0); PG8_MMA(0, 0, At, B0); PG8_BAR; PG8_SCHED;
            PG8_LDB(B1, 0, 1); PG8_STAGE(PG8_SB(0, 0), b2, voffB);
            PG8_BAR; PG8_WAIT_L(0); PG8_MMA(0, 1, At, B1); PG8_BAR;
            PG8_LDA(At, 0, 1); PG8_STAGE(PG8_SA(0, 0), a2, voffA);
            PG8_BAR; PG8_WAIT_L(0); PG8_MMA(1, 0, At, B0); PG8_BAR; PG8_SCHED;
            PG8_STAGE(PG8_SB(0, 1), b2 + hstepB, voffB);
            PG8_WAIT_V(6); PG8_BAR; PG8_MMA(1, 1, At, B1); PG8_BAR;
            PG8_LDB(B0, 1, 0); PG8_SCHED; PG8_LDA(At, 1, 0); PG8_STAGE(PG8_SA(0, 1), a2 + hstepA, voffA);
            PG8_WAIT_L(8); PG8_BAR; PG8_WAIT_L(0); PG8_MMA(0, 0, At, B0); PG8_BAR; PG8_SCHED;
            PG8_LDB(B1, 1, 1); PG8_STAGE(PG8_SB(1, 0), b3, voffB);
            PG8_BAR; PG8_WAIT_L(0); PG8_MMA(0, 1, At, B1); PG8_BAR;
            PG8_LDA(At, 1, 1); PG8_STAGE(PG8_SA(1, 0), a3, voffA);
            PG8_BAR; PG8_WAIT_L(0); PG8_MMA(1, 0, At, B0); PG8_BAR; PG8_SCHED;
            PG8_STAGE(PG8_SB(1, 1), b3 + hstepB, voffB);
            PG8_WAIT_V(6); PG8_BAR; PG8_MMA(1, 1, At, B1); PG8_BAR;
            }
        }
        if constexpr (ALIGN_EPI) { if (wr == 0) PG8_BAR; }
        if constexpr (!Epi::AFTER_DRAIN) { E(acc, cur, wr, wc, fr, fq); S.done(cur); }
        if (!has_next) break;
#pragma unroll
        for (int a = 0; a < 2; ++a)
#pragma unroll
            for (int b = 0; b < 2; ++b)
#pragma unroll
                for (int m = 0; m < 4; ++m)
#pragma unroll
                    for (int n = 0; n < 2; ++n) acc[a][b][m][n] = (f32x4){0.f, 0.f, 0.f, 0.f};
        cur = nxt; cA = nA; cB = nB; ++ui;
        if constexpr (ALIGN_EPI) { if (wr == 1) PG8_BAR; }
    }
    PG8_WAIT_V(0);
    if constexpr (!ALIGN_EPI) { if (wr == 0) PG8_BAR; }
    PG8_BAR;
    if constexpr (Epi::AFTER_DRAIN) { E.fused(acc, cur, wr, wc, fr, fq, lds, wid, lane); S.done(cur); }
#undef PG8_SA
#undef PG8_SB
#undef PG8_STAGE
#undef PG8_LDA
#undef PG8_LDB
#undef PG8_MMA
#undef PG8_WAIT_V
#undef PG8_WAIT_L
#undef PG8_BAR
#undef PG8_SCHED
}
}

typedef unsigned short bf16_t;
using pg8::bf16x8; using pg8::f32x4; using pg8::u32x4;
typedef float f32x16 __attribute__((ext_vector_type(16)));
typedef unsigned u32x2 __attribute__((ext_vector_type(2)));
#define DI __device__ __forceinline__
#define MFMA32(a, b, c) __builtin_amdgcn_mfma_f32_32x32x16_bf16((a), (b), (c), 0, 0, 0)

constexpr int SEQ = 4096, BATCH = 8, DM = 1024, DEPTH = 2;
constexpr int NB = 4, TC = NB * SEQ, NCHUNK = BATCH / NB;
constexpr int INW = 11168, LDZ = 11168, NZP = 11264;
constexpr int C_LRUX = 0, C_LRUG = 1024, C_MLAG = 2048, C_DILG = 2560, C_DQ = 3072, C_DK = 4608, C_DV = 6144, C_MERGE = 7680, C_CQ = 10752, C_CKV = 11008, C_KR = 11136;
constexpr float EPS = 1e-6f, LOG2E = 1.4426950408889634f, LN2 = 0.6931471805599453f, LOG2_THETA = 13.287712379549449f;
constexpr int NUP = 1792, KUP = 384;

constexpr size_t W_IN_B = (size_t)NZP * DM * 2, W_UP_B = (size_t)NUP * KUP * 2, W_SQ_B = (size_t)DM * DM * 2, W_HF_B = (size_t)DM * 512 * 2, W_G_B = (size_t)8 * 128 * 128 * 2;
constexpr size_t WL_IN = 0, WL_UP = WL_IN + W_IN_B, WL_PLRU = WL_UP + W_UP_B, WL_PMLA = WL_PLRU + W_SQ_B, WL_PDIL = WL_PMLA + W_HF_B, WL_OUT = WL_PDIL + W_HF_B,
                 WL_GX = WL_OUT + W_SQ_B, WL_GA = WL_GX + W_G_B, WL_SIZE = WL_GA + W_G_B;
constexpr size_t WS_W = 0, WS_Z = WS_W + 2 * WL_SIZE, WS_S = WS_Z + (size_t)TC * LDZ * 2;
constexpr size_t S_XN = 0;
constexpr int LDQ = 1792;
constexpr size_t S_QF = 0, S_KF = S_QF + (size_t)TC * LDQ * 2, S_AGG = S_KF + (size_t)TC * 768 * 2,
                 S_LSE = S_AGG + (size_t)(TC / 64) * 1024 * 8, S_P23_END = S_LSE + (size_t)3 * TC * 8 * 4;
constexpr size_t S_MRG = 0, S_MB = S_MRG + (size_t)TC * DM * 4, S_END = S_MB + (size_t)TC * DM * 2;
static_assert(S_P23_END <= S_END, "scratch");
constexpr size_t WS_CTL = WS_S + S_END;
constexpr size_t WS_NEED = WS_CTL + 256;
static_assert(WS_NEED <= 536870912ull, "workspace");
static_assert(WS_Z % 256 == 0 && WS_S % 256 == 0 && WL_SIZE % 256 == 0, "align");
constexpr int LDS_BYTES = 139264;

DI float bflo(unsigned w) { return __uint_as_float(w << 16); }
DI float bfhi(unsigned w) { return __uint_as_float(w & 0xffff0000u); }
DI unsigned pk2(float lo, float hi) { typedef float f2_t __attribute__((ext_vector_type(2))); typedef __bf16 b2_t __attribute__((ext_vector_type(2)));
    f2_t v = {lo, hi}; b2_t b = __builtin_convertvector(v, b2_t); return __builtin_bit_cast(unsigned, b); }
DI float sigmoidf_(float x) { return __builtin_amdgcn_rcpf(1.f + __builtin_amdgcn_exp2f(-LOG2E * x)); }
DI float siluf_(float x) { return x * sigmoidf_(x); }
DI float fexp_(float x) { return __builtin_amdgcn_exp2f(LOG2E * x); }
DI float wave_sum(float v) {
#pragma unroll
    for (int m = 1; m < 64; m <<= 1) v += __shfl_xor(v, m);
    return v; }
DI void lds_barrier() { asm volatile("s_waitcnt lgkmcnt(0)\n\ts_barrier" ::: "memory"); }
DI int crow(int i, int h) { return (i & 3) + 8 * (i >> 2) + 4 * h; }
DI void sincos_rev(float ang, float& s, float& c) { float rev = ang * 0.15915494309189535f; rev = rev - floorf(rev); s = __builtin_amdgcn_sinf(rev); c = __builtin_amdgcn_cosf(rev); }

struct Args { const float* in[24]; float* out; unsigned char* ws; };
#ifndef PROBE_K
#define PROBE_K (-1)
#endif
#define PSTAMP(k) do { if (PROBE_K >= 0) { const unsigned long long now_ = __builtin_amdgcn_s_memrealtime(); if ((k) == PROBE_K) tacc += now_ - tprev; tprev = now_; } } while (0)

DI void wconv_job(float* tl, const float* __restrict__ src, int lds_, int n0s, int nrows, int ncols, bf16_t* dst, int ldd, int n0d, int k0d, const float* __restrict__ scale) {
    const int tid = otid(), ntn = ncols / 32, ntk = nrows / 128, nt = ntn * ntk;
    for (int t = obid(); t < nt; t += gridDim.x) {
        const int tn = t % ntn, tk = t / ntn, k0 = tk * 128;
#pragma unroll
        for (int i = 0; i < 8; ++i) { const int kk = i * 16 + (tid >> 5), nn = tid & 31;
            float v = src[(size_t)(k0 + kk) * lds_ + n0s + tn * 32 + nn]; if (scale) v *= scale[k0 + kk]; tl[kk * 33 + nn] = v; }
        __syncthreads();
        { const int n = tid >> 4, kq = tid & 15; u32x4 w;
          w.x = pk2(tl[(kq * 8 + 0) * 33 + n], tl[(kq * 8 + 1) * 33 + n]); w.y = pk2(tl[(kq * 8 + 2) * 33 + n], tl[(kq * 8 + 3) * 33 + n]);
          w.z = pk2(tl[(kq * 8 + 4) * 33 + n], tl[(kq * 8 + 5) * 33 + n]); w.w = pk2(tl[(kq * 8 + 6) * 33 + n], tl[(kq * 8 + 7) * 33 + n]);
          *(u32x4*)(dst + (size_t)(n0d + tn * 32 + n) * ldd + k0d + k0 + kq * 8) = w; }
        __syncthreads();
    }
}
DI void zero_rect(bf16_t* dst, int ldd, int n0, int nn, int k0, int nk) {
    const int per = nk / 8, tot = nn * per;
    for (int i = obid() * 512 + otid(); i < tot; i += gridDim.x * 512) { const int n = i / per, c = i % per;
        *(u32x4*)(dst + (size_t)(n0 + n) * ldd + k0 + c * 8) = (u32x4){0u, 0u, 0u, 0u}; }
}
DI void prologue_weights(const Args& a, unsigned char* lds) {
    float* tl = (float*)lds;
    for (int l = 0; l < DEPTH; ++l) {
        unsigned char* wl = a.ws + WS_W + (size_t)l * WL_SIZE;
        bf16_t* win = (bf16_t*)(wl + WL_IN); const float* w_in = a.in[3] + (size_t)l * DM * INW;
        wconv_job(tl, w_in, INW, 0,    1024, 2048, win, DM, C_LRUX, 0, nullptr);
        wconv_job(tl, w_in, INW, 2464, 1024, 512,  win, DM, C_MLAG, 0, nullptr);
        wconv_job(tl, w_in, INW, 7584, 1024, 512,  win, DM, C_DILG, 0, nullptr);
        wconv_job(tl, w_in, INW, 2976, 1024, 4608, win, DM, C_DQ, 0, nullptr);
        wconv_job(tl, w_in, INW, 8096, 1024, 3072, win, DM, C_MERGE, 0, nullptr);
        wconv_job(tl, w_in, INW, 2048, 1024, 416,  win, DM, C_CQ, 0, nullptr);
        zero_rect(win, DM, INW, NZP - INW, 0, DM);
        bf16_t* wup = (bf16_t*)(wl + WL_UP);
        wconv_job(tl, a.in[14] + (size_t)l * 256 * 768, 768, 0, 256, 768, wup, KUP, 0, 0, a.in[12] + l * 256);
        wconv_job(tl, a.in[15] + (size_t)l * 128 * 1024, 1024, 0, 128, 1024, wup, KUP, 768, 256, a.in[13] + l * 128);
        zero_rect(wup, KUP, 0, 768, 256, 128); zero_rect(wup, KUP, 768, 1024, 0, 256);
        wconv_job(tl, a.in[11] + (size_t)l * DM * DM, DM, 0, 1024, 1024, (bf16_t*)(wl + WL_PLRU), 1024, 0, 0, nullptr);
        wconv_job(tl, a.in[18] + (size_t)l * 512 * DM, DM, 0, 512, 1024, (bf16_t*)(wl + WL_PMLA), 512, 0, 0, nullptr);
        wconv_job(tl, a.in[21] + (size_t)l * 512 * DM, DM, 0, 512, 1024, (bf16_t*)(wl + WL_PDIL), 512, 0, 0, nullptr);
        wconv_job(tl, a.in[23] + (size_t)l * DM * DM, DM, 0, 1024, 1024, (bf16_t*)(wl + WL_OUT), 1024, 0, 0, nullptr);
        for (int nb = 0; nb < 8; ++nb) {
            wconv_job(tl, a.in[6] + ((size_t)l * 8 + nb) * 128 * 128, 128, 0, 128, 128, (bf16_t*)(wl + WL_GX) + nb * 128 * 128, 128, 0, 0, nullptr);
            wconv_job(tl, a.in[8] + ((size_t)l * 8 + nb) * 128 * 128, 128, 0, 128, 128, (bf16_t*)(wl + WL_GA) + nb * 128 * 128, 128, 0, 0, nullptr);
        }
    }
}

DI void p0_rmsnorm(const float* __restrict__ x, const float* __restrict__ g, bf16_t* xn) {
    const int tid = otid(), lane = tid & 63, gw = obid() * 8 + (tid >> 6), nw = gridDim.x * 8;
    f32x4 gv[4];
#pragma unroll
    for (int i = 0; i < 4; ++i) gv[i] = *(const f32x4*)(g + i * 256 + lane * 4);
    for (int row = gw; row < TC; row += nw) {
        const float* xr = x + (size_t)row * DM; f32x4 v[4]; float ss = 0.f;
#pragma unroll
        for (int i = 0; i < 4; ++i) { v[i] = *(const f32x4*)(xr + i * 256 + lane * 4); ss += v[i][0] * v[i][0] + v[i][1] * v[i][1] + v[i][2] * v[i][2] + v[i][3] * v[i][3]; }
        ss = wave_sum(ss); const float rs = rsqrtf(ss * (1.f / DM) + EPS);
#pragma unroll
        for (int i = 0; i < 4; ++i) { u32x2 w; w.x = pk2(v[i][0] * rs * gv[i][0], v[i][1] * rs * gv[i][1]); w.y = pk2(v[i][2] * rs * gv[i][2], v[i][3] * rs * gv[i][3]);
            *(u32x2*)(xn + (size_t)row * DM + i * 256 + lane * 4) = w; }
    }
}

struct EpiZ {
    static constexpr bool PERM = true, AFTER_DRAIN = false;
    bf16_t* O; int ldc; int ncols;
    DI void operator()(const f32x4 (&acc)[2][2][4][2], const pg8::Unit& u, int wr, int wc, int fr, int fq) const {
        const int row0 = u.pm * 256 + wr * 64 + fr, col0 = u.pn * 256 + wc * 32 + 8 * fq;
#pragma unroll
        for (int ai = 0; ai < 2; ++ai)
#pragma unroll
            for (int m = 0; m < 4; ++m) { bf16_t* rowp = O + (size_t)(row0 + ai * 128 + m * 16) * ldc;
#pragma unroll
                for (int bj = 0; bj < 2; ++bj) { const int c = col0 + bj * 128; if (c < ncols) { const f32x4 v0 = acc[ai][bj][m][0], v1 = acc[ai][bj][m][1];
                    u32x4 w; w.x = pk2(v0[0], v0[1]); w.y = pk2(v0[2], v0[3]); w.z = pk2(v1[0], v1[1]); w.w = pk2(v1[2], v1[3]); *(u32x4*)(rowp + c) = w; } } }
    }
};
template <int BR> struct EpiMerge {
    static constexpr bool PERM = true, AFTER_DRAIN = false;
    const bf16_t* Z; const float* bm; float* MRG; bf16_t* MB;
    DI void operator()(const f32x4 (&acc)[2][2][4][2], const pg8::Unit& u, int wr, int wc, int fr, int fq) const {
        const int row0 = u.pm * 256 + wr * 64 + fr, col0 = u.pn * 256 + wc * 32 + 8 * fq;
#pragma unroll
        for (int bj = 0; bj < 2; ++bj) { const int c = col0 + bj * 128;
            const f32x4 b0 = *(const f32x4*)(bm + BR * 1024 + c), b1 = *(const f32x4*)(bm + BR * 1024 + c + 4);
#pragma unroll
            for (int ai = 0; ai < 2; ++ai)
#pragma unroll
                for (int m = 0; m < 4; ++m) { const size_t row = (size_t)(row0 + ai * 128 + m * 16);
                    const u32x4 gz = *(const u32x4*)(Z + row * LDZ + C_MERGE + BR * 1024 + c);
                    f32x4 g0, g1; g0[0] = sigmoidf_(bflo(gz.x) + b0[0]); g0[1] = sigmoidf_(bfhi(gz.x) + b0[1]); g0[2] = sigmoidf_(bflo(gz.y) + b0[2]); g0[3] = sigmoidf_(bfhi(gz.y) + b0[3]);
                    g1[0] = sigmoidf_(bflo(gz.z) + b1[0]); g1[1] = sigmoidf_(bfhi(gz.z) + b1[1]); g1[2] = sigmoidf_(bflo(gz.w) + b1[2]); g1[3] = sigmoidf_(bfhi(gz.w) + b1[3]);
                    f32x4 v0 = g0 * acc[ai][bj][m][0], v1 = g1 * acc[ai][bj][m][1];
                    float* mp = MRG + row * DM + c;
                    if (BR > 0) { v0 += *(const f32x4*)mp; v1 += *(const f32x4*)(mp + 4); }
                    if (BR < 2) { *(f32x4*)mp = v0; *(f32x4*)(mp + 4) = v1; }
                    else { u32x4 w; w.x = pk2(v0[0], v0[1]); w.y = pk2(v0[2], v0[3]); w.z = pk2(v1[0], v1[1]); w.w = pk2(v1[2], v1[3]); *(u32x4*)(MB + row * DM + c) = w; }
                    asm volatile("" ::: "memory"); } }
    }
};
struct EpiOut {
    static constexpr bool PERM = false, AFTER_DRAIN = false;
    const float* X; float* O;
    DI void operator()(const f32x4 (&acc)[2][2][4][2], const pg8::Unit& u, int wr, int wc, int fr, int fq) const {
        const int row0 = u.pm * 256 + wr * 64 + fr, col0 = u.pn * 256 + wc * 32 + 4 * fq;
#pragma unroll
        for (int ai = 0; ai < 2; ++ai)
#pragma unroll
            for (int m = 0; m < 4; ++m) { const size_t ro = (size_t)(row0 + ai * 128 + m * 16) * DM + col0;
#pragma unroll
                for (int bj = 0; bj < 2; ++bj)
#pragma unroll
                    for (int n = 0; n < 2; ++n) { const f32x4 xv = *(const f32x4*)(X + ro + bj * 128 + n * 16); *(f32x4*)(O + ro + bj * 128 + n * 16) = xv + acc[ai][bj][m][n]; } }
    }
};

DI void dil_prep(bf16_t* z, const int* __restrict__ pos, const float* __restrict__ gq, const float* __restrict__ gk) {
    const int tot = TC * 48;
    for (int it = obid() * 512 + otid(); it < tot; it += gridDim.x * 512) {
        const int tok = it / 48, hh = it % 48; const bool isq = hh < 24;
        bf16_t* p = z + (size_t)tok * LDZ + (isq ? C_DQ + hh * 64 : C_DK + (hh - 24) * 64);
        const float* g = isq ? gq : gk;
        float v[64]; float ss = 0.f;
#pragma unroll
        for (int c = 0; c < 8; ++c) { const u32x4 w = *(const u32x4*)(p + c * 8);
            v[c * 8 + 0] = bflo(w.x); v[c * 8 + 1] = bfhi(w.x); v[c * 8 + 2] = bflo(w.y); v[c * 8 + 3] = bfhi(w.y); v[c * 8 + 4] = bflo(w.z); v[c * 8 + 5] = bfhi(w.z); v[c * 8 + 6] = bflo(w.w); v[c * 8 + 7] = bfhi(w.w); }
#pragma unroll
        for (int i = 0; i < 64; ++i) ss += v[i] * v[i];
        const float rs = rsqrtf(ss * (1.f / 64.f) + EPS) * (isq ? 0.125f * LOG2E : 1.f);
        const float fp = (float)pos[tok];
#pragma unroll
        for (int i = 0; i < 32; ++i) { const float inv = exp2f(-(float)i * (LOG2_THETA / 32.f)); float s, c; sincos_rev(fp * inv, s, c);
            const float x1 = v[i] * rs * g[i], x2 = v[i + 32] * rs * g[i + 32]; v[i] = x1 * c - x2 * s; v[i + 32] = x2 * c + x1 * s; }
#pragma unroll
        for (int c = 0; c < 8; ++c) { u32x4 w; w.x = pk2(v[c * 8 + 0], v[c * 8 + 1]); w.y = pk2(v[c * 8 + 2], v[c * 8 + 3]); w.z = pk2(v[c * 8 + 4], v[c * 8 + 5]); w.w = pk2(v[c * 8 + 6], v[c * 8 + 7]);
            *(u32x4*)(p + c * 8) = w; }
    }
}

#define UNPK8(w, d, o, sc_) { d[o + 0] = bflo(w.x) * (sc_); d[o + 1] = bfhi(w.x) * (sc_); d[o + 2] = bflo(w.y) * (sc_); d[o + 3] = bfhi(w.y) * (sc_); d[o + 4] = bflo(w.z) * (sc_); d[o + 5] = bfhi(w.z) * (sc_); d[o + 6] = bflo(w.w) * (sc_); d[o + 7] = bfhi(w.w) * (sc_); }
DI float ssq8(u32x4 w) { return bflo(w.x) * bflo(w.x) + bfhi(w.x) * bfhi(w.x) + bflo(w.y) * bflo(w.y) + bfhi(w.y) * bfhi(w.y) + bflo(w.z) * bflo(w.z) + bfhi(w.z) * bfhi(w.z) + bflo(w.w) * bflo(w.w) + bfhi(w.w) * bfhi(w.w); }
DI u32x4 scale8(u32x4 w, float s, const float* __restrict__ g) { u32x4 o; o.x = pk2(bflo(w.x) * s * g[0], bfhi(w.x) * s * g[1]); o.y = pk2(bflo(w.y) * s * g[2], bfhi(w.y) * s * g[3]);
    o.z = pk2(bflo(w.z) * s * g[4], bfhi(w.z) * s * g[5]); o.w = pk2(bflo(w.w) * s * g[6], bfhi(w.w) * s * g[7]); return o; }
DI void mla_finalize(unsigned char* lds, const bf16_t* z, bf16_t* qf, bf16_t* kvr, bf16_t* kf, const int* __restrict__ pos, const float* __restrict__ gqn, const float* __restrict__ gkn) {
    float* rst = (float*)lds;
    const int tid = otid(), lane = tid & 63, wid = tid >> 6;
    for (int grp = obid(); grp < TC / 64; grp += gridDim.x) {
        const int t0 = grp * 64;
        __syncthreads();
        for (int i = 0; i < 8; ++i) { const int tok = t0 + wid * 8 + i; const bf16_t* zr = z + (size_t)tok * LDZ;
            const u32x2 a = *(const u32x2*)(zr + C_CQ + lane * 4); const unsigned b = *(const unsigned*)(zr + C_CKV + lane * 2);
            float s1 = bflo(a.x) * bflo(a.x) + bfhi(a.x) * bfhi(a.x) + bflo(a.y) * bflo(a.y) + bfhi(a.y) * bfhi(a.y), s2 = bflo(b) * bflo(b) + bfhi(b) * bfhi(b);
            s1 = wave_sum(s1); s2 = wave_sum(s2);
            if (lane == 0) { rst[(wid * 8 + i) * 2] = rsqrtf(s1 * (1.f / 256.f) + EPS); rst[(wid * 8 + i) * 2 + 1] = rsqrtf(s2 * (1.f / 128.f) + EPS); } }
        __syncthreads();
        const int tl_ = tid >> 3, hd = tid & 7, tok = t0 + tl_; const float rcq = rst[tl_ * 2], rckv = rst[tl_ * 2 + 1]; const float fp = (float)pos[tok];
        {
            bf16_t* p = qf + (size_t)tok * LDQ + hd * 96; float ss = 0.f;
#pragma unroll
            for (int c = 0; c < 12; ++c) ss += ssq8(*(const u32x4*)(p + c * 8));
            ss *= rcq * rcq;
            const float rs = rsqrtf(ss * (1.f / 96.f) + EPS) * rcq * (0.10206207261596575f * LOG2E);
#pragma unroll
            for (int c = 0; c < 8; ++c) { *(u32x4*)(p + c * 8) = scale8(*(const u32x4*)(p + c * 8), rs, gqn + c * 8); asm volatile("" ::: "memory"); }
            float v[32];
#pragma unroll
            for (int c = 0; c < 4; ++c) { const u32x4 w = *(const u32x4*)(p + 64 + c * 8); UNPK8(w, v, c * 8, rs) }
#pragma unroll
            for (int i = 0; i < 16; ++i) { const float inv = exp2f(-(float)i * (LOG2_THETA / 16.f)); float sn, cs; sincos_rev(fp * inv, sn, cs);
                const float x1 = v[i] * gqn[64 + i], x2 = v[16 + i] * gqn[80 + i]; v[i] = x1 * cs - x2 * sn; v[16 + i] = x2 * cs + x1 * sn; }
#pragma unroll
            for (int c = 0; c < 4; ++c) { u32x4 w; w.x = pk2(v[c * 8 + 0], v[c * 8 + 1]); w.y = pk2(v[c * 8 + 2], v[c * 8 + 3]); w.z = pk2(v[c * 8 + 4], v[c * 8 + 5]); w.w = pk2(v[c * 8 + 6], v[c * 8 + 7]);
                *(u32x4*)(p + 64 + c * 8) = w; }
        }
        asm volatile("" ::: "memory");
        {
            bf16_t* pkv = kvr + (size_t)tok * LDQ + hd * 128; const bf16_t* pkr = z + (size_t)tok * LDZ + C_KR; bf16_t* pk = kf + (size_t)tok * 768 + hd * 96; float ss = 0.f, sr = 0.f;
#pragma unroll
            for (int c = 0; c < 8; ++c) ss += ssq8(*(const u32x4*)(pkv + c * 8));
#pragma unroll
            for (int c = 0; c < 4; ++c) sr += ssq8(*(const u32x4*)(pkr + c * 8));
            ss = ss * rckv * rckv + sr;
            const float rs = rsqrtf(ss * (1.f / 96.f) + EPS);
#pragma unroll
            for (int c = 0; c < 8; ++c) { *(u32x4*)(pk + c * 8) = scale8(*(const u32x4*)(pkv + c * 8), rs * rckv, gkn + c * 8); asm volatile("" ::: "memory"); }
            float v[32];
#pragma unroll
            for (int c = 0; c < 4; ++c) { const u32x4 w = *(const u32x4*)(pkr + c * 8); UNPK8(w, v, c * 8, rs) }
#pragma unroll
            for (int i = 0; i < 16; ++i) { const float inv = exp2f(-(float)i * (LOG2_THETA / 16.f)); float sn, cs; sincos_rev(fp * inv, sn, cs);
                const float x1 = v[i] * gkn[64 + i], x2 = v[16 + i] * gkn[80 + i]; v[i] = x1 * cs - x2 * sn; v[16 + i] = x2 * cs + x1 * sn; }
#pragma unroll
            for (int c = 0; c < 4; ++c) { u32x4 w; w.x = pk2(v[c * 8 + 0], v[c * 8 + 1]); w.y = pk2(v[c * 8 + 2], v[c * 8 + 3]); w.z = pk2(v[c * 8 + 4], v[c * 8 + 5]); w.w = pk2(v[c * 8 + 6], v[c * 8 + 7]);
                *(u32x4*)(pk + 64 + c * 8) = w; }
#pragma unroll
            for (int c = 0; c < 8; ++c) { u32x4 w = *(const u32x4*)(pkv + 64 + c * 8);
                w.x = pk2(bflo(w.x) * rckv, bfhi(w.x) * rckv); w.y = pk2(bflo(w.y) * rckv, bfhi(w.y) * rckv); w.z = pk2(bflo(w.z) * rckv, bfhi(w.z) * rckv); w.w = pk2(bflo(w.w) * rckv, bfhi(w.w) * rckv);
                *(u32x4*)(pkv + 64 + c * 8) = w; }
        }
    }
}

DI void dil_combine(bf16_t* z, const float* __restrict__ lse) {
    const int tot = TC * 64;
    for (int it = obid() * 512 + otid(); it < tot; it += gridDim.x * 512) {
        const int tok = it >> 6, hd = (it >> 3) & 7, dc = it & 7;
        const float l0 = lse[(size_t)tok * 8 + hd], l1 = lse[(size_t)TC * 8 + (size_t)tok * 8 + hd], l2 = lse[(size_t)2 * TC * 8 + (size_t)tok * 8 + hd];
        const float mx = fmaxf(l0, fmaxf(l1, l2)); float w0 = fexp_(l0 - mx), w1 = fexp_(l1 - mx), w2 = fexp_(l2 - mx); const float iw = __builtin_amdgcn_rcpf(w0 + w1 + w2); w0 *= iw; w1 *= iw; w2 *= iw;
        bf16_t* zr = z + (size_t)tok * LDZ;
        const u32x4 a = *(const u32x4*)(zr + C_DQ + (0 * 8 + hd) * 64 + dc * 8), b = *(const u32x4*)(zr + C_DQ + (1 * 8 + hd) * 64 + dc * 8), c = *(const u32x4*)(zr + C_DQ + (2 * 8 + hd) * 64 + dc * 8);
        bf16_t* gp = zr + C_DILG + hd * 64 + dc * 8; const u32x4 g = *(const u32x4*)gp; u32x4 o;
#define CMB(F) { const float e0 = (w0 * bflo(a.F) + w1 * bflo(b.F) + w2 * bflo(c.F)) * siluf_(bflo(g.F)), e1 = (w0 * bfhi(a.F) + w1 * bfhi(b.F) + w2 * bfhi(c.F)) * siluf_(bfhi(g.F)); o.F = pk2(e0, e1); }
        CMB(x) CMB(y) CMB(z) CMB(w)
#undef CMB
        *(u32x4*)gp = o;
    }
}

struct LruP { const float* conv_w; const float* conv_b; const float* b_gx; const float* b_ga; const float* lam; const bf16_t* wgx; const bf16_t* wga; };
constexpr int L_XS = 0, L_XCB = 18432, L_XC = L_XCB + 17408, L_HB = L_XC + 32768, L_CW = L_HB + 32768, L_EX = L_CW + 5 * 128 * 4, L_END = L_EX + 2 * 128 * 8;
static_assert(L_END <= LDS_BYTES, "lru lds");
template <bool FINAL> DI void lru_unit(unsigned char* lds, bf16_t* z, float* agg, const LruP& P, int bl, int n, int grp) {
    const int tid0 = otid();
    bf16_t* xs = (bf16_t*)(lds + L_XS); bf16_t* xcb = (bf16_t*)(lds + L_XCB); float* xc = (float*)(lds + L_XC); float* hb = (float*)(lds + L_HB);
    float* cw = (float*)(lds + L_CW); float2* ex = (float2*)(lds + L_EX);
    __syncthreads();
    const int tid = tid0, lane = tid & 63, wid = tid >> 6, r = lane & 31, h = lane >> 5, ct = wid & 3, rt = wid >> 2;
    for (int i = tid; i < 640; i += 512) cw[i] = (i < 512) ? P.conv_w[(i >> 7) * 1024 + n * 128 + (i & 127)] : P.conv_b[n * 128 + (i & 127)];
    bf16x8 bx[8], ba[8];
    { const bf16_t* wx = P.wgx + (size_t)n * 16384 + (size_t)(ct * 32 + r) * 128 + 8 * h; const bf16_t* wa = P.wga + (size_t)n * 16384 + (size_t)(ct * 32 + r) * 128 + 8 * h;
#pragma unroll
      for (int s = 0; s < 8; ++s) { bx[s] = *(const bf16x8*)(wx + 16 * s); ba[s] = *(const bf16x8*)(wa + 16 * s); } }
    const int ch = ct * 32 + r, chg = n * 128 + ch; const float bgx = P.b_gx[chg], bga = P.b_ga[chg]; const float sp = __logf(1.f + __expf(-P.lam[chg]));
    float hrun = 0.f, Arun = 1.f;
    if (FINAL) {
#pragma unroll
        for (int g2 = 0; g2 < 7; ++g2) if (g2 < grp) { const float2 ab = *(const float2*)(agg + ((size_t)(bl * 8 + g2) * 1024 + chg) * 2); hrun = ab.x * hrun + ab.y; } }
    const size_t rowb = (size_t)bl * SEQ;
    u32x4 xr[3], gr[2];
#define LRU_XLOAD(J) { _Pragma("unroll") for (int q = 0; q < 3; ++q) { const int c = tid + q * 512; const int i = c >> 4, cc = c & 15; const int p = (J) * 64 - 3 + i; \
        xr[q] = (u32x4){0u, 0u, 0u, 0u}; if (c < 67 * 16 && p >= 0) xr[q] = *(const u32x4*)(z + (rowb + p) * LDZ + C_LRUX + n * 128 + cc * 8); } }
    LRU_XLOAD(grp * 8)
    __syncthreads();
#pragma unroll 1
    for (int jt = 0; jt < 8; ++jt) {
        int tq = tid0; asm volatile("" : "+v"(tq));
        const int tid = tq, lane = tid & 63, wid = tid >> 6, r = lane & 31, h = lane >> 5, ct = wid & 3, rt = wid >> 2, ch = ct * 32 + r;
        const int j = grp * 8 + jt; const size_t row0 = rowb + (size_t)j * 64;
#pragma unroll
        for (int q = 0; q < 3; ++q) { const int c = tid + q * 512; if (c < 67 * 16) *(u32x4*)(xs + (c >> 4) * 136 + (c & 15) * 8) = xr[q]; }
        lds_barrier();
        if (jt + 1 < 8) LRU_XLOAD(j + 1)
        if (FINAL) {
#pragma unroll
            for (int q = 0; q < 2; ++q) { const int c = tid + q * 512; gr[q] = *(const u32x4*)(z + (row0 + (c >> 4)) * LDZ + C_LRUG + n * 128 + (c & 15) * 8); } }
        {
            const int i = tid >> 3, c0 = (tid & 7) * 16; float acc[16];
#pragma unroll
            for (int q = 0; q < 4; ++q) { const f32x4 b = *(const f32x4*)(cw + 512 + c0 + q * 4); acc[q * 4] = b[0]; acc[q * 4 + 1] = b[1]; acc[q * 4 + 2] = b[2]; acc[q * 4 + 3] = b[3]; }
#pragma unroll
            for (int k = 0; k < 4; ++k) {
                const u32x4 xa = *(const u32x4*)(xs + (i + k) * 136 + c0), xb = *(const u32x4*)(xs + (i + k) * 136 + c0 + 8);
                const float xv[16] = {bflo(xa.x), bfhi(xa.x), bflo(xa.y), bfhi(xa.y), bflo(xa.z), bfhi(xa.z), bflo(xa.w), bfhi(xa.w), bflo(xb.x), bfhi(xb.x), bflo(xb.y), bfhi(xb.y), bflo(xb.z), bfhi(xb.z), bflo(xb.w), bfhi(xb.w)};
#pragma unroll
                for (int q = 0; q < 4; ++q) { const f32x4 w = *(const f32x4*)(cw + k * 128 + c0 + q * 4);
                    acc[q * 4] += w[0] * xv[q * 4]; acc[q * 4 + 1] += w[1] * xv[q * 4 + 1]; acc[q * 4 + 2] += w[2] * xv[q * 4 + 2]; acc[q * 4 + 3] += w[3] * xv[q * 4 + 3]; } }
#pragma unroll
            for (int q = 0; q < 4; ++q) *(f32x4*)(xc + i * 128 + c0 + q * 4) = (f32x4){acc[q * 4], acc[q * 4 + 1], acc[q * 4 + 2], acc[q * 4 + 3]};
            u32x4 w0, w1; w0.x = pk2(acc[0], acc[1]); w0.y = pk2(acc[2], acc[3]); w0.z = pk2(acc[4], acc[5]); w0.w = pk2(acc[6], acc[7]);
            w1.x = pk2(acc[8], acc[9]); w1.y = pk2(acc[10], acc[11]); w1.z = pk2(acc[12], acc[13]); w1.w = pk2(acc[14], acc[15]);
            *(u32x4*)(xcb + i * 136 + c0) = w0; *(u32x4*)(xcb + i * 136 + c0 + 8) = w1;
        }
        lds_barrier();
        float av[16], bv[16], Ao[4], Ho[4], Ap[4], Hp[4];
        {
            f32x16 gx, ga;
#pragma unroll
            for (int i = 0; i < 16; ++i) { gx[i] = 0.f; ga[i] = 0.f; }
#pragma unroll
            for (int s = 0; s < 8; ++s) { const bf16x8 a = *(const bf16x8*)(xcb + (rt * 32 + r) * 136 + 16 * s + 8 * h); gx = MFMA32(a, bx[s], gx); ga = MFMA32(a, ba[s], ga); }
#pragma unroll
            for (int i = 0; i < 16; ++i) { const int tk = rt * 32 + crow(i, h);
                const float vgx = sigmoidf_(gx[i] + bgx), vga = sigmoidf_(ga[i] + bga); const float la = -8.f * vga * sp; av[i] = fexp_(la);
                const float mult = __builtin_amdgcn_sqrtf(fmaxf(1.f - fexp_(2.f * la), 0.f));
                bv[i] = mult * vgx * xc[tk * 128 + ch]; }
        }
#pragma unroll
        for (int g = 0; g < 4; ++g) { float H = 0.f, A = 1.f;
#pragma unroll
            for (int k = 0; k < 4; ++k) { H = av[4 * g + k] * H + bv[4 * g + k]; A *= av[4 * g + k]; }
            Ao[g] = A; Ho[g] = H; Ap[g] = __shfl_xor(A, 32); Hp[g] = __shfl_xor(H, 32); }
        {   float c = 0.f, At = 1.f;
#pragma unroll
            for (int g = 0; g < 4; ++g) { const float A1 = h ? Ap[g] : Ao[g], H1 = h ? Hp[g] : Ho[g], A2 = h ? Ao[g] : Ap[g], H2 = h ? Ho[g] : Hp[g]; c = A1 * c + H1; c = A2 * c + H2; At *= A1 * A2; }
            if (h == 0) ex[rt * 128 + ch] = make_float2(At, c); }
        lds_barrier();
        {   const float2 e0 = ex[ch], e1 = ex[128 + ch]; const float hmid = e0.x * hrun + e0.y;
            float c = rt ? hmid : hrun;
            hrun = e1.x * hmid + e1.y; Arun *= e0.x * e1.x;
            if (FINAL) {
#pragma unroll
                for (int g = 0; g < 4; ++g) { const float A1 = h ? Ap[g] : Ao[g], H1 = h ? Hp[g] : Ho[g], A2 = h ? Ao[g] : Ap[g], H2 = h ? Ho[g] : Hp[g];
                    const float c1 = A1 * c + H1; float hh = h ? c1 : c; c = A2 * c1 + H2;
#pragma unroll
                    for (int k = 0; k < 4; ++k) { hh = av[4 * g + k] * hh + bv[4 * g + k]; hb[(rt * 32 + 8 * g + 4 * h + k) * 128 + ch] = hh; } } } }
        if (FINAL) {
            lds_barrier();
#pragma unroll
            for (int q = 0; q < 2; ++q) { const int c = tid + q * 512; const int i = c >> 4, cc = c & 15; bf16_t* gp = z + (row0 + i) * LDZ + C_LRUG + n * 128 + cc * 8; const u32x4 g = gr[q];
                const f32x4 h0 = *(const f32x4*)(hb + i * 128 + cc * 8), h1 = *(const f32x4*)(hb + i * 128 + cc * 8 + 4); u32x4 o;
                o.x = pk2(h0[0] * siluf_(bflo(g.x)), h0[1] * siluf_(bfhi(g.x))); o.y = pk2(h0[2] * siluf_(bflo(g.y)), h0[3] * siluf_(bfhi(g.y)));
                o.z = pk2(h1[0] * siluf_(bflo(g.z)), h1[1] * siluf_(bfhi(g.z))); o.w = pk2(h1[2] * siluf_(bflo(g.w)), h1[3] * siluf_(bfhi(g.w))); *(u32x4*)gp = o; }
        }
    }
#undef LRU_XLOAD
    if (!FINAL && h == 0 && rt == 0) *(float2*)(agg + ((size_t)(bl * 8 + grp) * 1024 + chg) * 2) = make_float2(Arun, hrun);
}

typedef short s16x4 __attribute__((ext_vector_type(4)));
DI s16x4 vtr(const bf16_t* p) { return __builtin_amdgcn_ds_read_tr16_b64_v4i16((__attribute__((address_space(3))) s16x4*)p); }
template <int DK, bool WIN, bool MLA>
DI void attn_unit(unsigned char* lds, const bf16_t* Qb, size_t qs, const bf16_t* Kb, size_t ks, const bf16_t* Vb, size_t vs, int q0, bf16_t* Ob, size_t os, float* lsep, size_t lses) {
    constexpr int KLD = DK + 8, VLD = 72, KC = DK / 8, KCH = 64 * KC, KBYTES = 64 * KLD * 2, BUFB = KBYTES + 64 * VLD * 2;
    const int tid = otid(), lane = tid & 63, wid = tid >> 6, r = lane & 31, h = lane >> 5;
    const int qw = q0 + 32 * wid;
    bf16x8 qf[DK / 16];
    { const bf16_t* qrow = Qb + (size_t)(qw + r) * qs + 8 * h;
#pragma unroll
      for (int s = 0; s < DK / 16; ++s) qf[s] = *(const bf16x8*)(qrow + 16 * s); }
    f32x16 o[2];
#pragma unroll
    for (int i = 0; i < 16; ++i) { o[0][i] = 0.f; o[1][i] = 0.f; }
    float mrow = -1e30f, lrow = 0.f;
    const int kt_lo = WIN ? (q0 >= 128 ? (q0 - 128) / 64 : 0) : 0, kt_hi = (q0 + 255) / 64, ntile = kt_hi - kt_lo + 1;
    const int k0r = tid / KC, k0c = tid % KC, k1r = (tid + 512) / KC, k1c = (tid + 512) % KC; const bool k1v = (tid + 512) < KCH;
    const int vkey = tid >> 3, vdc = tid & 7;
    const int koff0 = k0r * KLD + k0c * 8, koff1 = k1r * KLD + k1c * 8, voff = vkey * VLD + vdc * 8;
    const int kfrag = r * KLD + 8 * h, vfrag = (4 * h + ((lane & 15) >> 2)) * VLD + 16 * ((lane >> 4) & 1) + 4 * (lane & 3);
    u32x4 kreg0, kreg1 = (u32x4){0u, 0u, 0u, 0u}, vreg;
#define ATT_GLOAD(KT) { const size_t kb = (size_t)(KT) * 64; kreg0 = *(const u32x4*)(Kb + (kb + k0r) * ks + k0c * 8); if (k1v) kreg1 = *(const u32x4*)(Kb + (kb + k1r) * ks + k1c * 8); \
                        vreg = *(const u32x4*)(Vb + (kb + vkey) * vs + vdc * 8); }
#define ATT_LWRITE(SLOT) { bf16_t* kp_ = (bf16_t*)(lds + (SLOT) * BUFB); bf16_t* vp_ = (bf16_t*)(lds + (SLOT) * BUFB + KBYTES); \
                        *(u32x4*)(kp_ + koff0) = kreg0; if (k1v) *(u32x4*)(kp_ + koff1) = kreg1; *(u32x4*)(vp_ + voff) = vreg; }
    ATT_GLOAD(kt_lo)
    __syncthreads();
    ATT_LWRITE(0)
    if (ntile > 1) ATT_GLOAD(kt_lo + 1)
#pragma unroll 1
    for (int it = 0; it < ntile; ++it) {
        const int kbase = (kt_lo + it) * 64;
        lds_barrier();
        if (it + 1 < ntile) { ATT_LWRITE((it + 1) & 1) if (it + 2 < ntile) ATT_GLOAD(kt_lo + it + 2) }
        const bool active = (kbase <= qw + 31) && (!WIN || kbase + 63 >= qw - 128);
        if (active) {
            const bf16_t* Ks = (const bf16_t*)(lds + (it & 1) * BUFB) + kfrag; const bf16_t* Vs = (const bf16_t*)(lds + (it & 1) * BUFB + KBYTES) + vfrag;
            f32x16 x[2];
#pragma unroll
            for (int kt2 = 0; kt2 < 2; ++kt2) {
#pragma unroll
                for (int i = 0; i < 16; ++i) x[kt2][i] = 0.f;
#pragma unroll
                for (int s = 0; s < DK / 16; ++s) { const bf16x8 a = *(const bf16x8*)(Ks + kt2 * 32 * KLD + 16 * s); x[kt2] = MFMA32(a, qf[s], x[kt2]); } }
            const int qi = qw + r; float tmax = -INFINITY;
            const bool need_mask = (kbase + 63 > qw) || (WIN && kbase < qw + 31 - 128);
            if (need_mask) {
#pragma unroll
                for (int kt2 = 0; kt2 < 2; ++kt2)
#pragma unroll
                    for (int i = 0; i < 16; ++i) { const int key = kbase + kt2 * 32 + crow(i, h); const bool ok = (key <= qi) && (!WIN || key >= qi - 128);
                        x[kt2][i] = ok ? x[kt2][i] : -INFINITY; }
            }
#pragma unroll
            for (int kt2 = 0; kt2 < 2; ++kt2)
#pragma unroll
                for (int i = 0; i < 16; ++i) tmax = fmaxf(tmax, x[kt2][i]);
            tmax = fmaxf(tmax, __shfl_xor(tmax, 32));
            const float mnew = fmaxf(mrow, tmax), alpha = __builtin_amdgcn_exp2f(mrow - mnew); float rsum = 0.f;
#pragma unroll
            for (int kt2 = 0; kt2 < 2; ++kt2)
#pragma unroll
                for (int i = 0; i < 16; ++i) { const float p = __builtin_amdgcn_exp2f(x[kt2][i] - mnew); x[kt2][i] = p; rsum += p; }
            rsum += __shfl_xor(rsum, 32);
            lrow = lrow * alpha + rsum; mrow = mnew;
#pragma unroll
            for (int i = 0; i < 16; ++i) { o[0][i] *= alpha; o[1][i] *= alpha; }
#pragma unroll
            for (int kt2 = 0; kt2 < 2; ++kt2)
#pragma unroll
                for (int s = 0; s < 2; ++s) {
                    u32x4 pw; pw.x = pk2(x[kt2][8 * s + 0], x[kt2][8 * s + 1]); pw.y = pk2(x[kt2][8 * s + 2], x[kt2][8 * s + 3]); pw.z = pk2(x[kt2][8 * s + 4], x[kt2][8 * s + 5]); pw.w = pk2(x[kt2][8 * s + 6], x[kt2][8 * s + 7]);
                    const bf16x8 pb = __builtin_bit_cast(bf16x8, pw);
#pragma unroll
                    for (int n = 0; n < 2; ++n) { const bf16_t* vp = Vs + (kt2 * 32 + 16 * s) * VLD + 32 * n;
                        const s16x4 lo = vtr(vp), hi = vtr(vp + 8 * VLD);
                        const bf16x8 av = __builtin_shufflevector(lo, hi, 0, 1, 2, 3, 4, 5, 6, 7);
                        o[n] = MFMA32(av, pb, o[n]); } }
        }
    }
#undef ATT_GLOAD
#undef ATT_LWRITE
    const float inv = __builtin_amdgcn_rcpf(lrow); const size_t orow = (size_t)(qw + r) * os;
#pragma unroll
    for (int n = 0; n < 2; ++n)
#pragma unroll
        for (int g4 = 0; g4 < 4; ++g4) { const int dv = n * 32 + g4 * 8 + 4 * h; bf16_t* op = Ob + orow + dv;
            float e0 = o[n][g4 * 4] * inv, e1 = o[n][g4 * 4 + 1] * inv, e2 = o[n][g4 * 4 + 2] * inv, e3 = o[n][g4 * 4 + 3] * inv;
            if (MLA) { const u32x2 g = *(const u32x2*)op; e0 *= siluf_(bflo(g.x)); e1 *= siluf_(bfhi(g.x)); e2 *= siluf_(bflo(g.y)); e3 *= siluf_(bfhi(g.y)); }
            u32x2 w; w.x = pk2(e0, e1); w.y = pk2(e2, e3); *(u32x2*)op = w; }
    if (!MLA) { if (h == 0) lsep[(size_t)(qw + r) * lses] = (mrow + __log2f(lrow)) * LN2; }
}

DI void gsync(unsigned* ctr, unsigned& target) {
    asm volatile("s_waitcnt vmcnt(0)" ::: "memory");
    __syncthreads();
    target += gridDim.x;
    if (threadIdx.x == 0) {
        __builtin_amdgcn_fence(__ATOMIC_RELEASE, "agent");
        asm volatile("s_waitcnt vmcnt(0)" ::: "memory");
        (void)__hip_atomic_fetch_add(ctr, 1u, __ATOMIC_RELAXED, __HIP_MEMORY_SCOPE_AGENT);
        while (__hip_atomic_load(ctr, __ATOMIC_RELAXED, __HIP_MEMORY_SCOPE_AGENT) < target) __builtin_amdgcn_s_sleep(1);
        __builtin_amdgcn_fence(__ATOMIC_ACQUIRE, "agent");
        asm volatile("s_waitcnt vmcnt(0)" ::: "memory");
    }
    __syncthreads();
}

__global__ void __launch_bounds__(512, 2) hybrid_fwd(Args a) {
    extern __shared__ __attribute__((aligned(16))) unsigned char lds_raw[];
    cg::grid_group grid = cg::this_grid();
    unsigned char* lds = lds_raw; PG8_LAS unsigned char* ldsl = (PG8_LAS unsigned char*)lds_raw;
    const int G = gridDim.x;
#define bx obid()
    unsigned char* ws = a.ws;
    bf16_t* z = (bf16_t*)(ws + WS_Z); unsigned char* sc = ws + WS_S;
    bf16_t* xn = (bf16_t*)(sc + S_XN); bf16_t* qf = (bf16_t*)(sc + S_QF); bf16_t* kvr = qf + 768; bf16_t* kf = (bf16_t*)(sc + S_KF);
    float* agg = (float*)(sc + S_AGG); float* lse = (float*)(sc + S_LSE); float* mrg = (float*)(sc + S_MRG); bf16_t* mb = (bf16_t*)(sc + S_MB);
    const int* positions = (const int*)a.in[1];

    unsigned* gctr = (unsigned*)(ws + WS_CTL); unsigned gtarget = 0;
    if (blockIdx.x == 0 && threadIdx.x == 0) __hip_atomic_store(gctr, 0u, __ATOMIC_RELAXED, __HIP_MEMORY_SCOPE_AGENT);
    unsigned long long tacc = 0, tprev = 0; if (PROBE_K >= 0) tprev = __builtin_amdgcn_s_memrealtime();
    prologue_weights(a, lds);
    if (PROBE_K == 0) { grid.sync(); PSTAMP(0); }
#pragma unroll 1
    for (int l = 0; l < DEPTH; ++l) {
        const unsigned char* wl = ws + WS_W + (size_t)l * WL_SIZE;
#pragma unroll 1
        for (int c = 0; c < NCHUNK; ++c) {
            const size_t roff = (size_t)c * TC;
            const float* xin = (l == 0 ? a.in[0] : a.out) + roff * DM; float* xout = a.out + roff * DM; const int* pos = positions + roff;
            p0_rmsnorm(xin, a.in[2] + l * DM, xn);
            if (l == 0 && c == 0) grid.sync(); else gsync(gctr, gtarget);
            PSTAMP(1);
            { pg8::Gemm g; g.A = xn; g.Bt = (const bf16_t*)(wl + WL_IN); g.M = TC; g.N = NZP; g.K = DM; g.lda = DM;
              pg8::StaticOrder S; S.init(TC, NZP, G, bx); EpiZ E; E.O = z; E.ldc = LDZ; E.ncols = INW;
              pg8::gemm_phase<EpiZ, pg8::StaticOrder, true, true>(ldsl, g, S, E); }
            gsync(gctr, gtarget); PSTAMP(2);
            { pg8::Gemm g; g.A = z + C_CQ; g.Bt = (const bf16_t*)(wl + WL_UP); g.M = TC; g.N = NUP; g.K = KUP; g.lda = LDZ;
              pg8::StaticOrder S; S.init(TC, NUP, G, bx); EpiZ E; E.O = qf; E.ldc = LDQ; E.ncols = NUP;
              pg8::gemm_phase<EpiZ, pg8::StaticOrder, true, true>(ldsl, g, S, E); }
            __syncthreads();
            dil_prep(z, pos, a.in[19] + l * 64, a.in[20] + l * 64);
            LruP lp; lp.conv_w = a.in[4] + (size_t)l * 4 * 1024; lp.conv_b = a.in[5] + l * 1024; lp.b_gx = a.in[7] + l * 1024; lp.b_ga = a.in[9] + l * 1024; lp.lam = a.in[10] + l * 1024;
            lp.wgx = (const bf16_t*)(wl + WL_GX); lp.wga = (const bf16_t*)(wl + WL_GA);
            for (int u = bx; u < NB * 64; u += G) lru_unit<false>(lds, z, agg, lp, u >> 6, (u >> 3) & 7, u & 7);
            gsync(gctr, gtarget); PSTAMP(3);
            mla_finalize(lds, z, qf, kvr, kf, pos, a.in[16] + l * 96, a.in[17] + l * 96);
            gsync(gctr, gtarget); PSTAMP(4);
            for (int u = bx; u < 512 + NB * 384; u += G) {
                if (u < 512) {
                    int qb, bh; if (u < 256) { qb = 15 - (u >> 5); bh = u & 31; } else { qb = (u - 256) >> 5; bh = (u - 256) & 31; }
                    const int bl = bh >> 3, hd = bh & 7; const size_t t0 = (size_t)bl * SEQ;
                    attn_unit<96, false, true>(lds, qf + t0 * LDQ + hd * 96, LDQ, kf + t0 * 768 + hd * 96, 768, kvr + t0 * LDQ + hd * 128 + 64, LDQ, qb * 256,
                                               z + t0 * LDZ + C_MLAG + hd * 64, LDZ, nullptr, 0);
                } else {
                    const int v = u - 512, bl = v / 384, w = v % 384, gi = w >> 7, w2 = w & 127, hd = w2 >> 4, rem = w2 & 15;
                    const int d = 1 << (2 * gi), npairs = 16 >> (2 * gi), r = rem / npairs, pair = rem % npairs, head = gi * 8 + hd;
                    const size_t brow = (size_t)bl * SEQ + r; bf16_t* zb = z + brow * LDZ + head * 64; const size_t st = (size_t)d * LDZ;
                    attn_unit<64, true, false>(lds, zb + C_DQ, st, zb + C_DK, st, zb + C_DV, st, pair * 256, zb + C_DQ, st, lse + (size_t)gi * TC * 8 + brow * 8 + hd, (size_t)d * 8);
                }
            }
            gsync(gctr, gtarget); PSTAMP(5);
            dil_combine(z, lse);
            for (int u = bx; u < NB * 64; u += G) lru_unit<true>(lds, z, agg, lp, u >> 6, (u >> 3) & 7, u & 7);
            gsync(gctr, gtarget); PSTAMP(6);
            { pg8::StaticOrder S; S.init(TC, DM, G, bx); const float* bm = a.in[22] + (size_t)l * 3072;
              { pg8::Gemm g; g.A = z + C_LRUG; g.Bt = (const bf16_t*)(wl + WL_PLRU); g.M = TC; g.N = DM; g.K = 1024; g.lda = LDZ;
                EpiMerge<0> E; E.Z = z; E.bm = bm; E.MRG = mrg; E.MB = mb; pg8::gemm_phase<EpiMerge<0>, pg8::StaticOrder, true, true>(ldsl, g, S, E); }
              { pg8::Gemm g; g.A = z + C_MLAG; g.Bt = (const bf16_t*)(wl + WL_PMLA); g.M = TC; g.N = DM; g.K = 512; g.lda = LDZ;
                EpiMerge<1> E; E.Z = z; E.bm = bm; E.MRG = mrg; E.MB = mb; pg8::gemm_phase<EpiMerge<1>, pg8::StaticOrder, true, true>(ldsl, g, S, E); }
              { pg8::Gemm g; g.A = z + C_DILG; g.Bt = (const bf16_t*)(wl + WL_PDIL); g.M = TC; g.N = DM; g.K = 512; g.lda = LDZ;
                EpiMerge<2> E; E.Z = z; E.bm = bm; E.MRG = mrg; E.MB = mb; pg8::gemm_phase<EpiMerge<2>, pg8::StaticOrder, true, true>(ldsl, g, S, E); } }
            gsync(gctr, gtarget); PSTAMP(7);
            { pg8::Gemm g; g.A = mb; g.Bt = (const bf16_t*)(wl + WL_OUT); g.M = TC; g.N = DM; g.K = DM; g.lda = DM;
              pg8::StaticOrder S; S.init(TC, DM, G, bx); EpiOut E; E.X = xin; E.O = xout;
              pg8::gemm_phase<EpiOut, pg8::StaticOrder, true, true>(ldsl, g, S, E); }
            __syncthreads();
            if (PROBE_K == 8) { grid.sync(); PSTAMP(8); }
        }
    }
    if (PROBE_K >= 0 && blockIdx.x == 0 && threadIdx.x == 0) { const unsigned long long t0 = __builtin_amdgcn_s_memrealtime(); while (__builtin_amdgcn_s_memrealtime() - t0 < tacc) __builtin_amdgcn_s_sleep(8); }
}

extern "C" void kernel_launch(void* const* d_in, const int* in_sizes, int n_in, void* d_out, int out_size, void* d_ws, size_t ws_size, hipStream_t stream) {
    static int grid_blocks = 0;
    if (!grid_blocks) {
        int dev = 0, cus = 0, per_cu = 0;
        (void)hipGetDevice(&dev);
        (void)hipDeviceGetAttribute(&cus, hipDeviceAttributeMultiprocessorCount, dev);
        if (hipFuncSetAttribute((const void*)hybrid_fwd, hipFuncAttributeMaxDynamicSharedMemorySize, LDS_BYTES) != hipSuccess) fprintf(stderr, "hipFuncSetAttribute failed\n");
        if (hipOccupancyMaxActiveBlocksPerMultiprocessor(&per_cu, (const void*)hybrid_fwd, 512, LDS_BYTES) != hipSuccess || per_cu < 1) per_cu = 1;
        grid_blocks = cus * 1;
        if (ws_size < WS_NEED) fprintf(stderr, "workspace too small: %zu < %zu\n", ws_size, (size_t)WS_NEED);
    }
    if (ws_size < WS_NEED || n_in < 24) return;
    Args a{};
    for (int i = 0; i < 24; ++i) a.in[i] = (const float*)d_in[i];
    a.out = (float*)d_out; a.ws = (unsigned char*)d_ws;
    void* args[] = {&a};
    hipError_t e = hipLaunchCooperativeKernel((const void*)hybrid_fwd, dim3(grid_blocks), dim3(512), args, LDS_BYTES, stream);
    if (e != hipSuccess) fprintf(stderr, "cooperative launch failed: %s (grid %d)\n", hipGetErrorString(e), grid_blocks);
}
```

```cpp
#include <hip/hip_runtime.h>
#include <hip/hip_cooperative_groups.h>
#include <cstdio>
#include <cstdint>
namespace cg = cooperative_groups;
__device__ __forceinline__ int otid() { int t = threadIdx.x; asm volatile("" : "+v"(t)); return t; }
__device__ __forceinline__ int obid() { int b = blockIdx.x; asm volatile("" : "+s"(b)); return b; }
namespace pg8 {
#define PG8_LAS __attribute__((address_space(3)))
typedef unsigned short bf16_t;
typedef short bf16x8 __attribute__((ext_vector_type(8)));
typedef float f32x4 __attribute__((ext_vector_type(4)));
typedef unsigned u32x4 __attribute__((ext_vector_type(4)));
constexpr int BM = 256, BK = 64, HALF = 128, HTB = HALF * BK * 2  , STAGE_BYTES = 8 * HTB, NXCD = 8, WGM = 8;

__host__ __device__ __forceinline__ int lds_byte(int r, int c) { const int st = (r >> 4) * 2 + (c >> 5), rr = r & 15, cc = c & 31, ob = rr * 64 + cc * 2; return st * 1024 + (ob ^ (((ob >> 9) & 1) << 5)); }
__host__ __device__ __forceinline__ void stage_rc(int b, int& R, int& C) { const int st = b / 1024, sb = b % 1024, swz = sb ^ (((sb >> 9) & 1) << 5); R = (st >> 1) * 16 + swz / 64; C = (st & 1) * 32 + (swz % 64) / 2; }
__host__ __device__ __forceinline__ int perm32(int rho) { const int n = rho >> 4, i = rho & 15; return 8 * (i >> 2) + 4 * n + (i & 3); }

struct Unit { int pm, pn; };
struct Gemm { const bf16_t* A; const bf16_t* Bt; int M, N, K, lda; };

struct StaticOrder {
    int nM, nN, nwg, G, c;
    __host__ __device__ void init(int M, int N, int G_, int c_) { nM = M / BM; nN = N / BM; nwg = nM * nN; G = G_; c = c_; }
    __host__ __device__ bool next(int i, Unit& u) const {
        const long L = (long)i * G + c; if (L >= nwg) return false;
        int wgid = (int)L; { const int q = nwg / NXCD, r = nwg % NXCD, xcd = wgid % NXCD, off = wgid / NXCD; wgid = (xcd < r ? xcd * (q + 1) : r * (q + 1) + (xcd - r) * q) + off; }
        const int nig = WGM * nN, gid = wgid / nig, fm = gid * WGM, gsz = (nM - fm) < WGM ? (nM - fm) : WGM;
        u.pm = fm + ((wgid % nig) % gsz); u.pn = (wgid % nig) / gsz; return true;
    }
    __device__ __forceinline__ void a_ready(const Unit&) const {}
    __device__ __forceinline__ void done(const Unit&) const {}
};
__device__ __forceinline__ unsigned cvt_pk_bf16(float lo, float hi) { unsigned r; asm volatile("v_cvt_pk_bf16_f32 %0, %1, %2" : "=v"(r) : "v"(lo), "v"(hi)); return r; }
template <class Epi, class Sched, bool ALIGN_EPI = false, bool SP2 = false>
__device__ __forceinline__ void gemm_body(PG8_LAS unsigned char* lds, const Gemm g, const Sched& S, const Epi& E, f32x4 (&acc)[2][2][4][2], const bool zero_init) {
    const int tid = otid(), wid = __builtin_amdgcn_readfirstlane(tid >> 6), lane = tid & 63, wr = wid >> 2, wc = wid & 3, fr = lane & 15, fq = lane >> 4;
    const int K = g.K, nt = K / BK;
    unsigned voffA[2], voffB[2];
#pragma unroll
    for (int i = 0; i < 2; ++i) { int R, C; stage_rc(tid * 16 + i * 8192, R, C); const int Rb = Epi::PERM ? ((R & ~31) + perm32(R & 31)) : R;
        voffA[i] = (unsigned)(R * g.lda + C) * 2u; voffB[i] = (unsigned)(Rb * K + C) * 2u; }
    const size_t kstep = (size_t)(BK * 2);
    const size_t hstepA = (size_t)HALF * g.lda * 2, hstepB = (size_t)HALF * K * 2;
    const size_t tstepA = 2 * hstepA, tstepB = 2 * hstepB;
    const unsigned ldsw = (unsigned)wid * 1024u;
    const int aoff = lds_byte(wr * 64 + fr, fq * 8), boff = lds_byte(wc * 32 + fr, fq * 8);
#define PG8_SA(b, h) (((b) * 2 + (h)) * HTB)
#define PG8_SB(b, h) ((4 + (b) * 2 + (h)) * HTB)
#define PG8_STAGE(bufoff, gbase, voff) do { _Pragma("unroll") for (int _i = 0; _i < 2; ++_i) \
        __builtin_amdgcn_global_load_lds((const unsigned*)((const char*)(gbase) + (voff)[_i]), (PG8_LAS unsigned*)(lds + (bufoff) + ldsw + _i * 8192), 16, 0, 0); } while (0)
#define PG8_LDA(dst, b, h) do { _Pragma("unroll") for (int m = 0; m < 4; ++m) _Pragma("unroll") for (int k = 0; k < 2; ++k) dst[m][k] = *(const PG8_LAS bf16x8*)(lds + PG8_SA(b, h) + aoff + m * 2048 + k * 1024); } while (0)
#define PG8_LDB(dst, b, h) do { _Pragma("unroll") for (int n = 0; n < 2; ++n) _Pragma("unroll") for (int k = 0; k < 2; ++k) dst[n][k] = *(const PG8_LAS bf16x8*)(lds + PG8_SB(b, h) + boff + n * 2048 + k * 1024); } while (0)
#define PG8_MMA(ai, bj, At, Bt) do { __builtin_amdgcn_s_setprio(1); _Pragma("unroll") for (int m = 0; m < 4; ++m) _Pragma("unroll") for (int n = 0; n < 2; ++n) _Pragma("unroll") for (int k = 0; k < 2; ++k) \
        acc[ai][bj][m][n] = __builtin_amdgcn_mfma_f32_16x16x32_bf16(Bt[n][k], At[m][k], acc[ai][bj][m][n], 0, 0, 0); __builtin_amdgcn_s_setprio(0); } while (0)
#define PG8_WAIT_V(n) asm volatile("s_waitcnt vmcnt(" #n ")" ::: "memory")
#define PG8_WAIT_L(n) asm volatile("s_waitcnt lgkmcnt(" #n ")" ::: "memory")
#define PG8_BAR __builtin_amdgcn_s_barrier()
#define PG8_SCHED __builtin_amdgcn_sched_barrier(0)
    Unit cur, nxt; int ui = 0;
    if (!S.next(0, cur)) return;
    if (zero_init) {
#pragma unroll
    for (int a = 0; a < 2; ++a)
#pragma unroll
        for (int b = 0; b < 2; ++b)
#pragma unroll
            for (int m = 0; m < 4; ++m)
#pragma unroll
                for (int n = 0; n < 2; ++n) acc[a][b][m][n] = (f32x4){0.f, 0.f, 0.f, 0.f};
    }
    bf16x8 At[4][2], B0[2][2], B1[2][2];
    const char* cA = (const char*)g.A + (size_t)cur.pm * tstepA; const char* cB = (const char*)g.Bt + (size_t)cur.pn * tstepB;
    S.a_ready(cur);
    if constexpr (SP2) {
        PG8_STAGE(PG8_SB(0, 0), cB, voffB); PG8_STAGE(PG8_SB(0, 1), cB + hstepB, voffB); PG8_STAGE(PG8_SA(0, 0), cA, voffA); PG8_STAGE(PG8_SA(0, 1), cA + hstepA, voffA);
        if (wr == 1) PG8_BAR;
        PG8_WAIT_V(2); PG8_BAR;
        PG8_STAGE(PG8_SB(1, 0), cB + kstep, voffB); PG8_STAGE(PG8_SA(1, 0), cA + kstep, voffA); PG8_STAGE(PG8_SB(1, 1), cB + hstepB + kstep, voffB);
        PG8_WAIT_V(6); PG8_BAR;
    } else {
        PG8_STAGE(PG8_SB(0, 0), cB, voffB); PG8_STAGE(PG8_SA(0, 0), cA, voffA); PG8_STAGE(PG8_SB(0, 1), cB + hstepB, voffB); PG8_STAGE(PG8_SA(0, 1), cA + hstepA, voffA);
        if (wr == 1) PG8_BAR;
        PG8_WAIT_V(4); PG8_BAR;
        PG8_STAGE(PG8_SB(1, 0), cB + kstep, voffB); PG8_STAGE(PG8_SA(1, 0), cA + kstep, voffA); PG8_STAGE(PG8_SB(1, 1), cB + hstepB + kstep, voffB);
        PG8_WAIT_V(6); PG8_BAR;
    }
    for (;;) {
        const bool has_next = S.next(ui + 1, nxt);
        const char* nA = has_next ? (const char*)g.A + (size_t)nxt.pm * tstepA : cA; const char* nB = has_next ? (const char*)g.Bt + (size_t)nxt.pn * tstepB : cB;
#pragma unroll 1
        for (int t = 0; t < nt; t += 2) {
            if constexpr (Epi::CHAIN) { if (t == Epi::T1 || t == Epi::T2) E.mid(acc, cur, t, wr, wc, fr, fq); }
            const bool last = (t == nt - 2);
            const char* a1 = cA + (size_t)(t + 1) * kstep;
            const char* a2 = last ? nA : cA + (size_t)(t + 2) * kstep; const char* b2 = last ? nB : cB + (size_t)(t + 2) * kstep;
            const char* a3 = a2 + kstep; const char* b3 = b2 + kstep;
            if (last && has_next) S.a_ready(nxt);
            if constexpr (SP2) {
            PG8_LDB(B0, 0, 0); PG8_LDB(B1, 0, 1); PG8_SCHED; PG8_LDA(At, 0, 0); PG8_STAGE(PG8_SA(1, 1), a1 + hstepA, voffA);
            PG8_WAIT_V(8); PG8_WAIT_L(0); PG8_BAR; PG8_MMA(0, 0, At, B0); PG8_MMA(0, 1, At, B1); PG8_BAR; PG8_SCHED;
            PG8_LDA(At, 0, 1); PG8_STAGE(PG8_SB(0, 0), b2, voffB); PG8_STAGE(PG8_SB(0, 1), b2 + hstepB, voffB); PG8_STAGE(PG8_SA(0, 0), a2, voffA);
            PG8_WAIT_V(8); PG8_WAIT_L(0); PG8_BAR; PG8_MMA(1, 0, At, B0); PG8_MMA(1, 1, At, B1); PG8_BAR; PG8_SCHED;
            PG8_LDB(B0, 1, 0); PG8_LDB(B1, 1, 1); PG8_SCHED; PG8_LDA(At, 1, 0); PG8_STAGE(PG8_SA(0, 1), a2 + hstepA, voffA);
            PG8_WAIT_V(8); PG8_WAIT_L(0); PG8_BAR; PG8_MMA(0, 0, At, B0); PG8_MMA(0, 1, At, B1); PG8_BAR; PG8_SCHED;
            PG8_LDA(At, 1, 1); PG8_STAGE(PG8_SB(1, 0), b3, voffB); PG8_STAGE(PG8_SB(1, 1), b3 + hstepB, voffB); PG8_STAGE(PG8_SA(1, 0), a3, voffA);
            PG8_WAIT_V(8); PG8_WAIT_L(0); PG8_BAR; PG8_MMA(1, 0, At, B0); PG8_MMA(1, 1, At, B1); PG8_BAR; PG8_SCHED;
            } else {
            PG8_LDB(B0, 0, 0); PG8_SCHED; PG8_LDA(At, 0, 0); PG8_STAGE(PG8_SA(1, 1), a1 + hstepA, voffA);
            PG8_WAIT_L(8); PG8_BAR; PG8_WAIT_L(0); PG8_MMA(0, 0, At, B0); PG8_BAR; PG8_SCHED;
            PG8_LDB(B1, 0, 1); PG8_STAGE(PG8_SB(0, 0), b2, voffB);
            PG8_BAR; PG8_WAIT_L(0); PG8_MMA(0, 1, At, B1); PG8_BAR;
            PG8_LDA(At, 0, 1); PG8_STAGE(PG8_SA(0, 0), a2, voffA);
            PG8_BAR; PG8_WAIT_L(0); PG8_MMA(1, 0, At, B0); PG8_BAR; PG8_SCHED;
            PG8_STAGE(PG8_SB(0, 1), b2 + hstepB, voffB);
            PG8_WAIT_V(6); PG8_BAR; PG8_MMA(1, 1, At, B1); PG8_BAR;
            PG8_LDB(B0, 1, 0); PG8_SCHED; PG8_LDA(At, 1, 0); PG8_STAGE(PG8_SA(0, 1), a2 + hstepA, voffA);
            PG8_WAIT_L(8); PG8_BAR; PG8_WAIT_L(0); PG8_MMA(0, 0, At, B0); PG8_BAR; PG8_SCHED;
            PG8_LDB(B1, 1, 1); PG8_STAGE(PG8_SB(1, 0), b3, voffB);
            PG8_BAR; PG8_WAIT_L(0); PG8_MMA(0, 1, At, B1); PG8_BAR;
            PG8_LDA(At, 1, 1); PG8_STAGE(PG8_SA(1, 0), a3, voffA);
            PG8_BAR; PG8_WAIT_L(0); PG8_MMA(1, 0, At, B0); PG8_BAR; PG8_SCHED;
            PG8_STAGE(PG8_SB(1, 1), b3 + hstepB, voffB);
            PG8_WAIT_V(6); PG8_BAR; PG8_MMA(1, 1, At, B1); PG8_BAR;
            }
        }
        if constexpr (ALIGN_EPI) { if (wr == 0) PG8_BAR; }
        if constexpr (!Epi::AFTER_DRAIN) { E(acc, cur, wr, wc, fr, fq); S.done(cur); }
        if (!has_next) break;
#pragma unroll
        for (int a = 0; a < 2; ++a)
#pragma unroll
            for (int b = 0; b < 2; ++b)
#pragma unroll
                for (int m = 0; m < 4; ++m)
#pragma unroll
                    for (int n = 0; n < 2; ++n) acc[a][b][m][n] = (f32x4){0.f, 0.f, 0.f, 0.f};
        cur = nxt; cA = nA; cB = nB; ++ui;
        if constexpr (ALIGN_EPI) { if (wr == 1) PG8_BAR; }
    }
    PG8_WAIT_V(0);
    if constexpr (!ALIGN_EPI) { if (wr == 0) PG8_BAR; }
    PG8_BAR;
    if constexpr (Epi::AFTER_DRAIN) { E.fused(acc, cur, wr, wc, fr, fq, lds, wid, lane); S.done(cur); }
#undef PG8_SA
#undef PG8_SB
#undef PG8_STAGE
#undef PG8_LDA
#undef PG8_LDB
#undef PG8_MMA
#undef PG8_WAIT_V
#undef PG8_WAIT_L
#undef PG8_BAR
#undef PG8_SCHED
}
template <class Epi, class Sched, bool ALIGN_EPI = false, bool SP2 = false>
__device__ __forceinline__ void gemm_phase(PG8_LAS unsigned char* lds, const Gemm g, const Sched& S, const Epi& E) {
    f32x4 acc[2][2][4][2];
    gemm_body<Epi, Sched, ALIGN_EPI, SP2>(lds, g, S, E, acc, true);
}
struct OneUnit { Unit u;
    __device__ __forceinline__ bool next(int i, Unit& o) const { if (i) return false; o = u; return true; }
    __device__ __forceinline__ void a_ready(const Unit&) const {}
    __device__ __forceinline__ void done(const Unit&) const {} };
}

typedef unsigned short bf16_t;
using pg8::bf16x8; using pg8::f32x4; using pg8::u32x4;
typedef float f32x16 __attribute__((ext_vector_type(16)));
typedef unsigned u32x2 __attribute__((ext_vector_type(2)));
#define DI __device__ __forceinline__
#define MFMA32(a, b, c) __builtin_amdgcn_mfma_f32_32x32x16_bf16((a), (b), (c), 0, 0, 0)

constexpr int SEQ = 4096, BATCH = 8, DM = 1024, DEPTH = 2;
constexpr int NB = 4, TC = NB * SEQ, NCHUNK = BATCH / NB;
constexpr int INW = 11168, LDZ = 11168, NZP = 11264;
constexpr int C_LRUX = 0, C_LRUG = 1024, C_MLAG = 2048, C_DILG = 2560, C_DQ = 3072, C_DK = 4608, C_DV = 6144, C_MERGE = 7680, C_CQ = 10752, C_CKV = 11008, C_KR = 11136;
constexpr float EPS = 1e-6f, LOG2E = 1.4426950408889634f, LN2 = 0.6931471805599453f, LOG2_THETA = 13.287712379549449f;
constexpr int NUP = 1792, KUP = 384;

constexpr size_t W_IN_B = (size_t)NZP * DM * 2, W_UP_B = (size_t)NUP * KUP * 2, W_SQ_B = (size_t)DM * DM * 2, W_HF_B = (size_t)DM * 512 * 2, W_G_B = (size_t)8 * 128 * 128 * 2;
constexpr size_t WL_IN = 0, WL_UP = WL_IN + W_IN_B, WL_PCAT = WL_UP + W_UP_B  , WL_OUT = WL_PCAT + W_SQ_B + 2 * W_HF_B,
                 WL_GX = WL_OUT + W_SQ_B, WL_GA = WL_GX + W_G_B, WL_SIZE = WL_GA + W_G_B;
constexpr size_t WS_W = 0, WS_Z = WS_W + 2 * WL_SIZE, WS_S = WS_Z + (size_t)TC * LDZ * 2;
constexpr size_t S_XN = 0;
constexpr int LDQ = 1792;
constexpr size_t S_QF = 0, S_KF = S_QF + (size_t)TC * LDQ * 2, S_AGG = S_KF + (size_t)TC * 768 * 2,
                 S_LSE = S_AGG + (size_t)(TC / 64) * 1024 * 8, S_P23_END = S_LSE + (size_t)3 * TC * 8 * 4;
constexpr size_t S_MRG = 0, S_MB = S_MRG + (size_t)TC * DM * 4, S_END = S_MB + (size_t)TC * DM * 2;
static_assert(S_P23_END <= S_END, "scratch");
constexpr size_t WS_CTL = WS_S + S_END;
constexpr size_t WS_NEED = WS_CTL + 256;
static_assert(WS_NEED <= 536870912ull, "workspace");
static_assert(WS_Z % 256 == 0 && WS_S % 256 == 0 && WL_SIZE % 256 == 0, "align");
constexpr int LDS_BYTES = 139264;

DI float bflo(unsigned w) { return __uint_as_float(w << 16); }
DI float bfhi(unsigned w) { return __uint_as_float(w & 0xffff0000u); }
DI unsigned pk2(float lo, float hi) { typedef float f2_t __attribute__((ext_vector_type(2))); typedef __bf16 b2_t __attribute__((ext_vector_type(2)));
    f2_t v = {lo, hi}; b2_t b = __builtin_convertvector(v, b2_t); return __builtin_bit_cast(unsigned, b); }
DI float sigmoidf_(float x) { return __builtin_amdgcn_rcpf(1.f + __builtin_amdgcn_exp2f(-LOG2E * x)); }
DI float siluf_(float x) { return x * sigmoidf_(x); }
DI float fexp_(float x) { return __builtin_amdgcn_exp2f(LOG2E * x); }
DI float wave_sum(float v) {
#pragma unroll
    for (int m = 1; m < 64; m <<= 1) v += __shfl_xor(v, m);
    return v; }
DI void lds_barrier() { asm volatile("s_waitcnt lgkmcnt(0)\n\ts_barrier" ::: "memory"); }
DI int crow(int i, int h) { return (i & 3) + 8 * (i >> 2) + 4 * h; }
DI void sincos_rev(float ang, float& s, float& c) { float rev = ang * 0.15915494309189535f; rev = rev - floorf(rev); s = __builtin_amdgcn_sinf(rev); c = __builtin_amdgcn_cosf(rev); }

struct Args { const float* in[24]; float* out; unsigned char* ws; };
#ifndef PROBE_K
#define PROBE_K (-1)
#endif
#define PSTAMP(k) do { if (PROBE_K >= 0) { const unsigned long long now_ = __builtin_amdgcn_s_memrealtime(); if ((k) == PROBE_K) tacc += now_ - tprev; tprev = now_; } } while (0)

DI void wconv_job(float* tl, const float* __restrict__ src, int lds_, int n0s, int nrows, int ncols, bf16_t* dst, int ldd, int n0d, int k0d, const float* __restrict__ scale) {
    const int tid = otid(), ntn = ncols / 32, ntk = nrows / 128, nt = ntn * ntk;
    for (int t = obid(); t < nt; t += gridDim.x) {
        const int tn = t % ntn, tk = t / ntn, k0 = tk * 128;
#pragma unroll
        for (int i = 0; i < 8; ++i) { const int kk = i * 16 + (tid >> 5), nn = tid & 31;
            float v = src[(size_t)(k0 + kk) * lds_ + n0s + tn * 32 + nn]; if (scale) v *= scale[k0 + kk]; tl[kk * 33 + nn] = v; }
        __syncthreads();
        { const int n = tid >> 4, kq = tid & 15; u32x4 w;
          w.x = pk2(tl[(kq * 8 + 0) * 33 + n], tl[(kq * 8 + 1) * 33 + n]); w.y = pk2(tl[(kq * 8 + 2) * 33 + n], tl[(kq * 8 + 3) * 33 + n]);
          w.z = pk2(tl[(kq * 8 + 4) * 33 + n], tl[(kq * 8 + 5) * 33 + n]); w.w = pk2(tl[(kq * 8 + 6) * 33 + n], tl[(kq * 8 + 7) * 33 + n]);
          *(u32x4*)(dst + (size_t)(n0d + tn * 32 + n) * ldd + k0d + k0 + kq * 8) = w; }
        __syncthreads();
    }
}
DI void zero_rect(bf16_t* dst, int ldd, int n0, int nn, int k0, int nk) {
    const int per = nk / 8, tot = nn * per;
    for (int i = obid() * 512 + otid(); i < tot; i += gridDim.x * 512) { const int n = i / per, c = i % per;
        *(u32x4*)(dst + (size_t)(n0 + n) * ldd + k0 + c * 8) = (u32x4){0u, 0u, 0u, 0u}; }
}
DI void prologue_weights(const Args& a, unsigned char* lds) {
    float* tl = (float*)lds;
    for (int l = 0; l < DEPTH; ++l) {
        unsigned char* wl = a.ws + WS_W + (size_t)l * WL_SIZE;
        bf16_t* win = (bf16_t*)(wl + WL_IN); const float* w_in = a.in[3] + (size_t)l * DM * INW;
        wconv_job(tl, w_in, INW, 0,    1024, 2048, win, DM, C_LRUX, 0, nullptr);
        wconv_job(tl, w_in, INW, 2464, 1024, 512,  win, DM, C_MLAG, 0, nullptr);
        wconv_job(tl, w_in, INW, 7584, 1024, 512,  win, DM, C_DILG, 0, nullptr);
        wconv_job(tl, w_in, INW, 2976, 1024, 4608, win, DM, C_DQ, 0, nullptr);
        wconv_job(tl, w_in, INW, 8096, 1024, 3072, win, DM, C_MERGE, 0, nullptr);
        wconv_job(tl, w_in, INW, 2048, 1024, 416,  win, DM, C_CQ, 0, nullptr);
        zero_rect(win, DM, INW, NZP - INW, 0, DM);
        bf16_t* wup = (bf16_t*)(wl + WL_UP);
        wconv_job(tl, a.in[14] + (size_t)l * 256 * 768, 768, 0, 256, 768, wup, KUP, 0, 0, a.in[12] + l * 256);
        wconv_job(tl, a.in[15] + (size_t)l * 128 * 1024, 1024, 0, 128, 1024, wup, KUP, 768, 256, a.in[13] + l * 128);
        zero_rect(wup, KUP, 0, 768, 256, 128); zero_rect(wup, KUP, 768, 1024, 0, 256);
        wconv_job(tl, a.in[11] + (size_t)l * DM * DM, DM, 0, 1024, 1024, (bf16_t*)(wl + WL_PCAT), 2048, 0, 0, nullptr);
        wconv_job(tl, a.in[18] + (size_t)l * 512 * DM, DM, 0, 512, 1024, (bf16_t*)(wl + WL_PCAT), 2048, 0, 1024, nullptr);
        wconv_job(tl, a.in[21] + (size_t)l * 512 * DM, DM, 0, 512, 1024, (bf16_t*)(wl + WL_PCAT), 2048, 0, 1536, nullptr);
        wconv_job(tl, a.in[23] + (size_t)l * DM * DM, DM, 0, 1024, 1024, (bf16_t*)(wl + WL_OUT), 1024, 0, 0, nullptr);
        for (int nb = 0; nb < 8; ++nb) {
            wconv_job(tl, a.in[6] + ((size_t)l * 8 + nb) * 128 * 128, 128, 0, 128, 128, (bf16_t*)(wl + WL_GX) + nb * 128 * 128, 128, 0, 0, nullptr);
            wconv_job(tl, a.in[8] + ((size_t)l * 8 + nb) * 128 * 128, 128, 0, 128, 128, (bf16_t*)(wl + WL_GA) + nb * 128 * 128, 128, 0, 0, nullptr);
        }
    }
}

DI void p0_rmsnorm(const float* __restrict__ x, const float* __restrict__ g, bf16_t* xn) {
    const int tid = otid(), lane = tid & 63, gw = obid() * 8 + (tid >> 6), nw = gridDim.x * 8;
    f32x4 gv[4];
#pragma unroll
    for (int i = 0; i < 4; ++i) gv[i] = *(const f32x4*)(g + i * 256 + lane * 4);
    for (int row = gw; row < TC; row += nw) {
        const float* xr = x + (size_t)row * DM; f32x4 v[4]; float ss = 0.f;
#pragma unroll
        for (int i = 0; i < 4; ++i) { v[i] = *(const f32x4*)(xr + i * 256 + lane * 4); ss += v[i][0] * v[i][0] + v[i][1] * v[i][1] + v[i][2] * v[i][2] + v[i][3] * v[i][3]; }
        ss = wave_sum(ss); const float rs = rsqrtf(ss * (1.f / DM) + EPS);
#pragma unroll
        for (int i = 0; i < 4; ++i) { u32x2 w; w.x = pk2(v[i][0] * rs * gv[i][0], v[i][1] * rs * gv[i][1]); w.y = pk2(v[i][2] * rs * gv[i][2], v[i][3] * rs * gv[i][3]);
            *(u32x2*)(xn + (size_t)row * DM + i * 256 + lane * 4) = w; }
    }
}

struct EpiZ {
    static constexpr bool PERM = true, AFTER_DRAIN = false, CHAIN = false;
    bf16_t* O; int ldc; int ncols;
    DI void operator()(const f32x4 (&acc)[2][2][4][2], const pg8::Unit& u, int wr, int wc, int fr, int fq) const {
        const int row0 = u.pm * 256 + wr * 64 + fr, col0 = u.pn * 256 + wc * 32 + 8 * fq;
#pragma unroll
        for (int ai = 0; ai < 2; ++ai)
#pragma unroll
            for (int m = 0; m < 4; ++m) { bf16_t* rowp = O + (size_t)(row0 + ai * 128 + m * 16) * ldc;
#pragma unroll
                for (int bj = 0; bj < 2; ++bj) { const int c = col0 + bj * 128; if (c < ncols) { const f32x4 v0 = acc[ai][bj][m][0], v1 = acc[ai][bj][m][1];
                    u32x4 w; w.x = pk2(v0[0], v0[1]); w.y = pk2(v0[2], v0[3]); w.z = pk2(v1[0], v1[1]); w.w = pk2(v1[2], v1[3]); *(u32x4*)(rowp + c) = w; } } }
    }
};
struct EpiChain {
    static constexpr bool PERM = true, AFTER_DRAIN = false, CHAIN = true; static constexpr int T1 = 16, T2 = 24;
    const bf16_t* Z; const float* bm; bf16_t* MB;
    template <bool FIN> DI void run(f32x4 (&acc)[2][2][4][2], const pg8::Unit& u, int br, int wr, int wc, int fr_, int fq_) const {
        int fr = fr_, fq = fq_; asm volatile("" : "+v"(fr), "+v"(fq));
        const int row0 = u.pm * 256 + wr * 64 + fr, col0 = u.pn * 256 + wc * 32 + 8 * fq;
        const float* bmb = bm + br * 1024; const bf16_t* zb = Z + C_MERGE + br * 1024;
#pragma unroll
        for (int bj = 0; bj < 2; ++bj)
#pragma unroll
            for (int n = 0; n < 2; ++n) { const int c = col0 + bj * 128 + 4 * n;
                f32x4 b = *(const f32x4*)(bmb + c) * (-LOG2E), d = b; if (!FIN) d = *(const f32x4*)(bmb + 1024 + c) * (-LOG2E);
#pragma unroll
                for (int ai = 0; ai < 2; ++ai)
#pragma unroll
                    for (int m = 0; m < 4; ++m) { const size_t row = (size_t)(row0 + ai * 128 + m * 16); const bf16_t* zp = zb + row * LDZ + c;
                        const u32x2 gz = *(const u32x2*)zp;
                        f32x4 sc;
                        sc[0] = __builtin_amdgcn_rcpf(1.f + __builtin_amdgcn_exp2f(bflo(gz.x) * (-LOG2E) + b[0])); sc[1] = __builtin_amdgcn_rcpf(1.f + __builtin_amdgcn_exp2f(bfhi(gz.x) * (-LOG2E) + b[1]));
                        sc[2] = __builtin_amdgcn_rcpf(1.f + __builtin_amdgcn_exp2f(bflo(gz.y) * (-LOG2E) + b[2])); sc[3] = __builtin_amdgcn_rcpf(1.f + __builtin_amdgcn_exp2f(bfhi(gz.y) * (-LOG2E) + b[3]));
                        if (!FIN) {
                            const u32x2 hz = *(const u32x2*)(zp + 1024);
                            sc[0] *= 1.f + __builtin_amdgcn_exp2f(bflo(hz.x) * (-LOG2E) + d[0]); sc[1] *= 1.f + __builtin_amdgcn_exp2f(bfhi(hz.x) * (-LOG2E) + d[1]);
                            sc[2] *= 1.f + __builtin_amdgcn_exp2f(bflo(hz.y) * (-LOG2E) + d[2]); sc[3] *= 1.f + __builtin_amdgcn_exp2f(bfhi(hz.y) * (-LOG2E) + d[3]);
                            acc[ai][bj][m][n] *= sc; asm volatile("" : "+v"(acc[ai][bj][m][n]) :: "memory");
                        } else {
                            const f32x4 v = acc[ai][bj][m][n] * sc; u32x2 w; w.x = pk2(v[0], v[1]); w.y = pk2(v[2], v[3]); *(u32x2*)(MB + row * DM + c) = w; }
                        asm volatile("" ::: "memory"); } }
    }
    DI void mid(f32x4 (&acc)[2][2][4][2], const pg8::Unit& u, int t, int wr, int wc, int fr, int fq) const { run<false>(acc, u, t == T1 ? 0 : 1, wr, wc, fr, fq); }
    DI void operator()(f32x4 (&acc)[2][2][4][2], const pg8::Unit& u, int wr, int wc, int fr, int fq) const { run<true>(acc, u, 2, wr, wc, fr, fq); }
};
struct EpiOut {
    static constexpr bool PERM = false, AFTER_DRAIN = false, CHAIN = false;
    const float* X; float* O;
    DI void operator()(const f32x4 (&acc)[2][2][4][2], const pg8::Unit& u, int wr, int wc, int fr, int fq) const {
        const int row0 = u.pm * 256 + wr * 64 + fr, col0 = u.pn * 256 + wc * 32 + 4 * fq;
#pragma unroll
        for (int ai = 0; ai < 2; ++ai)
#pragma unroll
            for (int m = 0; m < 4; ++m) { const size_t ro = (size_t)(row0 + ai * 128 + m * 16) * DM + col0;
#pragma unroll
                for (int bj = 0; bj < 2; ++bj)
#pragma unroll
                    for (int n = 0; n < 2; ++n) { const f32x4 xv = *(const f32x4*)(X + ro + bj * 128 + n * 16); *(f32x4*)(O + ro + bj * 128 + n * 16) = xv + acc[ai][bj][m][n]; } }
    }
};

DI void dil_prep(bf16_t* z, const int* __restrict__ pos, const float* __restrict__ gq, const float* __restrict__ gk) {
    const int tot = TC * 48;
    for (int it = obid() * 512 + otid(); it < tot; it += gridDim.x * 512) {
        const int tok = it / 48, hh = it % 48; const bool isq = hh < 24;
        bf16_t* p = z + (size_t)tok * LDZ + (isq ? C_DQ + hh * 64 : C_DK + (hh - 24) * 64);
        const float* g = isq ? gq : gk;
        float v[64]; float ss = 0.f;
#pragma unroll
        for (int c = 0; c < 8; ++c) { const u32x4 w = *(const u32x4*)(p + c * 8);
            v[c * 8 + 0] = bflo(w.x); v[c * 8 + 1] = bfhi(w.x); v[c * 8 + 2] = bflo(w.y); v[c * 8 + 3] = bfhi(w.y); v[c * 8 + 4] = bflo(w.z); v[c * 8 + 5] = bfhi(w.z); v[c * 8 + 6] = bflo(w.w); v[c * 8 + 7] = bfhi(w.w); }
#pragma unroll
        for (int i = 0; i < 64; ++i) ss += v[i] * v[i];
        const float rs = rsqrtf(ss * (1.f / 64.f) + EPS) * (isq ? 0.125f * LOG2E : 1.f);
        const float fp = (float)pos[tok];
#pragma unroll
        for (int i = 0; i < 32; ++i) { const float inv = exp2f(-(float)i * (LOG2_THETA / 32.f)); float s, c; sincos_rev(fp * inv, s, c);
            const float x1 = v[i] * rs * g[i], x2 = v[i + 32] * rs * g[i + 32]; v[i] = x1 * c - x2 * s; v[i + 32] = x2 * c + x1 * s; }
#pragma unroll
        for (int c = 0; c < 8; ++c) { u32x4 w; w.x = pk2(v[c * 8 + 0], v[c * 8 + 1]); w.y = pk2(v[c * 8 + 2], v[c * 8 + 3]); w.z = pk2(v[c * 8 + 4], v[c * 8 + 5]); w.w = pk2(v[c * 8 + 6], v[c * 8 + 7]);
            *(u32x4*)(p + c * 8) = w; }
    }
}

#define UNPK8(W_, d, o, sc_) { const u32x4 w_ = (W_); d[o + 0] = bflo(w_.x) * (sc_); d[o + 1] = bfhi(w_.x) * (sc_); d[o + 2] = bflo(w_.y) * (sc_); d[o + 3] = bfhi(w_.y) * (sc_); d[o + 4] = bflo(w_.z) * (sc_); d[o + 5] = bfhi(w_.z) * (sc_); d[o + 6] = bflo(w_.w) * (sc_); d[o + 7] = bfhi(w_.w) * (sc_); }
DI float ssq8(u32x4 w) { return bflo(w.x) * bflo(w.x) + bfhi(w.x) * bfhi(w.x) + bflo(w.y) * bflo(w.y) + bfhi(w.y) * bfhi(w.y) + bflo(w.z) * bflo(w.z) + bfhi(w.z) * bfhi(w.z) + bflo(w.w) * bflo(w.w) + bfhi(w.w) * bfhi(w.w); }
DI u32x4 scale8(u32x4 w, float s, const float* __restrict__ g) { u32x4 o; o.x = pk2(bflo(w.x) * s * g[0], bfhi(w.x) * s * g[1]); o.y = pk2(bflo(w.y) * s * g[2], bfhi(w.y) * s * g[3]);
    o.z = pk2(bflo(w.z) * s * g[4], bfhi(w.z) * s * g[5]); o.w = pk2(bflo(w.w) * s * g[6], bfhi(w.w) * s * g[7]); return o; }
DI void rope16(float (&v)[32], const float* __restrict__ g, float fp) {
#pragma unroll
    for (int i = 0; i < 16; ++i) { const float inv = exp2f(-(float)i * (LOG2_THETA / 16.f)); float sn, cs; sincos_rev(fp * inv, sn, cs);
        const float x1 = v[i] * g[i], x2 = v[16 + i] * g[16 + i]; v[i] = x1 * cs - x2 * sn; v[16 + i] = x2 * cs + x1 * sn; }
}
DI void mla_finalize(unsigned char* lds, const bf16_t* z, bf16_t* qf, bf16_t* kvr, bf16_t* kf, const int* __restrict__ pos, const float* __restrict__ gqn_g, const float* __restrict__ gkn_g) {
    float* rst = (float*)lds;
    float* gl = rst + 128; const float* gqn = gl; const float* gkn = gl + 96;
    for (int grp = obid(); grp < TC / 64; grp += gridDim.x) {
        const int tid = otid(), lane = tid & 63, wid = tid >> 6;
        const int t0 = grp * 64;
        const int tl_ = tid >> 3, hd = tid & 7, tok = t0 + tl_;
        bf16_t* pq = qf + (size_t)tok * LDQ + hd * 96; bf16_t* pkv = kvr + (size_t)tok * LDQ + hd * 128; const bf16_t* pkr = z + (size_t)tok * LDZ + C_KR; bf16_t* pk = kf + (size_t)tok * 768 + hd * 96;
        u32x4 rq[12];
#pragma unroll
        for (int c = 0; c < 12; ++c) rq[c] = *(const u32x4*)(pq + c * 8);
        const float fp = (float)pos[tok];
        if (tid < 192) gl[tid] = (tid < 96) ? gqn_g[tid] : gkn_g[tid - 96];
        u32x2 la[8]; unsigned lb[8];
#pragma unroll
        for (int i = 0; i < 8; ++i) { const bf16_t* zr = z + (size_t)(t0 + wid * 8 + i) * LDZ; la[i] = *(const u32x2*)(zr + C_CQ + lane * 4); lb[i] = *(const unsigned*)(zr + C_CKV + lane * 2); }
        __syncthreads();
#pragma unroll
        for (int i = 0; i < 8; ++i) {
            float s1 = bflo(la[i].x) * bflo(la[i].x) + bfhi(la[i].x) * bfhi(la[i].x) + bflo(la[i].y) * bflo(la[i].y) + bfhi(la[i].y) * bfhi(la[i].y), s2 = bflo(lb[i]) * bflo(lb[i]) + bfhi(lb[i]) * bfhi(lb[i]);
            s1 = wave_sum(s1); s2 = wave_sum(s2);
            if (lane == 0) { rst[(wid * 8 + i) * 2] = rsqrtf(s1 * (1.f / 256.f) + EPS); rst[(wid * 8 + i) * 2 + 1] = rsqrtf(s2 * (1.f / 128.f) + EPS); } }
        __syncthreads();
        const float rcq = rst[tl_ * 2], rckv = rst[tl_ * 2 + 1];
        {
            float ss = 0.f;
#pragma unroll
            for (int c = 0; c < 12; ++c) ss += ssq8(rq[c]);
            ss *= rcq * rcq;
            const float rs = rsqrtf(ss * (1.f / 96.f) + EPS) * rcq * (0.10206207261596575f * LOG2E);
#pragma unroll
            for (int c = 0; c < 8; ++c) *(u32x4*)(pq + c * 8) = scale8(rq[c], rs, gqn + c * 8);
            float v[32];
#pragma unroll
            for (int c = 0; c < 4; ++c) { UNPK8(rq[8 + c], v, c * 8, rs) }
            rope16(v, gqn + 64, fp);
#pragma unroll
            for (int c = 0; c < 4; ++c) { u32x4 w; w.x = pk2(v[c * 8 + 0], v[c * 8 + 1]); w.y = pk2(v[c * 8 + 2], v[c * 8 + 3]); w.z = pk2(v[c * 8 + 4], v[c * 8 + 5]); w.w = pk2(v[c * 8 + 6], v[c * 8 + 7]);
                *(u32x4*)(pq + 64 + c * 8) = w; }
        }
        asm volatile("" ::: "memory");
        {
            u32x4 rk[8], rv[8], rr[4];
#pragma unroll
            for (int c = 0; c < 8; ++c) { rk[c] = *(const u32x4*)(pkv + c * 8); rv[c] = *(const u32x4*)(pkv + 64 + c * 8); }
#pragma unroll
            for (int c = 0; c < 4; ++c) rr[c] = *(const u32x4*)(pkr + c * 8);
            float ss = 0.f, sr = 0.f;
#pragma unroll
            for (int c = 0; c < 8; ++c) ss += ssq8(rk[c]);
#pragma unroll
            for (int c = 0; c < 4; ++c) sr += ssq8(rr[c]);
            ss = ss * rckv * rckv + sr;
            const float rs = rsqrtf(ss * (1.f / 96.f) + EPS);
#pragma unroll
            for (int c = 0; c < 8; ++c) *(u32x4*)(pk + c * 8) = scale8(rk[c], rs * rckv, gkn + c * 8);
            float v[32];
#pragma unroll
            for (int c = 0; c < 4; ++c) { UNPK8(rr[c], v, c * 8, rs) }
            rope16(v, gkn + 64, fp);
#pragma unroll
            for (int c = 0; c < 4; ++c) { u32x4 w; w.x = pk2(v[c * 8 + 0], v[c * 8 + 1]); w.y = pk2(v[c * 8 + 2], v[c * 8 + 3]); w.z = pk2(v[c * 8 + 4], v[c * 8 + 5]); w.w = pk2(v[c * 8 + 6], v[c * 8 + 7]);
                *(u32x4*)(pk + 64 + c * 8) = w; }
#pragma unroll
            for (int c = 0; c < 8; ++c) { u32x4 w = rv[c];
                w.x = pk2(bflo(w.x) * rckv, bfhi(w.x) * rckv); w.y = pk2(bflo(w.y) * rckv, bfhi(w.y) * rckv); w.z = pk2(bflo(w.z) * rckv, bfhi(w.z) * rckv); w.w = pk2(bflo(w.w) * rckv, bfhi(w.w) * rckv);
                *(u32x4*)(pkv + 64 + c * 8) = w; }
        }
    }
}

DI void dil_combine(bf16_t* z, const float* __restrict__ lse) {
    const int tot = TC * 64;
    for (int it = obid() * 512 + otid(); it < tot; it += gridDim.x * 512) {
        const int tok = it >> 6, hd = (it >> 3) & 7, dc = it & 7;
        const float l0 = lse[(size_t)tok * 8 + hd], l1 = lse[(size_t)TC * 8 + (size_t)tok * 8 + hd], l2 = lse[(size_t)2 * TC * 8 + (size_t)tok * 8 + hd];
        const float mx = fmaxf(l0, fmaxf(l1, l2)); float w0 = fexp_(l0 - mx), w1 = fexp_(l1 - mx), w2 = fexp_(l2 - mx); const float iw = __builtin_amdgcn_rcpf(w0 + w1 + w2); w0 *= iw; w1 *= iw; w2 *= iw;
        bf16_t* zr = z + (size_t)tok * LDZ;
        const u32x4 a = *(const u32x4*)(zr + C_DQ + (0 * 8 + hd) * 64 + dc * 8), b = *(const u32x4*)(zr + C_DQ + (1 * 8 + hd) * 64 + dc * 8), c = *(const u32x4*)(zr + C_DQ + (2 * 8 + hd) * 64 + dc * 8);
        bf16_t* gp = zr + C_DILG + hd * 64 + dc * 8; const u32x4 g = *(const u32x4*)gp; u32x4 o;
#define CMB(F) { const float e0 = (w0 * bflo(a.F) + w1 * bflo(b.F) + w2 * bflo(c.F)) * siluf_(bflo(g.F)), e1 = (w0 * bfhi(a.F) + w1 * bfhi(b.F) + w2 * bfhi(c.F)) * siluf_(bfhi(g.F)); o.F = pk2(e0, e1); }
        CMB(x) CMB(y) CMB(z) CMB(w)
#undef CMB
        *(u32x4*)gp = o;
    }
}

struct LruP { const float* conv_w; const float* conv_b; const float* b_gx; const float* b_ga; const float* lam; const bf16_t* wgx; const bf16_t* wga; };
constexpr int L_XS = 0, L_XCB = 18432, L_XC = L_XCB + 17408, L_HB = L_XC + 32768, L_CW = L_HB + 32768, L_EX = L_CW + 5 * 128 * 4, L_END = L_EX + 2 * 128 * 8;
static_assert(L_END <= LDS_BYTES, "lru lds");
template <bool FINAL> DI void lru_unit(unsigned char* lds, bf16_t* z, float* agg, const LruP& P, int bl, int n, int grp) {
    const int tid0 = otid();
    bf16_t* xs = (bf16_t*)(lds + L_XS); bf16_t* xcb = (bf16_t*)(lds + L_XCB); float* xc = (float*)(lds + L_XC); float* hb = (float*)(lds + L_HB);
    float* cw = (float*)(lds + L_CW); float2* ex = (float2*)(lds + L_EX);
    __syncthreads();
    const int tid = tid0, lane = tid & 63, wid = tid >> 6, r = lane & 31, h = lane >> 5, ct = wid & 3, rt = wid >> 2;
    for (int i = tid; i < 640; i += 512) cw[i] = (i < 512) ? P.conv_w[(i >> 7) * 1024 + n * 128 + (i & 127)] : P.conv_b[n * 128 + (i & 127)];
    bf16x8 bx[8], ba[8];
    { const bf16_t* wx = P.wgx + (size_t)n * 16384 + (size_t)(ct * 32 + r) * 128 + 8 * h; const bf16_t* wa = P.wga + (size_t)n * 16384 + (size_t)(ct * 32 + r) * 128 + 8 * h;
#pragma unroll
      for (int s = 0; s < 8; ++s) { bx[s] = *(const bf16x8*)(wx + 16 * s); ba[s] = *(const bf16x8*)(wa + 16 * s); } }
    const int ch = ct * 32 + r, chg = n * 128 + ch; const float bgx = P.b_gx[chg], bga = P.b_ga[chg]; const float sp = __logf(1.f + __expf(-P.lam[chg]));
    float hrun = 0.f, Arun = 1.f;
    if (FINAL) {
#pragma unroll
        for (int g2 = 0; g2 < 7; ++g2) if (g2 < grp) { const float2 ab = *(const float2*)(agg + ((size_t)(bl * 8 + g2) * 1024 + chg) * 2); hrun = ab.x * hrun + ab.y; } }
    const size_t rowb = (size_t)bl * SEQ;
    u32x4 xr[3], gr[2];
#define LRU_XLOAD(J) { _Pragma("unroll") for (int q = 0; q < 3; ++q) { const int c = tid + q * 512; const int i = c >> 4, cc = c & 15; const int p = (J) * 64 - 3 + i; \
        xr[q] = (u32x4){0u, 0u, 0u, 0u}; if (c < 67 * 16 && p >= 0) xr[q] = *(const u32x4*)(z + (rowb + p) * LDZ + C_LRUX + n * 128 + cc * 8); } }
#pragma unroll
    for (int s = 0; s < 8; ++s) asm volatile("" :: "v"(bx[s]), "v"(ba[s]));
    asm volatile("" :: "v"(bgx), "v"(bga), "v"(sp), "v"(hrun));
    LRU_XLOAD(grp * 8)
    __syncthreads();
#pragma unroll 1
    for (int jt = 0; jt < 8; ++jt) {
        int tq = tid0; asm volatile("" : "+v"(tq));
        const int tid = tq, lane = tid & 63, wid = tid >> 6, r = lane & 31, h = lane >> 5, ct = wid & 3, rt = wid >> 2, ch = ct * 32 + r;
        const int j = grp * 8 + jt; const size_t row0 = rowb + (size_t)j * 64;
#pragma unroll
        for (int q = 0; q < 3; ++q) { const int c = tid + q * 512; if (c < 67 * 16) *(u32x4*)(xs + (c >> 4) * 136 + (c & 15) * 8) = xr[q]; }
        lds_barrier();
        if (jt + 1 < 8) LRU_XLOAD(j + 1)
        if (FINAL) {
#pragma unroll
            for (int q = 0; q < 2; ++q) { const int c = tid + q * 512; gr[q] = *(const u32x4*)(z + (row0 + (c >> 4)) * LDZ + C_LRUG + n * 128 + (c & 15) * 8); } }
        {
            const int i = tid >> 3, c0 = (tid & 7) * 16; float acc[16];
#pragma unroll
            for (int q = 0; q < 4; ++q) { const f32x4 b = *(const f32x4*)(cw + 512 + c0 + q * 4); acc[q * 4] = b[0]; acc[q * 4 + 1] = b[1]; acc[q * 4 + 2] = b[2]; acc[q * 4 + 3] = b[3]; }
#pragma unroll
            for (int k = 0; k < 4; ++k) {
                const u32x4 xa = *(const u32x4*)(xs + (i + k) * 136 + c0), xb = *(const u32x4*)(xs + (i + k) * 136 + c0 + 8);
                const float xv[16] = {bflo(xa.x), bfhi(xa.x), bflo(xa.y), bfhi(xa.y), bflo(xa.z), bfhi(xa.z), bflo(xa.w), bfhi(xa.w), bflo(xb.x), bfhi(xb.x), bflo(xb.y), bfhi(xb.y), bflo(xb.z), bfhi(xb.z), bflo(xb.w), bfhi(xb.w)};
#pragma unroll
                for (int q = 0; q < 4; ++q) { const f32x4 w = *(const f32x4*)(cw + k * 128 + c0 + q * 4);
                    acc[q * 4] += w[0] * xv[q * 4]; acc[q * 4 + 1] += w[1] * xv[q * 4 + 1]; acc[q * 4 + 2] += w[2] * xv[q * 4 + 2]; acc[q * 4 + 3] += w[3] * xv[q * 4 + 3]; } }
#pragma unroll
            for (int q = 0; q < 4; ++q) *(f32x4*)(xc + i * 128 + c0 + q * 4) = (f32x4){acc[q * 4], acc[q * 4 + 1], acc[q * 4 + 2], acc[q * 4 + 3]};
            u32x4 w0, w1; w0.x = pk2(acc[0], acc[1]); w0.y = pk2(acc[2], acc[3]); w0.z = pk2(acc[4], acc[5]); w0.w = pk2(acc[6], acc[7]);
            w1.x = pk2(acc[8], acc[9]); w1.y = pk2(acc[10], acc[11]); w1.z = pk2(acc[12], acc[13]); w1.w = pk2(acc[14], acc[15]);
            *(u32x4*)(xcb + i * 136 + c0) = w0; *(u32x4*)(xcb + i * 136 + c0 + 8) = w1;
        }
        lds_barrier();
        float av[16], bv[16], Ao[4], Ho[4], Ap[4], Hp[4];
        {
            f32x16 gx, ga;
#pragma unroll
            for (int i = 0; i < 16; ++i) { gx[i] = 0.f; ga[i] = 0.f; }
#pragma unroll
            for (int s = 0; s < 8; ++s) { const bf16x8 a = *(const bf16x8*)(xcb + (rt * 32 + r) * 136 + 16 * s + 8 * h); gx = MFMA32(a, bx[s], gx); ga = MFMA32(a, ba[s], ga); }
#pragma unroll
            for (int i = 0; i < 16; ++i) { const int tk = rt * 32 + crow(i, h);
                const float vgx = sigmoidf_(gx[i] + bgx), vga = sigmoidf_(ga[i] + bga); const float la = -8.f * vga * sp; av[i] = fexp_(la);
                const float mult = __builtin_amdgcn_sqrtf(fmaxf(1.f - fexp_(2.f * la), 0.f));
                bv[i] = mult * vgx * xc[tk * 128 + ch]; }
        }
#pragma unroll
        for (int g = 0; g < 4; ++g) { float H = 0.f, A = 1.f;
#pragma unroll
            for (int k = 0; k < 4; ++k) { H = av[4 * g + k] * H + bv[4 * g + k]; A *= av[4 * g + k]; }
            Ao[g] = A; Ho[g] = H; Ap[g] = __shfl_xor(A, 32); Hp[g] = __shfl_xor(H, 32); }
        {   float c = 0.f, At = 1.f;
#pragma unroll
            for (int g = 0; g < 4; ++g) { const float A1 = h ? Ap[g] : Ao[g], H1 = h ? Hp[g] : Ho[g], A2 = h ? Ao[g] : Ap[g], H2 = h ? Ho[g] : Hp[g]; c = A1 * c + H1; c = A2 * c + H2; At *= A1 * A2; }
            if (h == 0) ex[rt * 128 + ch] = make_float2(At, c); }
        lds_barrier();
        {   const float2 e0 = ex[ch], e1 = ex[128 + ch]; const float hmid = e0.x * hrun + e0.y;
            float c = rt ? hmid : hrun;
            hrun = e1.x * hmid + e1.y; Arun *= e0.x * e1.x;
            if (FINAL) {
#pragma unroll
                for (int g = 0; g < 4; ++g) { const float A1 = h ? Ap[g] : Ao[g], H1 = h ? Hp[g] : Ho[g], A2 = h ? Ao[g] : Ap[g], H2 = h ? Ho[g] : Hp[g];
                    const float c1 = A1 * c + H1; float hh = h ? c1 : c; c = A2 * c1 + H2;
#pragma unroll
                    for (int k = 0; k < 4; ++k) { hh = av[4 * g + k] * hh + bv[4 * g + k]; hb[(rt * 32 + 8 * g + 4 * h + k) * 128 + ch] = hh; } } } }
        if (FINAL) {
            lds_barrier();
#pragma unroll
            for (int q = 0; q < 2; ++q) { const int c = tid + q * 512; const int i = c >> 4, cc = c & 15; bf16_t* gp = z + (row0 + i) * LDZ + C_LRUG + n * 128 + cc * 8; const u32x4 g = gr[q];
                const f32x4 h0 = *(const f32x4*)(hb + i * 128 + cc * 8), h1 = *(const f32x4*)(hb + i * 128 + cc * 8 + 4); u32x4 o;
                o.x = pk2(h0[0] * siluf_(bflo(g.x)), h0[1] * siluf_(bfhi(g.x))); o.y = pk2(h0[2] * siluf_(bflo(g.y)), h0[3] * siluf_(bfhi(g.y)));
                o.z = pk2(h1[0] * siluf_(bflo(g.z)), h1[1] * siluf_(bfhi(g.z))); o.w = pk2(h1[2] * siluf_(bflo(g.w)), h1[3] * siluf_(bfhi(g.w))); *(u32x4*)gp = o; }
        }
    }
#undef LRU_XLOAD
    if (!FINAL && h == 0 && rt == 0) *(float2*)(agg + ((size_t)(bl * 8 + grp) * 1024 + chg) * 2) = make_float2(Arun, hrun);
}

typedef short s16x4 __attribute__((ext_vector_type(4)));
DI s16x4 vtr(const bf16_t* p) { return __builtin_amdgcn_ds_read_tr16_b64_v4i16((__attribute__((address_space(3))) s16x4*)p); }
template <int DK, bool WIN, bool MLA>
DI void attn_unit(unsigned char* lds, const bf16_t* Qb, size_t qs, const bf16_t* Kb, size_t ks, const bf16_t* Vb, size_t vs, int q0, bf16_t* Ob, size_t os, float* lsep, size_t lses, const float CS) {
    constexpr int KLD = DK + 8, VLD = 72, KC = DK / 8, KCH = 64 * KC, KBYTES = 64 * KLD * 2, BUFB = KBYTES + 64 * VLD * 2;
    const int tid = otid(), lane = tid & 63, wid = tid >> 6, r = lane & 31, h = lane >> 5;
    const int qw = q0 + 32 * wid;
    bf16x8 qf[DK / 16];
    { const bf16_t* qrow = Qb + (size_t)(qw + r) * qs + 8 * h;
#pragma unroll
      for (int s = 0; s < DK / 16; ++s) qf[s] = *(const bf16x8*)(qrow + 16 * s); }
    f32x16 o[2];
#pragma unroll
    for (int i = 0; i < 16; ++i) { o[0][i] = 0.f; o[1][i] = 0.f; }
    float lrow = 0.f;
    const int kt_lo = WIN ? (q0 >= 128 ? (q0 - 128) / 64 : 0) : 0, kt_hi = (q0 + 255) / 64, ntile = kt_hi - kt_lo + 1;
    const int k0r = tid / KC, k0c = tid % KC, k1r = (tid + 512) / KC, k1c = (tid + 512) % KC; const bool k1v = (tid + 512) < KCH;
    const int vkey = tid >> 3, vdc = tid & 7;
    const int koff0 = k0r * KLD + k0c * 8, koff1 = k1r * KLD + k1c * 8, voff = vkey * VLD + vdc * 8;
    const int kfrag = r * KLD + 8 * h, vfrag = (4 * h + ((lane & 15) >> 2)) * VLD + 16 * ((lane >> 4) & 1) + 4 * (lane & 3);
    u32x4 kreg0, kreg1 = (u32x4){0u, 0u, 0u, 0u}, vreg;
#define ATT_GLOAD(KT) { const size_t kb = (size_t)(KT) * 64; kreg0 = *(const u32x4*)(Kb + (kb + k0r) * ks + k0c * 8); if (k1v) kreg1 = *(const u32x4*)(Kb + (kb + k1r) * ks + k1c * 8); \
                        vreg = *(const u32x4*)(Vb + (kb + vkey) * vs + vdc * 8); }
#define ATT_LWRITE(SLOT) { bf16_t* kp_ = (bf16_t*)(lds + (SLOT) * BUFB); bf16_t* vp_ = (bf16_t*)(lds + (SLOT) * BUFB + KBYTES); \
                        *(u32x4*)(kp_ + koff0) = kreg0; if (k1v) *(u32x4*)(kp_ + koff1) = kreg1; *(u32x4*)(vp_ + voff) = vreg; }
#pragma unroll
    for (int s = 0; s < DK / 16; ++s) asm volatile("" :: "v"(qf[s]));
    ATT_GLOAD(kt_lo)
    __syncthreads();
    ATT_LWRITE(0)
    if (ntile > 1) ATT_GLOAD(kt_lo + 1)
#pragma unroll 1
    for (int it = 0; it < ntile; ++it) {
        const int kbase = (kt_lo + it) * 64;
        lds_barrier();
        if (it + 1 < ntile) { ATT_LWRITE((it + 1) & 1) if (it + 2 < ntile) ATT_GLOAD(kt_lo + it + 2) }
        const bool active = (kbase <= qw + 31) && (!WIN || kbase + 63 >= qw - 128);
        if (active) {
            const bf16_t* Ks = (const bf16_t*)(lds + (it & 1) * BUFB) + kfrag; const bf16_t* Vs = (const bf16_t*)(lds + (it & 1) * BUFB + KBYTES) + vfrag;
            f32x16 x[2];
#pragma unroll
            for (int kt2 = 0; kt2 < 2; ++kt2) {
#pragma unroll
                for (int i = 0; i < 16; ++i) x[kt2][i] = -CS;
#pragma unroll
                for (int s = 0; s < DK / 16; ++s) { const bf16x8 a = *(const bf16x8*)(Ks + kt2 * 32 * KLD + 16 * s); x[kt2] = MFMA32(a, qf[s], x[kt2]); } }
            const int qi = qw + r;
            const bool need_mask = (kbase + 63 > qw) || (WIN && kbase < qw + 31 - 128);
            if (need_mask) {
#pragma unroll
                for (int kt2 = 0; kt2 < 2; ++kt2)
#pragma unroll
                    for (int i = 0; i < 16; ++i) { const int key = kbase + kt2 * 32 + crow(i, h); const bool ok = (key <= qi) && (!WIN || key >= qi - 128);
                        x[kt2][i] = ok ? x[kt2][i] : -INFINITY; }
            }
#pragma unroll
            for (int kt2 = 0; kt2 < 2; ++kt2)
#pragma unroll
                for (int i = 0; i < 16; ++i) { const float p = __builtin_amdgcn_exp2f(x[kt2][i]); x[kt2][i] = p; lrow += p; }
#pragma unroll
            for (int kt2 = 0; kt2 < 2; ++kt2)
#pragma unroll
                for (int s = 0; s < 2; ++s) {
                    u32x4 pw; pw.x = pk2(x[kt2][8 * s + 0], x[kt2][8 * s + 1]); pw.y = pk2(x[kt2][8 * s + 2], x[kt2][8 * s + 3]); pw.z = pk2(x[kt2][8 * s + 4], x[kt2][8 * s + 5]); pw.w = pk2(x[kt2][8 * s + 6], x[kt2][8 * s + 7]);
                    const bf16x8 pb = __builtin_bit_cast(bf16x8, pw);
#pragma unroll
                    for (int n = 0; n < 2; ++n) { const bf16_t* vp = Vs + (kt2 * 32 + 16 * s) * VLD + 32 * n;
                        const s16x4 lo = vtr(vp), hi = vtr(vp + 8 * VLD);
                        const bf16x8 av = __builtin_shufflevector(lo, hi, 0, 1, 2, 3, 4, 5, 6, 7);
                        o[n] = MFMA32(av, pb, o[n]); } }
        }
    }
#undef ATT_GLOAD
#undef ATT_LWRITE
    lrow += __shfl_xor(lrow, 32);
    const float inv = __builtin_amdgcn_rcpf(lrow); const size_t orow = (size_t)(qw + r) * os;
#pragma unroll
    for (int n = 0; n < 2; ++n)
#pragma unroll
        for (int g4 = 0; g4 < 4; ++g4) { const int dv = n * 32 + g4 * 8 + 4 * h; bf16_t* op = Ob + orow + dv;
            float e0 = o[n][g4 * 4] * inv, e1 = o[n][g4 * 4 + 1] * inv, e2 = o[n][g4 * 4 + 2] * inv, e3 = o[n][g4 * 4 + 3] * inv;
            if (MLA) { const u32x2 g = *(const u32x2*)op; e0 *= siluf_(bflo(g.x)); e1 *= siluf_(bfhi(g.x)); e2 *= siluf_(bflo(g.y)); e3 *= siluf_(bfhi(g.y)); }
            u32x2 w; w.x = pk2(e0, e1); w.y = pk2(e2, e3); *(u32x2*)op = w; }
    if (!MLA) { if (h == 0) lsep[(size_t)(qw + r) * lses] = (CS + __log2f(lrow)) * LN2; }
}

DI void gsync(unsigned* ctr, unsigned& target) {
    asm volatile("s_waitcnt vmcnt(0)" ::: "memory");
    __syncthreads();
    target += gridDim.x;
    if (threadIdx.x == 0) {
        __builtin_amdgcn_fence(__ATOMIC_RELEASE, "agent");
        asm volatile("s_waitcnt vmcnt(0)" ::: "memory");
        (void)__hip_atomic_fetch_add(ctr, 1u, __ATOMIC_RELAXED, __HIP_MEMORY_SCOPE_AGENT);
        while (__hip_atomic_load(ctr, __ATOMIC_RELAXED, __HIP_MEMORY_SCOPE_AGENT) < target) __builtin_amdgcn_s_sleep(1);
        __builtin_amdgcn_fence(__ATOMIC_ACQUIRE, "agent");
        asm volatile("s_waitcnt vmcnt(0)" ::: "memory");
    }
    __syncthreads();
}

__global__ void __launch_bounds__(512, 2) hybrid_fwd(Args a) {
    extern __shared__ __attribute__((aligned(16))) unsigned char lds_raw[];
    cg::grid_group grid = cg::this_grid();
    unsigned char* lds = lds_raw; PG8_LAS unsigned char* ldsl = (PG8_LAS unsigned char*)lds_raw;
    const int G = gridDim.x;
#define bx obid()
    unsigned char* ws = a.ws;
    bf16_t* z = (bf16_t*)(ws + WS_Z); unsigned char* sc = ws + WS_S;
    bf16_t* xn = (bf16_t*)(sc + S_XN); bf16_t* qf = (bf16_t*)(sc + S_QF); bf16_t* kvr = qf + 768; bf16_t* kf = (bf16_t*)(sc + S_KF);
    float* agg = (float*)(sc + S_AGG); float* lse = (float*)(sc + S_LSE); float* mrg = (float*)(sc + S_MRG); bf16_t* mb = (bf16_t*)(sc + S_MB);
    const int* positions = (const int*)a.in[1];

    unsigned* gctr = (unsigned*)(ws + WS_CTL); unsigned gtarget = 0;
    if (blockIdx.x == 0 && threadIdx.x == 0) __hip_atomic_store(gctr, 0u, __ATOMIC_RELAXED, __HIP_MEMORY_SCOPE_AGENT);
    unsigned long long tacc = 0, tprev = 0; if (PROBE_K >= 0) tprev = __builtin_amdgcn_s_memrealtime();
    prologue_weights(a, lds);
    if (PROBE_K == 0) { grid.sync(); PSTAMP(0); }
#pragma unroll 1
    for (int l = 0; l < DEPTH; ++l) {
#pragma unroll 1
        for (int c = 0; c < NCHUNK; ++c) {
            int lo = l; asm volatile("" : "+s"(lo));
            const unsigned char* wl = ws + WS_W + (size_t)lo * WL_SIZE;
            const size_t roff = (size_t)c * TC;
            const float* xin = (l == 0 ? a.in[0] : a.out) + roff * DM; float* xout = a.out + roff * DM; const int* pos = positions + roff;
            p0_rmsnorm(xin, a.in[2] + lo * DM, xn);
            if (l == 0 && c == 0) grid.sync(); else gsync(gctr, gtarget);
            PSTAMP(1);
            { pg8::Gemm g; g.A = xn; g.Bt = (const bf16_t*)(wl + WL_IN); g.M = TC; g.N = NZP; g.K = DM; g.lda = DM;
              pg8::StaticOrder S; S.init(TC, NZP, G, bx); EpiZ E; E.O = z; E.ldc = LDZ; E.ncols = INW;
              pg8::gemm_phase<EpiZ, pg8::StaticOrder, true, true>(ldsl, g, S, E); }
            gsync(gctr, gtarget); PSTAMP(2);
            { pg8::Gemm g; g.A = z + C_CQ; g.Bt = (const bf16_t*)(wl + WL_UP); g.M = TC; g.N = NUP; g.K = KUP; g.lda = LDZ;
              pg8::StaticOrder S; S.init(TC, NUP, G, bx); EpiZ E; E.O = qf; E.ldc = LDQ; E.ncols = NUP;
              pg8::gemm_phase<EpiZ, pg8::StaticOrder, true, true>(ldsl, g, S, E); }
            __syncthreads();
            dil_prep(z, pos, a.in[19] + lo * 64, a.in[20] + lo * 64);
            LruP lp; lp.conv_w = a.in[4] + (size_t)lo * 4 * 1024; lp.conv_b = a.in[5] + lo * 1024; lp.b_gx = a.in[7] + lo * 1024; lp.b_ga = a.in[9] + lo * 1024; lp.lam = a.in[10] + lo * 1024;
            lp.wgx = (const bf16_t*)(wl + WL_GX); lp.wga = (const bf16_t*)(wl + WL_GA);
            for (int u = bx; u < NB * 64; u += G) lru_unit<false>(lds, z, agg, lp, u >> 6, (u >> 3) & 7, u & 7);
            gsync(gctr, gtarget); PSTAMP(3);
            mla_finalize(lds, z, qf, kvr, kf, pos, a.in[16] + lo * 96, a.in[17] + lo * 96);
            gsync(gctr, gtarget); PSTAMP(4);
            float cs_mla, cs_dil;
            { float mq = 0.f, mk = 0.f, dq_ = 0.f, dk_ = 0.f; const float* g1 = a.in[16] + lo * 96; const float* g2 = a.in[17] + lo * 96; const float* g3 = a.in[19] + lo * 64; const float* g4 = a.in[20] + lo * 64;
              for (int i = 0; i < 96; ++i) { mq = fmaxf(mq, fabsf(g1[i])); mk = fmaxf(mk, fabsf(g2[i])); }
              for (int i = 0; i < 64; ++i) { dq_ = fmaxf(dq_, fabsf(g3[i])); dk_ = fmaxf(dk_, fabsf(g4[i])); }
              cs_mla = 96.f * 0.10206207261596575f * LOG2E * mq * mk; cs_dil = 64.f * 0.125f * LOG2E * dq_ * dk_; }
            for (int u = bx; u < 512 + NB * 384; u += G) {
                if (u < 512) {
                    int qb, bh; if (u < 256) { qb = 15 - (u >> 5); bh = u & 31; } else { qb = (u - 256) >> 5; bh = (u - 256) & 31; }
                    const int bl = bh >> 3, hd = bh & 7; const size_t t0 = (size_t)bl * SEQ;
                    attn_unit<96, false, true>(lds, qf + t0 * LDQ + hd * 96, LDQ, kf + t0 * 768 + hd * 96, 768, kvr + t0 * LDQ + hd * 128 + 64, LDQ, qb * 256,
                                               z + t0 * LDZ + C_MLAG + hd * 64, LDZ, nullptr, 0, cs_mla);
                } else {
                    const int v = u - 512, bl = v / 384, w = v % 384, gi = w >> 7, w2 = w & 127, hd = w2 >> 4, rem = w2 & 15;
                    const int d = 1 << (2 * gi), npairs = 16 >> (2 * gi), r = rem / npairs, pair = rem % npairs, head = gi * 8 + hd;
                    const size_t brow = (size_t)bl * SEQ + r; bf16_t* zb = z + brow * LDZ + head * 64; const size_t st = (size_t)d * LDZ;
                    attn_unit<64, true, false>(lds, zb + C_DQ, st, zb + C_DK, st, zb + C_DV, st, pair * 256, zb + C_DQ, st, lse + (size_t)gi * TC * 8 + brow * 8 + hd, (size_t)d * 8, cs_dil);
                }
            }
            gsync(gctr, gtarget); PSTAMP(5);
            dil_combine(z, lse);
            for (int u = bx; u < NB * 64; u += G) lru_unit<true>(lds, z, agg, lp, u >> 6, (u >> 3) & 7, u & 7);
            gsync(gctr, gtarget); PSTAMP(6);
            { pg8::Gemm g; g.A = z + C_LRUG; g.Bt = (const bf16_t*)(wl + WL_PCAT); g.M = TC; g.N = DM; g.K = 2048; g.lda = LDZ;
              pg8::StaticOrder S; S.init(TC, DM, G, bx); EpiChain E; E.Z = z; E.bm = a.in[22] + (size_t)lo * 3072; E.MB = mb;
              pg8::gemm_phase<EpiChain, pg8::StaticOrder, true, true>(ldsl, g, S, E); }
            gsync(gctr, gtarget); PSTAMP(7);
            { pg8::Gemm g; g.A = mb; g.Bt = (const bf16_t*)(wl + WL_OUT); g.M = TC; g.N = DM; g.K = DM; g.lda = DM;
              pg8::StaticOrder S; S.init(TC, DM, G, bx); EpiOut E; E.X = xin; E.O = xout;
              pg8::gemm_phase<EpiOut, pg8::StaticOrder, true, true>(ldsl, g, S, E); }
            __syncthreads();
            if (PROBE_K == 8) { grid.sync(); PSTAMP(8); }
        }
    }
    if (PROBE_K >= 0 && blockIdx.x == 0 && threadIdx.x == 0) { const unsigned long long t0 = __builtin_amdgcn_s_memrealtime(); while (__builtin_amdgcn_s_memrealtime() - t0 < tacc) __builtin_amdgcn_s_sleep(8); }
}

extern "C" void kernel_launch(void* const* d_in, const int* in_sizes, int n_in, void* d_out, int out_size, void* d_ws, size_t ws_size, hipStream_t stream) {
    static int grid_blocks = 0;
    if (!grid_blocks) {
        int dev = 0, cus = 0, per_cu = 0;
        (void)hipGetDevice(&dev);
        (void)hipDeviceGetAttribute(&cus, hipDeviceAttributeMultiprocessorCount, dev);
        if (hipFuncSetAttribute((const void*)hybrid_fwd, hipFuncAttributeMaxDynamicSharedMemorySize, LDS_BYTES) != hipSuccess) fprintf(stderr, "hipFuncSetAttribute failed\n");
        if (hipOccupancyMaxActiveBlocksPerMultiprocessor(&per_cu, (const void*)hybrid_fwd, 512, LDS_BYTES) != hipSuccess || per_cu < 1) per_cu = 1;
        grid_blocks = cus * 1;
        if (ws_size < WS_NEED) fprintf(stderr, "workspace too small: %zu < %zu\n", ws_size, (size_t)WS_NEED);
    }
    if (ws_size < WS_NEED || n_in < 24) return;
    Args a{};
    for (int i = 0; i < 24; ++i) a.in[i] = (const float*)d_in[i];
    a.out = (float*)d_out; a.ws = (unsigned char*)d_ws;
    void* args[] = {&a};
    hipError_t e = hipLaunchCooperativeKernel((const void*)hybrid_fwd, dim3(grid_blocks), dim3(512), args, LDS_BYTES, stream);
    if (e != hipSuccess) fprintf(stderr, "cooperative launch failed: %s (grid %d)\n", hipGetErrorString(e), grid_blocks);
}
```

```cpp
#include <hip/hip_runtime.h>
#include <hip/hip_cooperative_groups.h>
#include <cstdio>
#include <cstdint>
namespace cg = cooperative_groups;
__device__ __forceinline__ int otid() { int t = threadIdx.x; asm volatile("" : "+v"(t)); return t; }
__device__ __forceinline__ int obid() { int b = blockIdx.x; asm volatile("" : "+s"(b)); return b; }
namespace pg8 {
#define PG8_LAS __attribute__((address_space(3)))
typedef unsigned short bf16_t;
typedef short bf16x8 __attribute__((ext_vector_type(8)));
typedef float f32x4 __attribute__((ext_vector_type(4)));
typedef unsigned u32x4 __attribute__((ext_vector_type(4)));
constexpr int BM = 256, BK = 64, HALF = 128, HTB = HALF * BK * 2  , STAGE_BYTES = 8 * HTB, NXCD = 8, WGM = 8;

__host__ __device__ __forceinline__ int lds_byte(int r, int c) { const int st = (r >> 4) * 2 + (c >> 5), rr = r & 15, cc = c & 31, ob = rr * 64 + cc * 2; return st * 1024 + (ob ^ (((ob >> 9) & 1) << 5)); }
__host__ __device__ __forceinline__ void stage_rc(int b, int& R, int& C) { const int st = b / 1024, sb = b % 1024, swz = sb ^ (((sb >> 9) & 1) << 5); R = (st >> 1) * 16 + swz / 64; C = (st & 1) * 32 + (swz % 64) / 2; }
__host__ __device__ __forceinline__ int perm32(int rho) { const int n = rho >> 4, i = rho & 15; return 8 * (i >> 2) + 4 * n + (i & 3); }

struct Unit { int pm, pn; };
struct Gemm { const bf16_t* A; const bf16_t* Bt; int M, N, K, lda; };

struct StaticOrder {
    int nM, nN, nwg, G, c;
    __host__ __device__ void init(int M, int N, int G_, int c_) { nM = M / BM; nN = N / BM; nwg = nM * nN; G = G_; c = c_; }
    __host__ __device__ bool next(int i, Unit& u) const {
        const long L = (long)i * G + c; if (L >= nwg) return false;
        int wgid = (int)L; { const int q = nwg / NXCD, r = nwg % NXCD, xcd = wgid % NXCD, off = wgid / NXCD; wgid = (xcd < r ? xcd * (q + 1) : r * (q + 1) + (xcd - r) * q) + off; }
        const int nig = WGM * nN, gid = wgid / nig, fm = gid * WGM, gsz = (nM - fm) < WGM ? (nM - fm) : WGM;
        u.pm = fm + ((wgid % nig) % gsz); u.pn = (wgid % nig) / gsz; return true;
    }
    __device__ __forceinline__ void a_ready(const Unit&) const {}
    __device__ __forceinline__ void done(const Unit&) const {}
};
__device__ __forceinline__ unsigned cvt_pk_bf16(float lo, float hi) { unsigned r; asm volatile("v_cvt_pk_bf16_f32 %0, %1, %2" : "=v"(r) : "v"(lo), "v"(hi)); return r; }
template <class Epi, class Sched, bool ALIGN_EPI = false, bool SP2 = false>
__device__ __forceinline__ void gemm_body(PG8_LAS unsigned char* lds, const Gemm g, const Sched& S, const Epi& E, f32x4 (&acc)[2][2][4][2], const bool zero_init) {
    const int tid = otid(), wid = __builtin_amdgcn_readfirstlane(tid >> 6), lane = tid & 63, wr = wid >> 2, wc = wid & 3, fr = lane & 15, fq = lane >> 4;
    const int K = g.K, nt = K / BK;
    unsigned voffA[2], voffB[2];
#pragma unroll
    for (int i = 0; i < 2; ++i) { int R, C; stage_rc(tid * 16 + i * 8192, R, C); const int Rb = Epi::PERM ? ((R & ~31) + perm32(R & 31)) : R;
        voffA[i] = (unsigned)(R * g.lda + C) * 2u; voffB[i] = (unsigned)(Rb * K + C) * 2u; }
    const size_t kstep = (size_t)(BK * 2);
    const size_t hstepA = (size_t)HALF * g.lda * 2, hstepB = (size_t)HALF * K * 2;
    const size_t tstepA = 2 * hstepA, tstepB = 2 * hstepB;
    const unsigned ldsw = (unsigned)wid * 1024u;
    const int aoff = lds_byte(wr * 64 + fr, fq * 8), boff = lds_byte(wc * 32 + fr, fq * 8);
#define PG8_SA(b, h) (((b) * 2 + (h)) * HTB)
#define PG8_SB(b, h) ((4 + (b) * 2 + (h)) * HTB)
#define PG8_STAGE(bufoff, gbase, voff) do { _Pragma("unroll") for (int _i = 0; _i < 2; ++_i) \
        __builtin_amdgcn_global_load_lds((const unsigned*)((const char*)(gbase) + (voff)[_i]), (PG8_LAS unsigned*)(lds + (bufoff) + ldsw + _i * 8192), 16, 0, 0); } while (0)
#define PG8_LDA(dst, b, h) do { _Pragma("unroll") for (int m = 0; m < 4; ++m) _Pragma("unroll") for (int k = 0; k < 2; ++k) dst[m][k] = *(const PG8_LAS bf16x8*)(lds + PG8_SA(b, h) + aoff + m * 2048 + k * 1024); } while (0)
#define PG8_LDB(dst, b, h) do { _Pragma("unroll") for (int n = 0; n < 2; ++n) _Pragma("unroll") for (int k = 0; k < 2; ++k) dst[n][k] = *(const PG8_LAS bf16x8*)(lds + PG8_SB(b, h) + boff + n * 2048 + k * 1024); } while (0)
#define PG8_MMA(ai, bj, At, Bt) do { __builtin_amdgcn_s_setprio(1); _Pragma("unroll") for (int m = 0; m < 4; ++m) _Pragma("unroll") for (int n = 0; n < 2; ++n) _Pragma("unroll") for (int k = 0; k < 2; ++k) \
        acc[ai][bj][m][n] = __builtin_amdgcn_mfma_f32_16x16x32_bf16(Bt[n][k], At[m][k], acc[ai][bj][m][n], 0, 0, 0); __builtin_amdgcn_s_setprio(0); } while (0)
#define PG8_WAIT_V(n) asm volatile("s_waitcnt vmcnt(" #n ")" ::: "memory")
#define PG8_WAIT_L(n) asm volatile("s_waitcnt lgkmcnt(" #n ")" ::: "memory")
#define PG8_BAR __builtin_amdgcn_s_barrier()
#define PG8_SCHED __builtin_amdgcn_sched_barrier(0)
    Unit cur, nxt; int ui = 0;
    if (!S.next(0, cur)) return;
    if (zero_init) {
#pragma unroll
    for (int a = 0; a < 2; ++a)
#pragma unroll
        for (int b = 0; b < 2; ++b)
#pragma unroll
            for (int m = 0; m < 4; ++m)
#pragma unroll
                for (int n = 0; n < 2; ++n) acc[a][b][m][n] = (f32x4){0.f, 0.f, 0.f, 0.f};
    }
    bf16x8 At[4][2], B0[2][2], B1[2][2];
    const char* cA = (const char*)g.A + (size_t)cur.pm * tstepA; const char* cB = (const char*)g.Bt + (size_t)cur.pn * tstepB;
    S.a_ready(cur);
    if constexpr (SP2) {
        PG8_STAGE(PG8_SB(0, 0), cB, voffB); PG8_STAGE(PG8_SB(0, 1), cB + hstepB, voffB); PG8_STAGE(PG8_SA(0, 0), cA, voffA); PG8_STAGE(PG8_SA(0, 1), cA + hstepA, voffA);
        if (wr == 1) PG8_BAR;
        PG8_WAIT_V(2); PG8_BAR;
        PG8_STAGE(PG8_SB(1, 0), cB + kstep, voffB); PG8_STAGE(PG8_SA(1, 0), cA + kstep, voffA); PG8_STAGE(PG8_SB(1, 1), cB + hstepB + kstep, voffB);
        PG8_WAIT_V(6); PG8_BAR;
    } else {
        PG8_STAGE(PG8_SB(0, 0), cB, voffB); PG8_STAGE(PG8_SA(0, 0), cA, voffA); PG8_STAGE(PG8_SB(0, 1), cB + hstepB, voffB); PG8_STAGE(PG8_SA(0, 1), cA + hstepA, voffA);
        if (wr == 1) PG8_BAR;
        PG8_WAIT_V(4); PG8_BAR;
        PG8_STAGE(PG8_SB(1, 0), cB + kstep, voffB); PG8_STAGE(PG8_SA(1, 0), cA + kstep, voffA); PG8_STAGE(PG8_SB(1, 1), cB + hstepB + kstep, voffB);
        PG8_WAIT_V(6); PG8_BAR;
    }
    for (;;) {
        const bool has_next = S.next(ui + 1, nxt);
        const char* nA = has_next ? (const char*)g.A + (size_t)nxt.pm * tstepA : cA; const char* nB = has_next ? (const char*)g.Bt + (size_t)nxt.pn * tstepB : cB;
#pragma unroll 1
        for (int t = 0; t < nt; t += 2) {
            if constexpr (Epi::CHAIN) { if (t == Epi::T1 || t == Epi::T2) E.mid(acc, cur, t, wr, wc, fr, fq); }
            const bool last = (t == nt - 2);
            const char* a1 = cA + (size_t)(t + 1) * kstep;
            const char* a2 = last ? nA : cA + (size_t)(t + 2) * kstep; const char* b2 = last ? nB : cB + (size_t)(t + 2) * kstep;
            const char* a3 = a2 + kstep; const char* b3 = b2 + kstep;
            if (last && has_next) S.a_ready(nxt);
            if constexpr (SP2) {
            PG8_LDB(B0, 0, 0); PG8_LDB(B1, 0, 1); PG8_SCHED; PG8_LDA(At, 0, 0); PG8_STAGE(PG8_SA(1, 1), a1 + hstepA, voffA);
            PG8_WAIT_V(8); PG8_WAIT_L(0); PG8_BAR; PG8_MMA(0, 0, At, B0); PG8_MMA(0, 1, At, B1); PG8_BAR; PG8_SCHED;
            PG8_LDA(At, 0, 1); PG8_STAGE(PG8_SB(0, 0), b2, voffB); PG8_STAGE(PG8_SB(0, 1), b2 + hstepB, voffB); PG8_STAGE(PG8_SA(0, 0), a2, voffA);
            PG8_WAIT_V(8); PG8_WAIT_L(0); PG8_BAR; PG8_MMA(1, 0, At, B0); PG8_MMA(1, 1, At, B1); PG8_BAR; PG8_SCHED;
            PG8_LDB(B0, 1, 0); PG8_LDB(B1, 1, 1); PG8_SCHED; PG8_LDA(At, 1, 0); PG8_STAGE(PG8_SA(0, 1), a2 + hstepA, voffA);
            PG8_WAIT_V(8); PG8_WAIT_L(0); PG8_BAR; PG8_MMA(0, 0, At, B0); PG8_MMA(0, 1, At, B1); PG8_BAR; PG8_SCHED;
            PG8_LDA(At, 1, 1); PG8_STAGE(PG8_SB(1, 0), b3, voffB); PG8_STAGE(PG8_SB(1, 1), b3 + hstepB, voffB); PG8_STAGE(PG8_SA(1, 0), a3, voffA);
            PG8_WAIT_V(8); PG8_WAIT_L(0); PG8_BAR; PG8_MMA(1, 0, At, B0); PG8_MMA(1, 1, At, B1); PG8_BAR; PG8_SCHED;
            } else {
            PG8_LDB(B0, 0, 0); PG8_SCHED; PG8_LDA(At, 0, 0); PG8_STAGE(PG8_SA(1, 1), a1 + hstepA, voffA);
            PG8_WAIT_L(8); PG8_BAR; PG8_WAIT_L(0); PG8_MMA(0, 0, At, B0); PG8_BAR; PG8_SCHED;
            PG8_LDB(B1, 0, 1); PG8_STAGE(PG8_SB(0, 0), b2, voffB);
            PG8_BAR; PG8_WAIT_L(0); PG8_MMA(0, 1, At, B1); PG8_BAR;
            PG8_LDA(At, 0, 1); PG8_STAGE(PG8_SA(0, 0), a2, voffA);
            PG8_BAR; PG8_WAIT_L(0); PG8_MMA(1, 0, At, B0); PG8_BAR; PG8_SCHED;
            PG8_STAGE(PG8_SB(0, 1), b2 + hstepB, voffB);
            PG8_WAIT_V(6); PG8_BAR; PG8_MMA(1, 1, At, B1); PG8_BAR;
            PG8_LDB(B0, 1, 0); PG8_SCHED; PG8_LDA(At, 1, 0); PG8_STAGE(PG8_SA(0, 1), a2 + hstepA, voffA);
            PG8_WAIT_L(8); PG8_BAR; PG8_WAIT_L(0); PG8_MMA(0, 0, At, B0); PG8_BAR; PG8_SCHED;
            PG8_LDB(B1, 1, 1); PG8_STAGE(PG8_SB(1, 0), b3, voffB);
            PG8_BAR; PG8_WAIT_L(0); PG8_MMA(0, 1, At, B1); PG8_BAR;
            PG8_LDA(At, 1, 1); PG8_STAGE(PG8_SA(1, 0), a3, voffA);
            PG8_BAR; PG8_WAIT_L(0); PG8_MMA(1, 0, At, B0); PG8_BAR; PG8_SCHED;
            PG8_STAGE(PG8_SB(1, 1), b3 + hstepB, voffB);
            PG8_WAIT_V(6); PG8_BAR; PG8_MMA(1, 1, At, B1); PG8_BAR;
            }
        }
        if constexpr (ALIGN_EPI) { if (wr == 0) PG8_BAR; }
        if constexpr (!Epi::AFTER_DRAIN) { E(acc, cur, wr, wc, fr, fq); S.done(cur); }
        if (!has_next) break;
#pragma unroll
        for (int a = 0; a < 2; ++a)
#pragma unroll
            for (int b = 0; b < 2; ++b)
#pragma unroll
                for (int m = 0; m < 4; ++m)
#pragma unroll
                    for (int n = 0; n < 2; ++n) acc[a][b][m][n] = (f32x4){0.f, 0.f, 0.f, 0.f};
        cur = nxt; cA = nA; cB = nB; ++ui;
        if constexpr (ALIGN_EPI) { if (wr == 1) PG8_BAR; }
    }
    PG8_WAIT_V(0);
    if constexpr (!ALIGN_EPI) { if (wr == 0) PG8_BAR; }
    PG8_BAR;
    if constexpr (Epi::AFTER_DRAIN) { E.fused(acc, cur, wr, wc, fr, fq, lds, wid, lane); S.done(cur); }
#undef PG8_SA
#undef PG8_SB
#undef PG8_STAGE
#undef PG8_LDA
#undef PG8_LDB
#undef PG8_MMA
#undef PG8_WAIT_V
#undef PG8_WAIT_L
#undef PG8_BAR
#undef PG8_SCHED
}
template <class Epi, class Sched, bool ALIGN_EPI = false, bool SP2 = false>
__device__ __forceinline__ void gemm_phase(PG8_LAS unsigned char* lds, const Gemm g, const Sched& S, const Epi& E) {
    f32x4 acc[2][2][4][2];
    gemm_body<Epi, Sched, ALIGN_EPI, SP2>(lds, g, S, E, acc, true);
}
struct OneUnit { Unit u;
    __device__ __forceinline__ bool next(int i, Unit& o) const { if (i) return false; o = u; return true; }
    __device__ __forceinline__ void a_ready(const Unit&) const {}
    __device__ __forceinline__ void done(const Unit&) const {} };
}

typedef unsigned short bf16_t;
using pg8::bf16x8; using pg8::f32x4; using pg8::u32x4;
typedef float f32x16 __attribute__((ext_vector_type(16)));
typedef unsigned u32x2 __attribute__((ext_vector_type(2)));
#define DI __device__ __forceinline__
#define MFMA32(a, b, c) __builtin_amdgcn_mfma_f32_32x32x16_bf16((a), (b), (c), 0, 0, 0)

constexpr int SEQ = 4096, BATCH = 8, DM = 1024, DEPTH = 2;
constexpr int NB = 4, TC = NB * SEQ, NCHUNK = BATCH / NB;
constexpr int INW = 11168, LDZ = 11168, NZP = 11264;
constexpr int C_LRUX = 0, C_LRUG = 1024, C_MLAG = 2048, C_DILG = 2560, C_DQ = 3072, C_DK = 4608, C_DV = 6144, C_MERGE = 7680, C_CQ = 10752, C_CKV = 11008, C_KR = 11136;
constexpr float EPS = 1e-6f, LOG2E = 1.4426950408889634f, LN2 = 0.6931471805599453f, LOG2_THETA = 13.287712379549449f;
constexpr int NUP = 1792, KUP = 384;

constexpr size_t W_IN_B = (size_t)NZP * DM * 2, W_UP_B = (size_t)NUP * KUP * 2, W_SQ_B = (size_t)DM * DM * 2, W_HF_B = (size_t)DM * 512 * 2, W_G_B = (size_t)8 * 128 * 128 * 2;
constexpr size_t WL_IN = 0, WL_UP = WL_IN + W_IN_B, WL_PCAT = WL_UP + W_UP_B  , WL_OUT = WL_PCAT + W_SQ_B + 2 * W_HF_B,
                 WL_GX = WL_OUT + W_SQ_B, WL_GA = WL_GX + W_G_B, WL_SIZE = WL_GA + W_G_B;
constexpr size_t WS_W = 0, WS_Z = WS_W + 2 * WL_SIZE, WS_S = WS_Z + (size_t)TC * LDZ * 2;
constexpr size_t S_XN = 0;
constexpr int LDQ = 1792;
constexpr size_t S_QF = 0, S_KF = S_QF + (size_t)TC * LDQ * 2, S_AGG = S_KF + (size_t)TC * 768 * 2,
                 S_LSE = S_AGG + (size_t)(TC / 64) * 1024 * 8, S_P23_END = S_LSE + (size_t)3 * TC * 8 * 4;
constexpr size_t S_MRG = 0, S_MB = S_MRG + (size_t)TC * DM * 4, S_END = S_MB + (size_t)TC * DM * 2;
static_assert(S_P23_END <= S_END, "scratch");
constexpr size_t WS_CTL = WS_S + S_END;
constexpr size_t WS_NEED = WS_CTL + 256 * 129;
static_assert(WS_NEED <= 536870912ull, "workspace");
static_assert(WS_Z % 256 == 0 && WS_S % 256 == 0 && WL_SIZE % 256 == 0, "align");
constexpr int LDS_BYTES = 139264;

DI float bflo(unsigned w) { return __uint_as_float(w << 16); }
DI float bfhi(unsigned w) { return __uint_as_float(w & 0xffff0000u); }
DI unsigned pk2(float lo, float hi) { typedef float f2_t __attribute__((ext_vector_type(2))); typedef __bf16 b2_t __attribute__((ext_vector_type(2)));
    f2_t v = {lo, hi}; b2_t b = __builtin_convertvector(v, b2_t); return __builtin_bit_cast(unsigned, b); }
DI float sigmoidf_(float x) { return __builtin_amdgcn_rcpf(1.f + __builtin_amdgcn_exp2f(-LOG2E * x)); }
DI float siluf_(float x) { return x * sigmoidf_(x); }
DI float fexp_(float x) { return __builtin_amdgcn_exp2f(LOG2E * x); }
DI float wave_sum(float v) {
#pragma unroll
    for (int m = 1; m < 64; m <<= 1) v += __shfl_xor(v, m);
    return v; }
DI void lds_barrier() { asm volatile("s_waitcnt lgkmcnt(0)\n\ts_barrier" ::: "memory"); }
DI int crow(int i, int h) { return (i & 3) + 8 * (i >> 2) + 4 * h; }
DI void sincos_rev(float ang, float& s, float& c) { float rev = ang * 0.15915494309189535f; rev = rev - floorf(rev); s = __builtin_amdgcn_sinf(rev); c = __builtin_amdgcn_cosf(rev); }

struct Args { const float* in[24]; float* out; unsigned char* ws; };
#ifndef PROBE_K
#define PROBE_K (-1)
#endif
#define PSTAMP(k) do { if (PROBE_K >= 0) { const unsigned long long now_ = __builtin_amdgcn_s_memrealtime(); if ((k) == PROBE_K) tacc += now_ - tprev; tprev = now_; } } while (0)

DI void wconv_job(float* tl, const float* __restrict__ src, int lds_, int n0s, int nrows, int ncols, bf16_t* dst, int ldd, int n0d, int k0d, const float* __restrict__ scale) {
    const int tid = otid(), ntn = ncols / 32, ntk = nrows / 128, nt = ntn * ntk;
    float pv[8];
#define WC_LOAD(T) { const int tn_ = (T) % ntn, k0_ = ((T) / ntn) * 128; _Pragma("unroll") for (int i = 0; i < 8; ++i) { const int kk = i * 16 + (tid >> 5), nn = tid & 31; \
        float v = src[(size_t)(k0_ + kk) * lds_ + n0s + tn_ * 32 + nn]; if (scale) v *= scale[k0_ + kk]; pv[i] = v; } }
    int t = obid(); if (t < nt) WC_LOAD(t)
    for (; t < nt; t += gridDim.x) {
        const int tn = t % ntn, tk = t / ntn, k0 = tk * 128;
#pragma unroll
        for (int i = 0; i < 8; ++i) tl[(i * 16 + (tid >> 5)) * 33 + (tid & 31)] = pv[i];
        __syncthreads();
        if (t + (int)gridDim.x < nt) WC_LOAD(t + gridDim.x)
        { const int n = tid >> 4, kq = tid & 15; u32x4 w;
          w.x = pk2(tl[(kq * 8 + 0) * 33 + n], tl[(kq * 8 + 1) * 33 + n]); w.y = pk2(tl[(kq * 8 + 2) * 33 + n], tl[(kq * 8 + 3) * 33 + n]);
          w.z = pk2(tl[(kq * 8 + 4) * 33 + n], tl[(kq * 8 + 5) * 33 + n]); w.w = pk2(tl[(kq * 8 + 6) * 33 + n], tl[(kq * 8 + 7) * 33 + n]);
          *(u32x4*)(dst + (size_t)(n0d + tn * 32 + n) * ldd + k0d + k0 + kq * 8) = w; }
        lds_barrier();
    }
#undef WC_LOAD
}
DI void zero_rect(bf16_t* dst, int ldd, int n0, int nn, int k0, int nk) {
    const int per = nk / 8, tot = nn * per;
    for (int i = obid() * 512 + otid(); i < tot; i += gridDim.x * 512) { const int n = i / per, c = i % per;
        *(u32x4*)(dst + (size_t)(n0 + n) * ldd + k0 + c * 8) = (u32x4){0u, 0u, 0u, 0u}; }
}
DI void prologue_weights(const Args& a, unsigned char* lds) {
    float* tl = (float*)lds;
    for (int l = 0; l < DEPTH; ++l) {
        unsigned char* wl = a.ws + WS_W + (size_t)l * WL_SIZE;
        bf16_t* win = (bf16_t*)(wl + WL_IN); const float* w_in = a.in[3] + (size_t)l * DM * INW;
        wconv_job(tl, w_in, INW, 0,    1024, 2048, win, DM, C_LRUX, 0, nullptr);
        wconv_job(tl, w_in, INW, 2464, 1024, 512,  win, DM, C_MLAG, 0, nullptr);
        wconv_job(tl, w_in, INW, 7584, 1024, 512,  win, DM, C_DILG, 0, nullptr);
        wconv_job(tl, w_in, INW, 2976, 1024, 4608, win, DM, C_DQ, 0, nullptr);
        wconv_job(tl, w_in, INW, 8096, 1024, 3072, win, DM, C_MERGE, 0, nullptr);
        wconv_job(tl, w_in, INW, 2048, 1024, 416,  win, DM, C_CQ, 0, nullptr);
        zero_rect(win, DM, INW, NZP - INW, 0, DM);
        bf16_t* wup = (bf16_t*)(wl + WL_UP);
        wconv_job(tl, a.in[14] + (size_t)l * 256 * 768, 768, 0, 256, 768, wup, KUP, 0, 0, a.in[12] + l * 256);
        wconv_job(tl, a.in[15] + (size_t)l * 128 * 1024, 1024, 0, 128, 1024, wup, KUP, 768, 256, a.in[13] + l * 128);
        zero_rect(wup, KUP, 0, 768, 256, 128); zero_rect(wup, KUP, 768, 1024, 0, 256);
        wconv_job(tl, a.in[11] + (size_t)l * DM * DM, DM, 0, 1024, 1024, (bf16_t*)(wl + WL_PCAT), 2048, 0, 0, nullptr);
        wconv_job(tl, a.in[18] + (size_t)l * 512 * DM, DM, 0, 512, 1024, (bf16_t*)(wl + WL_PCAT), 2048, 0, 1024, nullptr);
        wconv_job(tl, a.in[21] + (size_t)l * 512 * DM, DM, 0, 512, 1024, (bf16_t*)(wl + WL_PCAT), 2048, 0, 1536, nullptr);
        wconv_job(tl, a.in[23] + (size_t)l * DM * DM, DM, 0, 1024, 1024, (bf16_t*)(wl + WL_OUT), 1024, 0, 0, nullptr);
        for (int nb = 0; nb < 8; ++nb) {
            wconv_job(tl, a.in[6] + ((size_t)l * 8 + nb) * 128 * 128, 128, 0, 128, 128, (bf16_t*)(wl + WL_GX) + nb * 128 * 128, 128, 0, 0, nullptr);
            wconv_job(tl, a.in[8] + ((size_t)l * 8 + nb) * 128 * 128, 128, 0, 128, 128, (bf16_t*)(wl + WL_GA) + nb * 128 * 128, 128, 0, 0, nullptr);
        }
    }
}

DI void p0_rmsnorm(const float* __restrict__ x, const float* __restrict__ g, bf16_t* xn) {
    const int tid = otid(), lane = tid & 63, gw = obid() * 8 + (tid >> 6), nw = gridDim.x * 8;
    f32x4 gv[4];
#pragma unroll
    for (int i = 0; i < 4; ++i) gv[i] = *(const f32x4*)(g + i * 256 + lane * 4);
    for (int row = gw; row < TC; row += nw) {
        const float* xr = x + (size_t)row * DM; f32x4 v[4]; float ss = 0.f;
#pragma unroll
        for (int i = 0; i < 4; ++i) { v[i] = *(const f32x4*)(xr + i * 256 + lane * 4); ss += v[i][0] * v[i][0] + v[i][1] * v[i][1] + v[i][2] * v[i][2] + v[i][3] * v[i][3]; }
        ss = wave_sum(ss); const float rs = rsqrtf(ss * (1.f / DM) + EPS);
#pragma unroll
        for (int i = 0; i < 4; ++i) { u32x2 w; w.x = pk2(v[i][0] * rs * gv[i][0], v[i][1] * rs * gv[i][1]); w.y = pk2(v[i][2] * rs * gv[i][2], v[i][3] * rs * gv[i][3]);
            *(u32x2*)(xn + (size_t)row * DM + i * 256 + lane * 4) = w; }
    }
}

struct EpiZ {
    static constexpr bool PERM = true, AFTER_DRAIN = false, CHAIN = false;
    bf16_t* O; int ldc; int ncols;
    DI void operator()(const f32x4 (&acc)[2][2][4][2], const pg8::Unit& u, int wr, int wc, int fr, int fq) const {
        const int row0 = u.pm * 256 + wr * 64 + fr, col0 = u.pn * 256 + wc * 32 + 8 * fq;
#pragma unroll
        for (int ai = 0; ai < 2; ++ai)
#pragma unroll
            for (int m = 0; m < 4; ++m) { bf16_t* rowp = O + (size_t)(row0 + ai * 128 + m * 16) * ldc;
#pragma unroll
                for (int bj = 0; bj < 2; ++bj) { const int c = col0 + bj * 128; if (c < ncols) { const f32x4 v0 = acc[ai][bj][m][0], v1 = acc[ai][bj][m][1];
                    u32x4 w; w.x = pk2(v0[0], v0[1]); w.y = pk2(v0[2], v0[3]); w.z = pk2(v1[0], v1[1]); w.w = pk2(v1[2], v1[3]); *(u32x4*)(rowp + c) = w; } } }
    }
};
struct EpiChain {
    static constexpr bool PERM = true, AFTER_DRAIN = false, CHAIN = true; static constexpr int T1 = 16, T2 = 24;
    const bf16_t* Z; const float* bm; bf16_t* MB;
    template <bool FIN> DI void run(f32x4 (&acc)[2][2][4][2], const pg8::Unit& u, int br, int wr, int wc, int fr_, int fq_) const {
        int fr = fr_, fq = fq_; asm volatile("" : "+v"(fr), "+v"(fq));
        const int row0 = u.pm * 256 + wr * 64 + fr, col0 = u.pn * 256 + wc * 32 + 8 * fq;
        const float* bmb = bm + br * 1024; const bf16_t* zb = Z + C_MERGE + br * 1024;
#pragma unroll
        for (int bj = 0; bj < 2; ++bj)
#pragma unroll
            for (int n = 0; n < 2; ++n) { const int c = col0 + bj * 128 + 4 * n;
                f32x4 b = *(const f32x4*)(bmb + c) * (-LOG2E), d = b; if (!FIN) d = *(const f32x4*)(bmb + 1024 + c) * (-LOG2E);
                u32x2 gz[8], hz[8];
#pragma unroll
                for (int q = 0; q < 8; ++q) { const bf16_t* zp = zb + (size_t)(row0 + (q >> 2) * 128 + (q & 3) * 16) * LDZ + c; gz[q] = *(const u32x2*)zp; if (!FIN) hz[q] = *(const u32x2*)(zp + 1024); }
#pragma unroll
                for (int q = 0; q < 8; ++q) { const int ai = q >> 2, m = q & 3; const size_t row = (size_t)(row0 + ai * 128 + m * 16);
                    f32x4 sc;
                    sc[0] = __builtin_amdgcn_rcpf(1.f + __builtin_amdgcn_exp2f(bflo(gz[q].x) * (-LOG2E) + b[0])); sc[1] = __builtin_amdgcn_rcpf(1.f + __builtin_amdgcn_exp2f(bfhi(gz[q].x) * (-LOG2E) + b[1]));
                    sc[2] = __builtin_amdgcn_rcpf(1.f + __builtin_amdgcn_exp2f(bflo(gz[q].y) * (-LOG2E) + b[2])); sc[3] = __builtin_amdgcn_rcpf(1.f + __builtin_amdgcn_exp2f(bfhi(gz[q].y) * (-LOG2E) + b[3]));
                    if (!FIN) {
                        sc[0] *= 1.f + __builtin_amdgcn_exp2f(bflo(hz[q].x) * (-LOG2E) + d[0]); sc[1] *= 1.f + __builtin_amdgcn_exp2f(bfhi(hz[q].x) * (-LOG2E) + d[1]);
                        sc[2] *= 1.f + __builtin_amdgcn_exp2f(bflo(hz[q].y) * (-LOG2E) + d[2]); sc[3] *= 1.f + __builtin_amdgcn_exp2f(bfhi(hz[q].y) * (-LOG2E) + d[3]);
                        acc[ai][bj][m][n] *= sc; asm volatile("" : "+v"(acc[ai][bj][m][n]));
                    } else {
                        const f32x4 v = acc[ai][bj][m][n] * sc; u32x2 w; w.x = pk2(v[0], v[1]); w.y = pk2(v[2], v[3]); *(u32x2*)(MB + row * DM + c) = w; } }
                asm volatile("" ::: "memory"); }
    }
    DI void mid(f32x4 (&acc)[2][2][4][2], const pg8::Unit& u, int t, int wr, int wc, int fr, int fq) const { run<false>(acc, u, t == T1 ? 0 : 1, wr, wc, fr, fq); }
    DI void operator()(f32x4 (&acc)[2][2][4][2], const pg8::Unit& u, int wr, int wc, int fr, int fq) const { run<true>(acc, u, 2, wr, wc, fr, fq); }
};
struct EpiOut {
    static constexpr bool PERM = false, AFTER_DRAIN = false, CHAIN = false;
    const float* X; float* O;
    DI void operator()(const f32x4 (&acc)[2][2][4][2], const pg8::Unit& u, int wr, int wc, int fr, int fq) const {
        const int row0 = u.pm * 256 + wr * 64 + fr, col0 = u.pn * 256 + wc * 32 + 4 * fq;
#pragma unroll
        for (int ai = 0; ai < 2; ++ai)
#pragma unroll
            for (int mp = 0; mp < 2; ++mp) {
                f32x4 xv[2][2][2];
#pragma unroll
                for (int mm = 0; mm < 2; ++mm) { const size_t ro = (size_t)(row0 + ai * 128 + (mp * 2 + mm) * 16) * DM + col0;
#pragma unroll
                    for (int bj = 0; bj < 2; ++bj)
#pragma unroll
                        for (int n = 0; n < 2; ++n) xv[mm][bj][n] = *(const f32x4*)(X + ro + bj * 128 + n * 16); }
#pragma unroll
                for (int mm = 0; mm < 2; ++mm) { const size_t ro = (size_t)(row0 + ai * 128 + (mp * 2 + mm) * 16) * DM + col0;
#pragma unroll
                    for (int bj = 0; bj < 2; ++bj)
#pragma unroll
                        for (int n = 0; n < 2; ++n) *(f32x4*)(O + ro + bj * 128 + n * 16) = xv[mm][bj][n] + acc[ai][bj][mp * 2 + mm][n]; }
                asm volatile("" ::: "memory"); }
    }
};

#define UNPK8(W_, d, o, sc_) { const u32x4 w_ = (W_); d[o + 0] = bflo(w_.x) * (sc_); d[o + 1] = bfhi(w_.x) * (sc_); d[o + 2] = bflo(w_.y) * (sc_); d[o + 3] = bfhi(w_.y) * (sc_); d[o + 4] = bflo(w_.z) * (sc_); d[o + 5] = bfhi(w_.z) * (sc_); d[o + 6] = bflo(w_.w) * (sc_); d[o + 7] = bfhi(w_.w) * (sc_); }
DI void dil_prep(bf16_t* z, const int* __restrict__ pos, const float* __restrict__ gq, const float* __restrict__ gk) {
    const int tid = otid(), lane = tid & 63, gw = obid() * 8 + (tid >> 6), nw = gridDim.x * 8, j = lane & 7, hsub = lane >> 3;
    float inv[8], gqo[8], gqp[8], gko[8], gkp[8];
#pragma unroll
    for (int e = 0; e < 8; ++e) { inv[e] = __builtin_amdgcn_exp2f(-(float)(8 * (j & 3) + e) * (LOG2_THETA / 32.f));
        gqo[e] = gq[j * 8 + e]; gqp[e] = gq[(j ^ 4) * 8 + e]; gko[e] = gk[j * 8 + e]; gkp[e] = gk[(j ^ 4) * 8 + e]; }
    const float sgn = (j < 4) ? -1.f : 1.f;
    for (int wi0 = gw; wi0 < TC * 6; wi0 += 8 * nw) {
        u32x4 wv[8];
#pragma unroll
        for (int b = 0; b < 8; ++b) { const int wi = wi0 + b * nw; wv[b] = (u32x4){0u, 0u, 0u, 0u};
            if (wi < TC * 6) { const int tok = wi / 6, grp = wi - tok * 6; wv[b] = *(const u32x4*)(z + (size_t)tok * LDZ + (grp < 3 ? C_DQ + grp * 512 : C_DK + (grp - 3) * 512) + hsub * 64 + j * 8); } }
#pragma unroll
        for (int b = 0; b < 8; ++b) { const int wi = wi0 + b * nw; if (wi < TC * 6) {
            const int tok = wi / 6, grp = wi - tok * 6; const bool isq = grp < 3;
            bf16_t* p = z + (size_t)tok * LDZ + (isq ? C_DQ + grp * 512 : C_DK + (grp - 3) * 512) + hsub * 64 + j * 8;
            const u32x4 w = wv[b]; u32x4 q;
            q.x = __shfl_xor(w.x, 4); q.y = __shfl_xor(w.y, 4); q.z = __shfl_xor(w.z, 4); q.w = __shfl_xor(w.w, 4);
            float v[8], u[8]; UNPK8(w, v, 0, 1.f) UNPK8(q, u, 0, 1.f)
            float ss = 0.f;
#pragma unroll
            for (int e = 0; e < 8; ++e) ss += v[e] * v[e];
            ss += __shfl_xor(ss, 1); ss += __shfl_xor(ss, 2); ss += __shfl_xor(ss, 4);
            const float rs = rsqrtf(ss * (1.f / 64.f) + EPS) * (isq ? 0.125f * LOG2E : 1.f);
            const float fp = (float)pos[tok];
            float o[8];
#pragma unroll
            for (int e = 0; e < 8; ++e) { float sn, cs; sincos_rev(fp * inv[e], sn, cs);
                const float a = v[e] * rs * (isq ? gqo[e] : gko[e]), bb = u[e] * rs * (isq ? gqp[e] : gkp[e]); o[e] = a * cs + sgn * bb * sn; }
            u32x4 r; r.x = pk2(o[0], o[1]); r.y = pk2(o[2], o[3]); r.z = pk2(o[4], o[5]); r.w = pk2(o[6], o[7]);
            *(u32x4*)p = r; } }
    }
}

DI float ssq8(u32x4 w) { return bflo(w.x) * bflo(w.x) + bfhi(w.x) * bfhi(w.x) + bflo(w.y) * bflo(w.y) + bfhi(w.y) * bfhi(w.y) + bflo(w.z) * bflo(w.z) + bfhi(w.z) * bfhi(w.z) + bflo(w.w) * bflo(w.w) + bfhi(w.w) * bfhi(w.w); }
DI u32x4 scale8(u32x4 w, float s, const float* __restrict__ g) { u32x4 o; o.x = pk2(bflo(w.x) * s * g[0], bfhi(w.x) * s * g[1]); o.y = pk2(bflo(w.y) * s * g[2], bfhi(w.y) * s * g[3]);
    o.z = pk2(bflo(w.z) * s * g[4], bfhi(w.z) * s * g[5]); o.w = pk2(bflo(w.w) * s * g[6], bfhi(w.w) * s * g[7]); return o; }
DI void rope16(float (&v)[32], const float* __restrict__ g, float fp) {
#pragma unroll
    for (int i = 0; i < 16; ++i) { const float inv = exp2f(-(float)i * (LOG2_THETA / 16.f)); float sn, cs; sincos_rev(fp * inv, sn, cs);
        const float x1 = v[i] * g[i], x2 = v[16 + i] * g[16 + i]; v[i] = x1 * cs - x2 * sn; v[16 + i] = x2 * cs + x1 * sn; }
}
DI void mla_finalize(unsigned char* lds, const bf16_t* z, bf16_t* qf, bf16_t* kvr, bf16_t* kf, const int* __restrict__ pos, const float* __restrict__ gqn_g, const float* __restrict__ gkn_g) {
    float* rst = (float*)lds;
    float* gl = rst + 128; const float* gqn = gl; const float* gkn = gl + 96;
    for (int grp = obid(); grp < TC / 64; grp += gridDim.x) {
        const int tid = otid(), lane = tid & 63, wid = tid >> 6;
        const int t0 = grp * 64;
        const int tl_ = tid >> 3, hd = tid & 7, tok = t0 + tl_;
        bf16_t* pq = qf + (size_t)tok * LDQ + hd * 96; bf16_t* pkv = kvr + (size_t)tok * LDQ + hd * 128; const bf16_t* pkr = z + (size_t)tok * LDZ + C_KR; bf16_t* pk = kf + (size_t)tok * 768 + hd * 96;
        u32x4 rq[12];
#pragma unroll
        for (int c = 0; c < 12; ++c) rq[c] = *(const u32x4*)(pq + c * 8);
        const float fp = (float)pos[tok];
        if (tid < 192) gl[tid] = (tid < 96) ? gqn_g[tid] : gkn_g[tid - 96];
        u32x2 la[8]; unsigned lb[8];
#pragma unroll
        for (int i = 0; i < 8; ++i) { const bf16_t* zr = z + (size_t)(t0 + wid * 8 + i) * LDZ; la[i] = *(const u32x2*)(zr + C_CQ + lane * 4); lb[i] = *(const unsigned*)(zr + C_CKV + lane * 2); }
        __syncthreads();
#pragma unroll
        for (int i = 0; i < 8; ++i) {
            float s1 = bflo(la[i].x) * bflo(la[i].x) + bfhi(la[i].x) * bfhi(la[i].x) + bflo(la[i].y) * bflo(la[i].y) + bfhi(la[i].y) * bfhi(la[i].y), s2 = bflo(lb[i]) * bflo(lb[i]) + bfhi(lb[i]) * bfhi(lb[i]);
            s1 = wave_sum(s1); s2 = wave_sum(s2);
            if (lane == 0) { rst[(wid * 8 + i) * 2] = rsqrtf(s1 * (1.f / 256.f) + EPS); rst[(wid * 8 + i) * 2 + 1] = rsqrtf(s2 * (1.f / 128.f) + EPS); } }
        __syncthreads();
        const float rcq = rst[tl_ * 2], rckv = rst[tl_ * 2 + 1];
        {
            float ss = 0.f;
#pragma unroll
            for (int c = 0; c < 12; ++c) ss += ssq8(rq[c]);
            ss *= rcq * rcq;
            const float rs = rsqrtf(ss * (1.f / 96.f) + EPS) * rcq * (0.10206207261596575f * LOG2E);
#pragma unroll
            for (int c = 0; c < 8; ++c) *(u32x4*)(pq + c * 8) = scale8(rq[c], rs, gqn + c * 8);
            float v[32];
#pragma unroll
            for (int c = 0; c < 4; ++c) { UNPK8(rq[8 + c], v, c * 8, rs) }
            rope16(v, gqn + 64, fp);
#pragma unroll
            for (int c = 0; c < 4; ++c) { u32x4 w; w.x = pk2(v[c * 8 + 0], v[c * 8 + 1]); w.y = pk2(v[c * 8 + 2], v[c * 8 + 3]); w.z = pk2(v[c * 8 + 4], v[c * 8 + 5]); w.w = pk2(v[c * 8 + 6], v[c * 8 + 7]);
                *(u32x4*)(pq + 64 + c * 8) = w; }
        }
        asm volatile("" ::: "memory");
        {
            u32x4 rk[8], rv[8], rr[4];
#pragma unroll
            for (int c = 0; c < 8; ++c) { rk[c] = *(const u32x4*)(pkv + c * 8); rv[c] = *(const u32x4*)(pkv + 64 + c * 8); }
#pragma unroll
            for (int c = 0; c < 4; ++c) rr[c] = *(const u32x4*)(pkr + c * 8);
            float ss = 0.f, sr = 0.f;
#pragma unroll
            for (int c = 0; c < 8; ++c) ss += ssq8(rk[c]);
#pragma unroll
            for (int c = 0; c < 4; ++c) sr += ssq8(rr[c]);
            ss = ss * rckv * rckv + sr;
            const float rs = rsqrtf(ss * (1.f / 96.f) + EPS);
#pragma unroll
            for (int c = 0; c < 8; ++c) *(u32x4*)(pk + c * 8) = scale8(rk[c], rs * rckv, gkn + c * 8);
            float v[32];
#pragma unroll
            for (int c = 0; c < 4; ++c) { UNPK8(rr[c], v, c * 8, rs) }
            rope16(v, gkn + 64, fp);
#pragma unroll
            for (int c = 0; c < 4; ++c) { u32x4 w; w.x = pk2(v[c * 8 + 0], v[c * 8 + 1]); w.y = pk2(v[c * 8 + 2], v[c * 8 + 3]); w.z = pk2(v[c * 8 + 4], v[c * 8 + 5]); w.w = pk2(v[c * 8 + 6], v[c * 8 + 7]);
                *(u32x4*)(pk + 64 + c * 8) = w; }
#pragma unroll
            for (int c = 0; c < 8; ++c) { u32x4 w = rv[c];
                w.x = pk2(bflo(w.x) * rckv, bfhi(w.x) * rckv); w.y = pk2(bflo(w.y) * rckv, bfhi(w.y) * rckv); w.z = pk2(bflo(w.z) * rckv, bfhi(w.z) * rckv); w.w = pk2(bflo(w.w) * rckv, bfhi(w.w) * rckv);
                *(u32x4*)(pkv + 64 + c * 8) = w; }
        }
    }
}

DI void dil_combine(bf16_t* z, const float* __restrict__ lse) {
    const int tot = TC * 64, stride = gridDim.x * 512;
    for (int it0 = obid() * 512 + otid(); it0 < tot; it0 += 2 * stride) {
        u32x4 A[2], B[2], C[2], Gt[2]; float L0[2], L1[2], L2[2];
#pragma unroll
        for (int b = 0; b < 2; ++b) { const int it = it0 + b * stride; if (it < tot) { const int tok = it >> 6, hd = (it >> 3) & 7, dc = it & 7; const bf16_t* zr = z + (size_t)tok * LDZ;
            L0[b] = lse[(size_t)tok * 8 + hd]; L1[b] = lse[(size_t)TC * 8 + (size_t)tok * 8 + hd]; L2[b] = lse[(size_t)2 * TC * 8 + (size_t)tok * 8 + hd];
            A[b] = *(const u32x4*)(zr + C_DQ + (0 * 8 + hd) * 64 + dc * 8); B[b] = *(const u32x4*)(zr + C_DQ + (1 * 8 + hd) * 64 + dc * 8); C[b] = *(const u32x4*)(zr + C_DQ + (2 * 8 + hd) * 64 + dc * 8);
            Gt[b] = *(const u32x4*)(zr + C_DILG + hd * 64 + dc * 8); } }
#pragma unroll
        for (int b = 0; b < 2; ++b) { const int it = it0 + b * stride; if (it < tot) { const int tok = it >> 6, hd = (it >> 3) & 7, dc = it & 7;
            const float l0 = L0[b], l1 = L1[b], l2 = L2[b];
            const float mx = fmaxf(l0, fmaxf(l1, l2)); float w0 = fexp_(l0 - mx), w1 = fexp_(l1 - mx), w2 = fexp_(l2 - mx); const float iw = __builtin_amdgcn_rcpf(w0 + w1 + w2); w0 *= iw; w1 *= iw; w2 *= iw;
            const u32x4 a = A[b], bq = B[b], c = C[b], g = Gt[b]; u32x4 o;
#define CMB(F) { const float e0 = (w0 * bflo(a.F) + w1 * bflo(bq.F) + w2 * bflo(c.F)) * siluf_(bflo(g.F)), e1 = (w0 * bfhi(a.F) + w1 * bfhi(bq.F) + w2 * bfhi(c.F)) * siluf_(bfhi(g.F)); o.F = pk2(e0, e1); }
            CMB(x) CMB(y) CMB(z) CMB(w)
#undef CMB
            *(u32x4*)(z + (size_t)tok * LDZ + C_DILG + hd * 64 + dc * 8) = o; } }
    }
}

struct LruP { const float* conv_w; const float* conv_b; const float* b_gx; const float* b_ga; const float* lam; const bf16_t* wgx; const bf16_t* wga; };
constexpr int L_XS = 0, L_XCB = 18432, L_XC = L_XCB + 17408, L_HB = L_XC + 32768, L_CW = L_HB + 32768, L_EX = L_CW + 5 * 128 * 4, L_END = L_EX + 2 * 128 * 8;
static_assert(L_END <= LDS_BYTES, "lru lds");
template <bool FINAL> DI void lru_unit(unsigned char* lds, bf16_t* z, float* agg, const LruP& P, int bl, int n, int grp) {
    const int tid0 = otid();
    bf16_t* xs = (bf16_t*)(lds + L_XS); bf16_t* xcb = (bf16_t*)(lds + L_XCB); float* xc = (float*)(lds + L_XC); float* hb = (float*)(lds + L_HB);
    float* cw = (float*)(lds + L_CW); float2* ex = (float2*)(lds + L_EX);
    __syncthreads();
    const int tid = tid0, lane = tid & 63, wid = tid >> 6, r = lane & 31, h = lane >> 5, ct = wid & 3, rt = wid >> 2;
    for (int i = tid; i < 640; i += 512) cw[i] = (i < 512) ? P.conv_w[(i >> 7) * 1024 + n * 128 + (i & 127)] : P.conv_b[n * 128 + (i & 127)];
    bf16x8 bx[8], ba[8];
    { const bf16_t* wx = P.wgx + (size_t)n * 16384 + (size_t)(ct * 32 + r) * 128 + 8 * h; const bf16_t* wa = P.wga + (size_t)n * 16384 + (size_t)(ct * 32 + r) * 128 + 8 * h;
#pragma unroll
      for (int s = 0; s < 8; ++s) { bx[s] = *(const bf16x8*)(wx + 16 * s); ba[s] = *(const bf16x8*)(wa + 16 * s); } }
    const int ch = ct * 32 + r, chg = n * 128 + ch; const float bgx = P.b_gx[chg], bga = P.b_ga[chg]; const float sp = __logf(1.f + __expf(-P.lam[chg]));
    float hrun = 0.f, Arun = 1.f;
    if (FINAL) {
#pragma unroll
        for (int g2 = 0; g2 < 7; ++g2) if (g2 < grp) { const float2 ab = *(const float2*)(agg + ((size_t)(bl * 8 + g2) * 1024 + chg) * 2); hrun = ab.x * hrun + ab.y; } }
    const size_t rowb = (size_t)bl * SEQ;
    u32x4 xr[3], gr[2];
#define LRU_XLOAD(J) { _Pragma("unroll") for (int q = 0; q < 3; ++q) { const int c = tid + q * 512; const int i = c >> 4, cc = c & 15; const int p = (J) * 64 - 3 + i; \
        xr[q] = (u32x4){0u, 0u, 0u, 0u}; if (c < 67 * 16 && p >= 0) xr[q] = *(const u32x4*)(z + (rowb + p) * LDZ + C_LRUX + n * 128 + cc * 8); } }
#pragma unroll
    for (int s = 0; s < 8; ++s) asm volatile("" :: "v"(bx[s]), "v"(ba[s]));
    asm volatile("" :: "v"(bgx), "v"(bga), "v"(sp), "v"(hrun));
    LRU_XLOAD(grp * 8)
    __syncthreads();
#pragma unroll 1
    for (int jt = 0; jt < 8; ++jt) {
        int tq = tid0; asm volatile("" : "+v"(tq));
        const int tid = tq, lane = tid & 63, wid = tid >> 6, r = lane & 31, h = lane >> 5, ct = wid & 3, rt = wid >> 2, ch = ct * 32 + r;
        const int j = grp * 8 + jt; const size_t row0 = rowb + (size_t)j * 64;
#pragma unroll
        for (int q = 0; q < 3; ++q) { const int c = tid + q * 512; if (c < 67 * 16) *(u32x4*)(xs + (c >> 4) * 136 + (c & 15) * 8) = xr[q]; }
        lds_barrier();
        if (jt + 1 < 8) LRU_XLOAD(j + 1)
        if (FINAL) {
#pragma unroll
            for (int q = 0; q < 2; ++q) { const int c = tid + q * 512; gr[q] = *(const u32x4*)(z + (row0 + (c >> 4)) * LDZ + C_LRUG + n * 128 + (c & 15) * 8); } }
        {
            const int i = tid >> 3, c0 = (tid & 7) * 16; float acc[16];
#pragma unroll
            for (int q = 0; q < 4; ++q) { const f32x4 b = *(const f32x4*)(cw + 512 + c0 + q * 4); acc[q * 4] = b[0]; acc[q * 4 + 1] = b[1]; acc[q * 4 + 2] = b[2]; acc[q * 4 + 3] = b[3]; }
#pragma unroll
            for (int k = 0; k < 4; ++k) {
                const u32x4 xa = *(const u32x4*)(xs + (i + k) * 136 + c0), xb = *(const u32x4*)(xs + (i + k) * 136 + c0 + 8);
                const float xv[16] = {bflo(xa.x), bfhi(xa.x), bflo(xa.y), bfhi(xa.y), bflo(xa.z), bfhi(xa.z), bflo(xa.w), bfhi(xa.w), bflo(xb.x), bfhi(xb.x), bflo(xb.y), bfhi(xb.y), bflo(xb.z), bfhi(xb.z), bflo(xb.w), bfhi(xb.w)};
#pragma unroll
                for (int q = 0; q < 4; ++q) { const f32x4 w = *(const f32x4*)(cw + k * 128 + c0 + q * 4);
                    acc[q * 4] += w[0] * xv[q * 4]; acc[q * 4 + 1] += w[1] * xv[q * 4 + 1]; acc[q * 4 + 2] += w[2] * xv[q * 4 + 2]; acc[q * 4 + 3] += w[3] * xv[q * 4 + 3]; } }
#pragma unroll
            for (int q = 0; q < 4; ++q) *(f32x4*)(xc + i * 128 + c0 + q * 4) = (f32x4){acc[q * 4], acc[q * 4 + 1], acc[q * 4 + 2], acc[q * 4 + 3]};
            u32x4 w0, w1; w0.x = pk2(acc[0], acc[1]); w0.y = pk2(acc[2], acc[3]); w0.z = pk2(acc[4], acc[5]); w0.w = pk2(acc[6], acc[7]);
            w1.x = pk2(acc[8], acc[9]); w1.y = pk2(acc[10], acc[11]); w1.z = pk2(acc[12], acc[13]); w1.w = pk2(acc[14], acc[15]);
            *(u32x4*)(xcb + i * 136 + c0) = w0; *(u32x4*)(xcb + i * 136 + c0 + 8) = w1;
        }
        lds_barrier();
        float av[16], bv[16], Ao[4], Ho[4], Ap[4], Hp[4];
        {
            f32x16 gx, ga;
#pragma unroll
            for (int i = 0; i < 16; ++i) { gx[i] = 0.f; ga[i] = 0.f; }
#pragma unroll
            for (int s = 0; s < 8; ++s) { const bf16x8 a = *(const bf16x8*)(xcb + (rt * 32 + r) * 136 + 16 * s + 8 * h); gx = MFMA32(a, bx[s], gx); ga = MFMA32(a, ba[s], ga); }
#pragma unroll
            for (int i = 0; i < 16; ++i) { const int tk = rt * 32 + crow(i, h);
                const float vgx = sigmoidf_(gx[i] + bgx), vga = sigmoidf_(ga[i] + bga); const float la = -8.f * vga * sp; av[i] = fexp_(la);
                const float mult = __builtin_amdgcn_sqrtf(fmaxf(1.f - av[i] * av[i], 0.f));
                bv[i] = mult * vgx * xc[tk * 128 + ch]; }
        }
#pragma unroll
        for (int g = 0; g < 4; ++g) { float H = 0.f, A = 1.f;
#pragma unroll
            for (int k = 0; k < 4; ++k) { H = av[4 * g + k] * H + bv[4 * g + k]; A *= av[4 * g + k]; }
            Ao[g] = A; Ho[g] = H; Ap[g] = __shfl_xor(A, 32); Hp[g] = __shfl_xor(H, 32); }
        {   float c = 0.f, At = 1.f;
#pragma unroll
            for (int g = 0; g < 4; ++g) { const float A1 = h ? Ap[g] : Ao[g], H1 = h ? Hp[g] : Ho[g], A2 = h ? Ao[g] : Ap[g], H2 = h ? Ho[g] : Hp[g]; c = A1 * c + H1; c = A2 * c + H2; At *= A1 * A2; }
            if (h == 0) ex[rt * 128 + ch] = make_float2(At, c); }
        lds_barrier();
        {   const float2 e0 = ex[ch], e1 = ex[128 + ch]; const float hmid = e0.x * hrun + e0.y;
            float c = rt ? hmid : hrun;
            hrun = e1.x * hmid + e1.y; Arun *= e0.x * e1.x;
            if (FINAL) {
#pragma unroll
                for (int g = 0; g < 4; ++g) { const float A1 = h ? Ap[g] : Ao[g], H1 = h ? Hp[g] : Ho[g], A2 = h ? Ao[g] : Ap[g], H2 = h ? Ho[g] : Hp[g];
                    const float c1 = A1 * c + H1; float hh = h ? c1 : c; c = A2 * c1 + H2;
#pragma unroll
                    for (int k = 0; k < 4; ++k) { hh = av[4 * g + k] * hh + bv[4 * g + k]; hb[(rt * 32 + 8 * g + 4 * h + k) * 128 + ch] = hh; } } } }
        if (FINAL) {
            lds_barrier();
#pragma unroll
            for (int q = 0; q < 2; ++q) { const int c = tid + q * 512; const int i = c >> 4, cc = c & 15; bf16_t* gp = z + (row0 + i) * LDZ + C_LRUG + n * 128 + cc * 8; const u32x4 g = gr[q];
                const f32x4 h0 = *(const f32x4*)(hb + i * 128 + cc * 8), h1 = *(const f32x4*)(hb + i * 128 + cc * 8 + 4); u32x4 o;
                o.x = pk2(h0[0] * siluf_(bflo(g.x)), h0[1] * siluf_(bfhi(g.x))); o.y = pk2(h0[2] * siluf_(bflo(g.y)), h0[3] * siluf_(bfhi(g.y)));
                o.z = pk2(h1[0] * siluf_(bflo(g.z)), h1[1] * siluf_(bfhi(g.z))); o.w = pk2(h1[2] * siluf_(bflo(g.w)), h1[3] * siluf_(bfhi(g.w))); *(u32x4*)gp = o; }
        }
    }
#undef LRU_XLOAD
    if (!FINAL && h == 0 && rt == 0) *(float2*)(agg + ((size_t)(bl * 8 + grp) * 1024 + chg) * 2) = make_float2(Arun, hrun);
}

typedef short s16x4 __attribute__((ext_vector_type(4)));
DI s16x4 vtr(const bf16_t* p) { return __builtin_amdgcn_ds_read_tr16_b64_v4i16((__attribute__((address_space(3))) s16x4*)p); }
template <int DK, bool WIN, bool MLA>
DI void attn_unit(unsigned char* lds, const bf16_t* Qb, size_t qs, const bf16_t* Kb, size_t ks, const bf16_t* Vb, size_t vs, int q0, bf16_t* Ob, size_t os, float* lsep, size_t lses, const float CS) {
    constexpr int KLD = DK + 8, VLD = 72, KC = DK / 8, KCH = 64 * KC, KBYTES = 64 * KLD * 2, BUFB = KBYTES + 64 * VLD * 2;
    const int tid = otid(), lane = tid & 63, wid = tid >> 6, r = lane & 31, h = lane >> 5;
    const int qw = q0 + 32 * wid;
    bf16x8 qf[DK / 16];
    { const bf16_t* qrow = Qb + (size_t)(qw + r) * qs + 8 * h;
#pragma unroll
      for (int s = 0; s < DK / 16; ++s) qf[s] = *(const bf16x8*)(qrow + 16 * s); }
    f32x16 o[2];
#pragma unroll
    for (int i = 0; i < 16; ++i) { o[0][i] = 0.f; o[1][i] = 0.f; }
    float lrow = 0.f;
    const int kt_lo = WIN ? (q0 >= 128 ? (q0 - 128) / 64 : 0) : 0, kt_hi = (q0 + 255) / 64, ntile = kt_hi - kt_lo + 1;
    const int k0r = tid / KC, k0c = tid % KC, k1r = (tid + 512) / KC, k1c = (tid + 512) % KC; const bool k1v = (tid + 512) < KCH;
    const int vkey = tid >> 3, vdc = tid & 7;
    const int koff0 = k0r * KLD + k0c * 8, koff1 = k1r * KLD + k1c * 8, voff = vkey * VLD + vdc * 8;
    const int kfrag = r * KLD + 8 * h, vfrag = (4 * h + ((lane & 15) >> 2)) * VLD + 16 * ((lane >> 4) & 1) + 4 * (lane & 3);
    u32x4 kreg0, kreg1 = (u32x4){0u, 0u, 0u, 0u}, vreg;
#define ATT_GLOAD(KT) { const size_t kb = (size_t)(KT) * 64; kreg0 = *(const u32x4*)(Kb + (kb + k0r) * ks + k0c * 8); if (k1v) kreg1 = *(const u32x4*)(Kb + (kb + k1r) * ks + k1c * 8); \
                        vreg = *(const u32x4*)(Vb + (kb + vkey) * vs + vdc * 8); }
#define ATT_LWRITE(SLOT) { bf16_t* kp_ = (bf16_t*)(lds + (SLOT) * BUFB); bf16_t* vp_ = (bf16_t*)(lds + (SLOT) * BUFB + KBYTES); \
                        *(u32x4*)(kp_ + koff0) = kreg0; if (k1v) *(u32x4*)(kp_ + koff1) = kreg1; *(u32x4*)(vp_ + voff) = vreg; }
    ATT_GLOAD(kt_lo)
#pragma unroll
    for (int s = 0; s < DK / 16; ++s) asm volatile("" :: "v"(qf[s]));
    __syncthreads();
    ATT_LWRITE(0)
    if (ntile > 1) ATT_GLOAD(kt_lo + 1)
#pragma unroll 1
    for (int it = 0; it < ntile; ++it) {
        const int kbase = (kt_lo + it) * 64;
        lds_barrier();
        if (it + 1 < ntile) { ATT_LWRITE((it + 1) & 1) if (it + 2 < ntile) ATT_GLOAD(kt_lo + it + 2) }
        const bool active = (kbase <= qw + 31) && (!WIN || kbase + 63 >= qw - 128);
        if (active) {
            const bf16_t* Ks = (const bf16_t*)(lds + (it & 1) * BUFB) + kfrag; const bf16_t* Vs = (const bf16_t*)(lds + (it & 1) * BUFB + KBYTES) + vfrag;
            f32x16 x[2];
#pragma unroll
            for (int kt2 = 0; kt2 < 2; ++kt2) {
#pragma unroll
                for (int i = 0; i < 16; ++i) x[kt2][i] = -CS;
#pragma unroll
                for (int s = 0; s < DK / 16; ++s) { const bf16x8 a = *(const bf16x8*)(Ks + kt2 * 32 * KLD + 16 * s); x[kt2] = MFMA32(a, qf[s], x[kt2]); } }
            const int qi = qw + r;
            const bool need_mask = (kbase + 63 > qw) || (WIN && kbase < qw + 31 - 128);
            if (need_mask) {
#pragma unroll
                for (int kt2 = 0; kt2 < 2; ++kt2)
#pragma unroll
                    for (int i = 0; i < 16; ++i) { const int key = kbase + kt2 * 32 + crow(i, h); const bool ok = (key <= qi) && (!WIN || key >= qi - 128);
                        x[kt2][i] = ok ? x[kt2][i] : -INFINITY; }
            }
#pragma unroll
            for (int kt2 = 0; kt2 < 2; ++kt2)
#pragma unroll
                for (int i = 0; i < 16; ++i) { const float p = __builtin_amdgcn_exp2f(x[kt2][i]); x[kt2][i] = p; lrow += p; }
#pragma unroll
            for (int kt2 = 0; kt2 < 2; ++kt2)
#pragma unroll
                for (int s = 0; s < 2; ++s) {
                    u32x4 pw; pw.x = pk2(x[kt2][8 * s + 0], x[kt2][8 * s + 1]); pw.y = pk2(x[kt2][8 * s + 2], x[kt2][8 * s + 3]); pw.z = pk2(x[kt2][8 * s + 4], x[kt2][8 * s + 5]); pw.w = pk2(x[kt2][8 * s + 6], x[kt2][8 * s + 7]);
                    const bf16x8 pb = __builtin_bit_cast(bf16x8, pw);
#pragma unroll
                    for (int n = 0; n < 2; ++n) { const bf16_t* vp = Vs + (kt2 * 32 + 16 * s) * VLD + 32 * n;
                        const s16x4 lo = vtr(vp), hi = vtr(vp + 8 * VLD);
                        const bf16x8 av = __builtin_shufflevector(lo, hi, 0, 1, 2, 3, 4, 5, 6, 7);
                        o[n] = MFMA32(av, pb, o[n]); } }
        }
    }
#undef ATT_GLOAD
#undef ATT_LWRITE
    lrow += __shfl_xor(lrow, 32);
    const float inv = __builtin_amdgcn_rcpf(lrow); const size_t orow = (size_t)(qw + r) * os;
    u32x2 gv[2][4];
    if (MLA) {
#pragma unroll
        for (int n = 0; n < 2; ++n)
#pragma unroll
            for (int g4 = 0; g4 < 4; ++g4) gv[n][g4] = *(const u32x2*)(Ob + orow + n * 32 + g4 * 8 + 4 * h); }
#pragma unroll
    for (int n = 0; n < 2; ++n)
#pragma unroll
        for (int g4 = 0; g4 < 4; ++g4) { const int dv = n * 32 + g4 * 8 + 4 * h; bf16_t* op = Ob + orow + dv;
            float e0 = o[n][g4 * 4] * inv, e1 = o[n][g4 * 4 + 1] * inv, e2 = o[n][g4 * 4 + 2] * inv, e3 = o[n][g4 * 4 + 3] * inv;
            if (MLA) { const u32x2 g = gv[n][g4]; e0 *= siluf_(bflo(g.x)); e1 *= siluf_(bfhi(g.x)); e2 *= siluf_(bflo(g.y)); e3 *= siluf_(bfhi(g.y)); }
            u32x2 w; w.x = pk2(e0, e1); w.y = pk2(e2, e3); *(u32x2*)op = w; }
    if (!MLA) { if (h == 0) lsep[(size_t)(qw + r) * lses] = (CS + __log2f(lrow)) * LN2; }
}

DI void gsync(unsigned* ctr, unsigned& target) {
    asm volatile("s_waitcnt vmcnt(0)" ::: "memory");
    __syncthreads();
    target += gridDim.x;
    if (threadIdx.x == 0) {
        __builtin_amdgcn_fence(__ATOMIC_RELEASE, "agent");
        asm volatile("s_waitcnt vmcnt(0)" ::: "memory");
        (void)__hip_atomic_fetch_add(ctr, 1u, __ATOMIC_RELAXED, __HIP_MEMORY_SCOPE_AGENT);
        while (__hip_atomic_load(ctr, __ATOMIC_RELAXED, __HIP_MEMORY_SCOPE_AGENT) < target) __builtin_amdgcn_s_sleep(16);
        __builtin_amdgcn_fence(__ATOMIC_ACQUIRE, "agent");
        asm volatile("s_waitcnt vmcnt(0)" ::: "memory");
    }
    __syncthreads();
}

DI void panel_signal(unsigned* cnt) {
    if (threadIdx.x == 0) { __builtin_amdgcn_fence(__ATOMIC_RELEASE, "agent"); asm volatile("s_waitcnt vmcnt(0)" ::: "memory");
        (void)__hip_atomic_fetch_add(cnt, 1u, __ATOMIC_RELAXED, __HIP_MEMORY_SCOPE_AGENT); }
}
DI void panel_wait(unsigned* cnt, unsigned target) {
    if (threadIdx.x == 0) { while (__hip_atomic_load(cnt, __ATOMIC_RELAXED, __HIP_MEMORY_SCOPE_AGENT) < target) __builtin_amdgcn_s_sleep(8);
        __builtin_amdgcn_fence(__ATOMIC_ACQUIRE, "agent"); asm volatile("s_waitcnt vmcnt(0)" ::: "memory"); }
    __syncthreads();
}

__global__ void __launch_bounds__(512, 2) hybrid_fwd(Args a) {
    extern __shared__ __attribute__((aligned(16))) unsigned char lds_raw[];
    cg::grid_group grid = cg::this_grid();
    unsigned char* lds = lds_raw; PG8_LAS unsigned char* ldsl = (PG8_LAS unsigned char*)lds_raw;
    const int G = gridDim.x;
#define bx obid()
    unsigned char* ws = a.ws;
    bf16_t* z = (bf16_t*)(ws + WS_Z); unsigned char* sc = ws + WS_S;
    bf16_t* xn = (bf16_t*)(sc + S_XN); bf16_t* qf = (bf16_t*)(sc + S_QF); bf16_t* kvr = qf + 768; bf16_t* kf = (bf16_t*)(sc + S_KF);
    float* agg = (float*)(sc + S_AGG); float* lse = (float*)(sc + S_LSE); float* mrg = (float*)(sc + S_MRG); bf16_t* mb = (bf16_t*)(sc + S_MB);
    const int* positions = (const int*)a.in[1];

    unsigned* gctr = (unsigned*)(ws + WS_CTL); unsigned gtarget = 0;
    if (blockIdx.x == 0 && threadIdx.x < 129) __hip_atomic_store(gctr + 64 * threadIdx.x, 0u, __ATOMIC_RELAXED, __HIP_MEMORY_SCOPE_AGENT);
    unsigned* cntA = gctr + 64; unsigned* cntB = gctr + 64 * 65; const bool fullgrid = (G == 256);
    unsigned long long tacc = 0, tprev = 0; if (PROBE_K >= 0) tprev = __builtin_amdgcn_s_memrealtime();
    prologue_weights(a, lds);
    if (PROBE_K == 0) { grid.sync(); PSTAMP(0); }
#pragma unroll 1
    for (int l = 0; l < DEPTH; ++l) {
#pragma unroll 1
        for (int c = 0; c < NCHUNK; ++c) {
            int lo = l; asm volatile("" : "+s"(lo));
            const unsigned char* wl = ws + WS_W + (size_t)lo * WL_SIZE;
            const size_t roff = (size_t)c * TC;
            const float* xin = (l == 0 ? a.in[0] : a.out) + roff * DM; float* xout = a.out + roff * DM; const int* pos = positions + roff;
            p0_rmsnorm(xin, a.in[2] + lo * DM, xn);
            if (l == 0 && c == 0) grid.sync(); else gsync(gctr, gtarget);
            PSTAMP(1);
            { pg8::Gemm g; g.A = xn; g.Bt = (const bf16_t*)(wl + WL_IN); g.M = TC; g.N = NZP; g.K = DM; g.lda = DM;
              pg8::StaticOrder S; S.init(TC, NZP, G, bx); EpiZ E; E.O = z; E.ldc = LDZ; E.ncols = INW;
              pg8::gemm_phase<EpiZ, pg8::StaticOrder, true, true>(ldsl, g, S, E); }
            gsync(gctr, gtarget); PSTAMP(2);
            { pg8::Gemm g; g.A = z + C_CQ; g.Bt = (const bf16_t*)(wl + WL_UP); g.M = TC; g.N = NUP; g.K = KUP; g.lda = LDZ;
              pg8::StaticOrder S; S.init(TC, NUP, G, bx); EpiZ E; E.O = qf; E.ldc = LDQ; E.ncols = NUP;
              pg8::gemm_phase<EpiZ, pg8::StaticOrder, true, true>(ldsl, g, S, E);
              if (fullgrid) { pg8::Unit uu; for (int i = 0; S.next(i, uu); ++i) if (uu.pn >= 0) panel_signal(cntB + 64 * uu.pm); } }
            __syncthreads();
            const bool lru_first = (bx & 1) != 0;
            if (!lru_first) dil_prep(z, pos, a.in[19] + lo * 64, a.in[20] + lo * 64);
            LruP lp; lp.conv_w = a.in[4] + (size_t)lo * 4 * 1024; lp.conv_b = a.in[5] + lo * 1024; lp.b_gx = a.in[7] + lo * 1024; lp.b_ga = a.in[9] + lo * 1024; lp.lam = a.in[10] + lo * 1024;
            lp.wgx = (const bf16_t*)(wl + WL_GX); lp.wga = (const bf16_t*)(wl + WL_GA);
            for (int u = bx; u < NB * 64; u += G) lru_unit<false>(lds, z, agg, lp, u >> 6, (u >> 3) & 7, u & 7);
            if (lru_first) { __syncthreads(); dil_prep(z, pos, a.in[19] + lo * 64, a.in[20] + lo * 64); }
            if (fullgrid) panel_wait(cntB + 64 * (bx >> 2), 7u * (unsigned)(l * NCHUNK + c + 1)); else gsync(gctr, gtarget);
            PSTAMP(3);
            mla_finalize(lds, z, qf, kvr, kf, pos, a.in[16] + lo * 96, a.in[17] + lo * 96);
            gsync(gctr, gtarget); PSTAMP(4);
            float cs_mla, cs_dil;
            { float mq = 0.f, mk = 0.f, dq_ = 0.f, dk_ = 0.f; const float* g1 = a.in[16] + lo * 96; const float* g2 = a.in[17] + lo * 96; const float* g3 = a.in[19] + lo * 64; const float* g4 = a.in[20] + lo * 64;
              for (int i = 0; i < 96; ++i) { mq = fmaxf(mq, fabsf(g1[i])); mk = fmaxf(mk, fabsf(g2[i])); }
              for (int i = 0; i < 64; ++i) { dq_ = fmaxf(dq_, fabsf(g3[i])); dk_ = fmaxf(dk_, fabsf(g4[i])); }
              cs_mla = 96.f * 0.10206207261596575f * LOG2E * mq * mk; cs_dil = 64.f * 0.125f * LOG2E * dq_ * dk_; }
            for (int u = bx; u < 512 + NB * 384; u += G) {
                if (u < 512) {
                    int qb, bh; if (u < 256) { qb = 15 - (u >> 5); bh = u & 31; } else { qb = (u - 256) >> 5; bh = (u - 256) & 31; }
                    const int bl = bh >> 3, hd = bh & 7; const size_t t0 = (size_t)bl * SEQ;
                    attn_unit<96, false, true>(lds, qf + t0 * LDQ + hd * 96, LDQ, kf + t0 * 768 + hd * 96, 768, kvr + t0 * LDQ + hd * 128 + 64, LDQ, qb * 256,
                                               z + t0 * LDZ + C_MLAG + hd * 64, LDZ, nullptr, 0, cs_mla);
                } else {
                    const int v = u - 512, bl = v / 384, w = v % 384, gi = w >> 7, w2 = w & 127, hd = w2 >> 4, rem = w2 & 15;
                    const int d = 1 << (2 * gi), npairs = 16 >> (2 * gi), r = rem / npairs, pair = rem % npairs, head = gi * 8 + hd;
                    const size_t brow = (size_t)bl * SEQ + r; bf16_t* zb = z + brow * LDZ + head * 64; const size_t st = (size_t)d * LDZ;
                    attn_unit<64, true, false>(lds, zb + C_DQ, st, zb + C_DK, st, zb + C_DV, st, pair * 256, zb + C_DQ, st, lse + (size_t)gi * TC * 8 + brow * 8 + hd, (size_t)d * 8, cs_dil);
                }
            }
            gsync(gctr, gtarget); PSTAMP(5);
            dil_combine(z, lse);
            for (int u = bx; u < NB * 64; u += G) lru_unit<true>(lds, z, agg, lp, u >> 6, (u >> 3) & 7, u & 7);
            gsync(gctr, gtarget); PSTAMP(6);
            { pg8::Gemm g; g.A = z + C_LRUG; g.Bt = (const bf16_t*)(wl + WL_PCAT); g.M = TC; g.N = DM; g.K = 2048; g.lda = LDZ;
              pg8::StaticOrder S; S.init(TC, DM, G, bx); EpiChain E; E.Z = z; E.bm = a.in[22] + (size_t)lo * 3072; E.MB = mb;
              pg8::gemm_phase<EpiChain, pg8::StaticOrder, true, true>(ldsl, g, S, E);
              if (fullgrid) { pg8::Unit uu; S.next(0, uu); panel_signal(cntA + 64 * uu.pm); panel_wait(cntA + 64 * uu.pm, 4u * (unsigned)(l * NCHUNK + c + 1)); } }
            if (!fullgrid) gsync(gctr, gtarget);
            PSTAMP(7);
            { pg8::Gemm g; g.A = mb; g.Bt = (const bf16_t*)(wl + WL_OUT); g.M = TC; g.N = DM; g.K = DM; g.lda = DM;
              pg8::StaticOrder S; S.init(TC, DM, G, bx); EpiOut E; E.X = xin; E.O = xout;
              pg8::gemm_phase<EpiOut, pg8::StaticOrder, true, true>(ldsl, g, S, E); }
            __syncthreads();
            if (PROBE_K == 8) { grid.sync(); PSTAMP(8); }
        }
    }
    if (PROBE_K >= 0 && blockIdx.x == 0 && threadIdx.x == 0) { const unsigned long long t0 = __builtin_amdgcn_s_memrealtime(); while (__builtin_amdgcn_s_memrealtime() - t0 < tacc) __builtin_amdgcn_s_sleep(8); }
}

extern "C" void kernel_launch(void* const* d_in, const int* in_sizes, int n_in, void* d_out, int out_size, void* d_ws, size_t ws_size, hipStream_t stream) {
    static int grid_blocks = 0;
    if (!grid_blocks) {
        int dev = 0, cus = 0, per_cu = 0;
        (void)hipGetDevice(&dev);
        (void)hipDeviceGetAttribute(&cus, hipDeviceAttributeMultiprocessorCount, dev);
        if (hipFuncSetAttribute((const void*)hybrid_fwd, hipFuncAttributeMaxDynamicSharedMemorySize, LDS_BYTES) != hipSuccess) fprintf(stderr, "hipFuncSetAttribute failed\n");
        if (hipOccupancyMaxActiveBlocksPerMultiprocessor(&per_cu, (const void*)hybrid_fwd, 512, LDS_BYTES) != hipSuccess || per_cu < 1) per_cu = 1;
        grid_blocks = cus * 1;
        if (ws_size < WS_NEED) fprintf(stderr, "workspace too small: %zu < %zu\n", ws_size, (size_t)WS_NEED);
    }
    if (ws_size < WS_NEED || n_in < 24) return;
    Args a{};
    for (int i = 0; i < 24; ++i) a.in[i] = (const float*)d_in[i];
    a.out = (float*)d_out; a.ws = (unsigned char*)d_ws;
    void* args[] = {&a};
    hipError_t e = hipLaunchCooperativeKernel((const void*)hybrid_fwd, dim3(grid_blocks), dim3(512), args, LDS_BYTES, stream);
    if (e != hipSuccess) fprintf(stderr, "cooperative launch failed: %s (grid %d)\n", hipGetErrorString(e), grid_blocks);
}
```

```cpp
#include <hip/hip_runtime.h>
#include <hip/hip_cooperative_groups.h>
#include <cstdio>
#include <cstdint>
namespace cg = cooperative_groups;
__device__ __forceinline__ int otid() { int t = threadIdx.x; asm volatile("" : "+v"(t)); return t; }
__device__ __forceinline__ int obid() { int b = blockIdx.x; asm volatile("" : "+s"(b)); return b; }
namespace pg8 {
#define PG8_LAS __attribute__((address_space(3)))
typedef unsigned short bf16_t;
typedef short bf16x8 __attribute__((ext_vector_type(8)));
typedef float f32x4 __attribute__((ext_vector_type(4)));
typedef unsigned u32x4 __attribute__((ext_vector_type(4)));
constexpr int BM = 256, BK = 64, HALF = 128, HTB = HALF * BK * 2  , STAGE_BYTES = 8 * HTB, NXCD = 8, WGM = 8;

__host__ __device__ __forceinline__ int lds_byte(int r, int c) { const int st = (r >> 4) * 2 + (c >> 5), rr = r & 15, cc = c & 31, ob = rr * 64 + cc * 2; return st * 1024 + (ob ^ (((ob >> 9) & 1) << 5)); }
__host__ __device__ __forceinline__ void stage_rc(int b, int& R, int& C) { const int st = b / 1024, sb = b % 1024, swz = sb ^ (((sb >> 9) & 1) << 5); R = (st >> 1) * 16 + swz / 64; C = (st & 1) * 32 + (swz % 64) / 2; }
__host__ __device__ __forceinline__ int perm32(int rho) { const int n = rho >> 4, i = rho & 15; return 8 * (i >> 2) + 4 * n + (i & 3); }

struct Unit { int pm, pn; };
struct Gemm { const bf16_t* A; const bf16_t* Bt; int M, N, K, lda; };

struct StaticOrder {
    int nM, nN, nwg, G, c;
    __host__ __device__ void init(int M, int N, int G_, int c_) { nM = M / BM; nN = N / BM; nwg = nM * nN; G = G_; c = c_; }
    __host__ __device__ bool next(int i, Unit& u) const {
        const long L = (long)i * G + c; if (L >= nwg) return false;
        int wgid = (int)L; { const int q = nwg / NXCD, r = nwg % NXCD, xcd = wgid % NXCD, off = wgid / NXCD; wgid = (xcd < r ? xcd * (q + 1) : r * (q + 1) + (xcd - r) * q) + off; }
        const int nig = WGM * nN, gid = wgid / nig, fm = gid * WGM, gsz = (nM - fm) < WGM ? (nM - fm) : WGM;
        u.pm = fm + ((wgid % nig) % gsz); u.pn = (wgid % nig) / gsz; return true;
    }
    __device__ __forceinline__ void a_ready(const Unit&) const {}
    __device__ __forceinline__ void done(const Unit&) const {}
};
__device__ __forceinline__ unsigned cvt_pk_bf16(float lo, float hi) { unsigned r; asm volatile("v_cvt_pk_bf16_f32 %0, %1, %2" : "=v"(r) : "v"(lo), "v"(hi)); return r; }
template <class Epi, class Sched, bool ALIGN_EPI = false, bool SP2 = false>
__device__ __forceinline__ void gemm_body(PG8_LAS unsigned char* lds, const Gemm g, const Sched& S, const Epi& E, f32x4 (&acc)[2][2][4][2], const bool zero_init) {
    const int tid = otid(), wid = __builtin_amdgcn_readfirstlane(tid >> 6), lane = tid & 63, wr = wid >> 2, wc = wid & 3, fr = lane & 15, fq = lane >> 4;
    const int K = g.K, nt = K / BK;
    unsigned voffA[2], voffB[2];
#pragma unroll
    for (int i = 0; i < 2; ++i) { int R, C; stage_rc(tid * 16 + i * 8192, R, C); const int Rb = Epi::PERM ? ((R & ~31) + perm32(R & 31)) : R;
        voffA[i] = (unsigned)(R * g.lda + C) * 2u; voffB[i] = (unsigned)(Rb * K + C) * 2u; }
    const size_t kstep = (size_t)(BK * 2);
    const size_t hstepA = (size_t)HALF * g.lda * 2, hstepB = (size_t)HALF * K * 2;
    const size_t tstepA = 2 * hstepA, tstepB = 2 * hstepB;
    const unsigned ldsw = (unsigned)wid * 1024u;
    const int aoff = lds_byte(wr * 64 + fr, fq * 8), boff = lds_byte(wc * 32 + fr, fq * 8);
#define PG8_SA(b, h) (((b) * 2 + (h)) * HTB)
#define PG8_SB(b, h) ((4 + (b) * 2 + (h)) * HTB)
#define PG8_STAGE(bufoff, gbase, voff) do { _Pragma("unroll") for (int _i = 0; _i < 2; ++_i) \
        __builtin_amdgcn_global_load_lds((const unsigned*)((const char*)(gbase) + (voff)[_i]), (PG8_LAS unsigned*)(lds + (bufoff) + ldsw + _i * 8192), 16, 0, 0); } while (0)
#define PG8_LDA(dst, b, h) do { _Pragma("unroll") for (int m = 0; m < 4; ++m) _Pragma("unroll") for (int k = 0; k < 2; ++k) dst[m][k] = *(const PG8_LAS bf16x8*)(lds + PG8_SA(b, h) + aoff + m * 2048 + k * 1024); } while (0)
#define PG8_LDB(dst, b, h) do { _Pragma("unroll") for (int n = 0; n < 2; ++n) _Pragma("unroll") for (int k = 0; k < 2; ++k) dst[n][k] = *(const PG8_LAS bf16x8*)(lds + PG8_SB(b, h) + boff + n * 2048 + k * 1024); } while (0)
#define PG8_MMA(ai, bj, At, Bt) do { __builtin_amdgcn_s_setprio(1); _Pragma("unroll") for (int m = 0; m < 4; ++m) _Pragma("unroll") for (int n = 0; n < 2; ++n) _Pragma("unroll") for (int k = 0; k < 2; ++k) \
        acc[ai][bj][m][n] = __builtin_amdgcn_mfma_f32_16x16x32_bf16(Bt[n][k], At[m][k], acc[ai][bj][m][n], 0, 0, 0); __builtin_amdgcn_s_setprio(0); } while (0)
#define PG8_WAIT_V(n) asm volatile("s_waitcnt vmcnt(" #n ")" ::: "memory")
#define PG8_WAIT_L(n) asm volatile("s_waitcnt lgkmcnt(" #n ")" ::: "memory")
#define PG8_BAR __builtin_amdgcn_s_barrier()
#define PG8_SCHED __builtin_amdgcn_sched_barrier(0)
    Unit cur, nxt; int ui = 0;
    if (!S.next(0, cur)) return;
    if (zero_init) {
#pragma unroll
    for (int a = 0; a < 2; ++a)
#pragma unroll
        for (int b = 0; b < 2; ++b)
#pragma unroll
            for (int m = 0; m < 4; ++m)
#pragma unroll
                for (int n = 0; n < 2; ++n) acc[a][b][m][n] = (f32x4){0.f, 0.f, 0.f, 0.f};
    }
    bf16x8 At[4][2], B0[2][2], B1[2][2];
    const char* cA = (const char*)g.A + (size_t)cur.pm * tstepA; const char* cB = (const char*)g.Bt + (size_t)cur.pn * tstepB;
    S.a_ready(cur);
    if constexpr (SP2) {
        PG8_STAGE(PG8_SB(0, 0), cB, voffB); PG8_STAGE(PG8_SB(0, 1), cB + hstepB, voffB); PG8_STAGE(PG8_SA(0, 0), cA, voffA); PG8_STAGE(PG8_SA(0, 1), cA + hstepA, voffA);
        if (wr == 1) PG8_BAR;
        PG8_WAIT_V(2); PG8_BAR;
        PG8_STAGE(PG8_SB(1, 0), cB + kstep, voffB); PG8_STAGE(PG8_SA(1, 0), cA + kstep, voffA); PG8_STAGE(PG8_SB(1, 1), cB + hstepB + kstep, voffB);
        PG8_WAIT_V(6); PG8_BAR;
    } else {
        PG8_STAGE(PG8_SB(0, 0), cB, voffB); PG8_STAGE(PG8_SA(0, 0), cA, voffA); PG8_STAGE(PG8_SB(0, 1), cB + hstepB, voffB); PG8_STAGE(PG8_SA(0, 1), cA + hstepA, voffA);
        if (wr == 1) PG8_BAR;
        PG8_WAIT_V(4); PG8_BAR;
        PG8_STAGE(PG8_SB(1, 0), cB + kstep, voffB); PG8_STAGE(PG8_SA(1, 0), cA + kstep, voffA); PG8_STAGE(PG8_SB(1, 1), cB + hstepB + kstep, voffB);
        PG8_WAIT_V(6); PG8_BAR;
    }
    for (;;) {
        const bool has_next = S.next(ui + 1, nxt);
        const char* nA = has_next ? (const char*)g.A + (size_t)nxt.pm * tstepA : cA; const char* nB = has_next ? (const char*)g.Bt + (size_t)nxt.pn * tstepB : cB;
#pragma unroll 1
        for (int t = 0; t < nt; t += 2) {
            if constexpr (Epi::CHAIN) { if (t == Epi::T1 || t == Epi::T2) E.mid(acc, cur, t, wr, wc, fr, fq); }
            const bool last = (t == nt - 2);
            const char* a1 = cA + (size_t)(t + 1) * kstep;
            const char* a2 = last ? nA : cA + (size_t)(t + 2) * kstep; const char* b2 = last ? nB : cB + (size_t)(t + 2) * kstep;
            const char* a3 = a2 + kstep; const char* b3 = b2 + kstep;
            if (last && has_next) S.a_ready(nxt);
            if constexpr (SP2) {
            PG8_LDB(B0, 0, 0); PG8_LDB(B1, 0, 1); PG8_SCHED; PG8_LDA(At, 0, 0); PG8_STAGE(PG8_SA(1, 1), a1 + hstepA, voffA);
            PG8_WAIT_V(8); PG8_WAIT_L(0); PG8_BAR; PG8_MMA(0, 0, At, B0); PG8_MMA(0, 1, At, B1); PG8_BAR; PG8_SCHED;
            PG8_LDA(At, 0, 1); PG8_STAGE(PG8_SB(0, 0), b2, voffB); PG8_STAGE(PG8_SB(0, 1), b2 + hstepB, voffB); PG8_STAGE(PG8_SA(0, 0), a2, voffA);
            PG8_WAIT_V(8); PG8_WAIT_L(0); PG8_BAR; PG8_MMA(1, 0, At, B0); PG8_MMA(1, 1, At, B1); PG8_BAR; PG8_SCHED;
            PG8_LDB(B0, 1, 0); PG8_LDB(B1, 1, 1); PG8_SCHED; PG8_LDA(At, 1, 0); PG8_STAGE(PG8_SA(0, 1), a2 + hstepA, voffA);
            PG8_WAIT_V(8); PG8_WAIT_L(0); PG8_BAR; PG8_MMA(0, 0, At, B0); PG8_MMA(0, 1, At, B1); PG8_BAR; PG8_SCHED;
            PG8_LDA(At, 1, 1); PG8_STAGE(PG8_SB(1, 0), b3, voffB); PG8_STAGE(PG8_SB(1, 1), b3 + hstepB, voffB); PG8_STAGE(PG8_SA(1, 0), a3, voffA);
            PG8_WAIT_V(8); PG8_WAIT_L(0); PG8_BAR; PG8_MMA(1, 0, At, B0); PG8_MMA(1, 1, At, B1); PG8_BAR; PG8_SCHED;
            } else {
            PG8_LDB(B0, 0, 0); PG8_SCHED; PG8_LDA(At, 0, 0); PG8_STAGE(PG8_SA(1, 1), a1 + hstepA, voffA);
            PG8_WAIT_L(8); PG8_BAR; PG8_WAIT_L(0); PG8_MMA(0, 0, At, B0); PG8_BAR; PG8_SCHED;
            PG8_LDB(B1, 0, 1); PG8_STAGE(PG8_SB(0, 0), b2, voffB);
            PG8_BAR; PG8_WAIT_L(0); PG8_MMA(0, 1, At, B1); PG8_BAR;
            PG8_LDA(At, 0, 1); PG8_STAGE(PG8_SA(0, 0), a2, voffA);
            PG8_BAR; PG8_WAIT_L(0); PG8_MMA(1, 0, At, B0); PG8_BAR; PG8_SCHED;
            PG8_STAGE(PG8_SB(0, 1), b2 + hstepB, voffB);
            PG8_WAIT_V(6); PG8_BAR; PG8_MMA(1, 1, At, B1); PG8_BAR;
            PG8_LDB(B0, 1, 0); PG8_SCHED; PG8_LDA(At, 1, 0); PG8_STAGE(PG8_SA(0, 1), a2 + hstepA, voffA);
            PG8_WAIT_L(8); PG8_BAR; PG8_WAIT_L(0); PG8_MMA(0, 0, At, B0); PG8_BAR; PG8_SCHED;
            PG8_LDB(B1, 1, 1); PG8_STAGE(PG8_SB(1, 0), b3, voffB);
            PG8_BAR; PG8_WAIT_L(0); PG8_MMA(0, 1, At, B1); PG8_BAR;
            PG8_LDA(At, 1, 1); PG8_STAGE(PG8_SA(1, 0), a3, voffA);
            PG8_BAR; PG8_WAIT_L(0); PG8_MMA(1, 0, At, B0); PG8_BAR; PG8_SCHED;
            PG8_STAGE(PG8_SB(1, 1), b3 + hstepB, voffB);
            PG8_WAIT_V(6); PG8_BAR; PG8_MMA(1, 1, At, B1); PG8_BAR;
            }
        }
        if constexpr (ALIGN_EPI) { if (wr == 0) PG8_BAR; }
        if constexpr (!Epi::AFTER_DRAIN) { E(acc, cur, wr, wc, fr, fq); S.done(cur); }
        if (!has_next) break;
#pragma unroll
        for (int a = 0; a < 2; ++a)
#pragma unroll
            for (int b = 0; b < 2; ++b)
#pragma unroll
                for (int m = 0; m < 4; ++m)
#pragma unroll
                    for (int n = 0; n < 2; ++n) acc[a][b][m][n] = (f32x4){0.f, 0.f, 0.f, 0.f};
        cur = nxt; cA = nA; cB = nB; ++ui;
        if constexpr (ALIGN_EPI) { if (wr == 1) PG8_BAR; }
    }
    PG8_WAIT_V(0);
    if constexpr (!ALIGN_EPI) { if (wr == 0) PG8_BAR; }
    PG8_BAR;
    if constexpr (Epi::AFTER_DRAIN) { E.fused(acc, cur, wr, wc, fr, fq, lds, wid, lane); S.done(cur); }
#undef PG8_SA
#undef PG8_SB
#undef PG8_STAGE
#undef PG8_LDA
#undef PG8_LDB
#undef PG8_MMA
#undef PG8_WAIT_V
#undef PG8_WAIT_L
#undef PG8_BAR
#undef PG8_SCHED
}
template <class Epi, class Sched, bool ALIGN_EPI = false, bool SP2 = false>
__device__ __forceinline__ void gemm_phase(PG8_LAS unsigned char* lds, const Gemm g, const Sched& S, const Epi& E) {
    f32x4 acc[2][2][4][2];
    gemm_body<Epi, Sched, ALIGN_EPI, SP2>(lds, g, S, E, acc, true);
}
struct OneUnit { Unit u;
    __device__ __forceinline__ bool next(int i, Unit& o) const { if (i) return false; o = u; return true; }
    __device__ __forceinline__ void a_ready(const Unit&) const {}
    __device__ __forceinline__ void done(const Unit&) const {} };
}

typedef unsigned short bf16_t;
using pg8::bf16x8; using pg8::f32x4; using pg8::u32x4;
typedef float f32x16 __attribute__((ext_vector_type(16)));
typedef unsigned u32x2 __attribute__((ext_vector_type(2)));
#define DI __device__ __forceinline__
#define MFMA32(a, b, c) __builtin_amdgcn_mfma_f32_32x32x16_bf16((a), (b), (c), 0, 0, 0)

constexpr int SEQ = 4096, BATCH = 8, DM = 1024, DEPTH = 2;
constexpr int NB = 4, TC = NB * SEQ, NCHUNK = BATCH / NB;
constexpr int INW = 11168, LDZ = 11168, NZP = 11264;
constexpr int C_LRUX = 0, C_LRUG = 1024, C_MLAG = 2048, C_DILG = 2560, C_DQ = 3072, C_DK = 4608, C_DV = 6144, C_MERGE = 7680, C_CQ = 10752, C_CKV = 11008, C_KR = 11136;
constexpr float EPS = 1e-6f, LOG2E = 1.4426950408889634f, LN2 = 0.6931471805599453f, LOG2_THETA = 13.287712379549449f;
constexpr int NUP = 1792, KUP = 384;

constexpr size_t W_IN_B = (size_t)NZP * DM * 2, W_UP_B = (size_t)NUP * KUP * 2, W_SQ_B = (size_t)DM * DM * 2, W_HF_B = (size_t)DM * 512 * 2, W_G_B = (size_t)8 * 128 * 128 * 2;
constexpr size_t WL_IN = 0, WL_UP = WL_IN + W_IN_B, WL_PCAT = WL_UP + W_UP_B  , WL_OUT = WL_PCAT + W_SQ_B + 2 * W_HF_B,
                 WL_GX = WL_OUT + W_SQ_B, WL_GA = WL_GX + W_G_B, WL_SIZE = WL_GA + W_G_B;
constexpr size_t WS_W = 0, WS_Z = WS_W + 2 * WL_SIZE, WS_S = WS_Z + (size_t)TC * LDZ * 2;
constexpr size_t S_XN = 0;
constexpr int LDQ = 1792;
constexpr size_t S_QF = 0, S_KF = S_QF + (size_t)TC * LDQ * 2, S_AGG = S_KF + (size_t)TC * 768 * 2,
                 S_LSE = S_AGG + (size_t)(TC / 64) * 1024 * 8, S_P23_END = S_LSE + (size_t)3 * TC * 8 * 4;
constexpr size_t S_MRG = 0, S_MB = S_MRG + (size_t)TC * DM * 4, S_END = S_MB + (size_t)TC * DM * 2;
static_assert(S_P23_END <= S_END, "scratch");
constexpr size_t WS_CTL = WS_S + S_END;
constexpr size_t WS_NEED = WS_CTL + 256 * 129;
static_assert(WS_NEED <= 536870912ull, "workspace");
static_assert(WS_Z % 256 == 0 && WS_S % 256 == 0 && WL_SIZE % 256 == 0, "align");
constexpr int LDS_BYTES = 139264;

DI float bflo(unsigned w) { return __uint_as_float(w << 16); }
DI float bfhi(unsigned w) { return __uint_as_float(w & 0xffff0000u); }
DI unsigned pk2(float lo, float hi) { typedef float f2_t __attribute__((ext_vector_type(2))); typedef __bf16 b2_t __attribute__((ext_vector_type(2)));
    f2_t v = {lo, hi}; b2_t b = __builtin_convertvector(v, b2_t); return __builtin_bit_cast(unsigned, b); }
DI float sigmoidf_(float x) { return __builtin_amdgcn_rcpf(1.f + __builtin_amdgcn_exp2f(-LOG2E * x)); }
DI float siluf_(float x) { return x * sigmoidf_(x); }
DI float fexp_(float x) { return __builtin_amdgcn_exp2f(LOG2E * x); }
DI float wave_sum(float v) {
#pragma unroll
    for (int m = 1; m < 64; m <<= 1) v += __shfl_xor(v, m);
    return v; }
DI void lds_barrier() { asm volatile("s_waitcnt lgkmcnt(0)\n\ts_barrier" ::: "memory"); }
DI int crow(int i, int h) { return (i & 3) + 8 * (i >> 2) + 4 * h; }
DI void sincos_rev(float ang, float& s, float& c) { float rev = ang * 0.15915494309189535f; rev = rev - floorf(rev); s = __builtin_amdgcn_sinf(rev); c = __builtin_amdgcn_cosf(rev); }

struct Args { const float* in[24]; float* out; unsigned char* ws; };
#ifndef PROBE_K
#define PROBE_K (-1)
#endif
#define PSTAMP(k) do { if (PROBE_K >= 0) { const unsigned long long now_ = __builtin_amdgcn_s_memrealtime(); if ((k) == PROBE_K) tacc += now_ - tprev; tprev = now_; } } while (0)

DI void wconv_job(float* tl, const float* __restrict__ src, int lds_, int n0s, int nrows, int ncols, bf16_t* dst, int ldd, int n0d, int k0d, const float* __restrict__ scale) {
    const int tid = otid(), ntn = ncols / 32, ntk = nrows / 128, nt = ntn * ntk;
    float pv[8];
#define WC_LOAD(T) { const int tn_ = (T) % ntn, k0_ = ((T) / ntn) * 128; _Pragma("unroll") for (int i = 0; i < 8; ++i) { const int kk = i * 16 + (tid >> 5), nn = tid & 31; \
        float v = src[(size_t)(k0_ + kk) * lds_ + n0s + tn_ * 32 + nn]; if (scale) v *= scale[k0_ + kk]; pv[i] = v; } }
    int t = obid(); if (t < nt) WC_LOAD(t)
    for (; t < nt; t += gridDim.x) {
        const int tn = t % ntn, tk = t / ntn, k0 = tk * 128;
#pragma unroll
        for (int i = 0; i < 8; ++i) tl[(i * 16 + (tid >> 5)) * 33 + (tid & 31)] = pv[i];
        __syncthreads();
        if (t + (int)gridDim.x < nt) WC_LOAD(t + gridDim.x)
        { const int n = tid >> 4, kq = tid & 15; u32x4 w;
          w.x = pk2(tl[(kq * 8 + 0) * 33 + n], tl[(kq * 8 + 1) * 33 + n]); w.y = pk2(tl[(kq * 8 + 2) * 33 + n], tl[(kq * 8 + 3) * 33 + n]);
          w.z = pk2(tl[(kq * 8 + 4) * 33 + n], tl[(kq * 8 + 5) * 33 + n]); w.w = pk2(tl[(kq * 8 + 6) * 33 + n], tl[(kq * 8 + 7) * 33 + n]);
          *(u32x4*)(dst + (size_t)(n0d + tn * 32 + n) * ldd + k0d + k0 + kq * 8) = w; }
        lds_barrier();
    }
#undef WC_LOAD
}
DI void zero_rect(bf16_t* dst, int ldd, int n0, int nn, int k0, int nk) {
    const int per = nk / 8, tot = nn * per;
    for (int i = obid() * 512 + otid(); i < tot; i += gridDim.x * 512) { const int n = i / per, c = i % per;
        *(u32x4*)(dst + (size_t)(n0 + n) * ldd + k0 + c * 8) = (u32x4){0u, 0u, 0u, 0u}; }
}
DI void prologue_weights(const Args& a, unsigned char* lds) {
    float* tl = (float*)lds;
    for (int l = 0; l < DEPTH; ++l) {
        unsigned char* wl = a.ws + WS_W + (size_t)l * WL_SIZE;
        bf16_t* win = (bf16_t*)(wl + WL_IN); const float* w_in = a.in[3] + (size_t)l * DM * INW;
        wconv_job(tl, w_in, INW, 0,    1024, 2048, win, DM, C_LRUX, 0, nullptr);
        wconv_job(tl, w_in, INW, 2464, 1024, 512,  win, DM, C_MLAG, 0, nullptr);
        wconv_job(tl, w_in, INW, 7584, 1024, 512,  win, DM, C_DILG, 0, nullptr);
        wconv_job(tl, w_in, INW, 2976, 1024, 4608, win, DM, C_DQ, 0, nullptr);
        wconv_job(tl, w_in, INW, 8096, 1024, 3072, win, DM, C_MERGE, 0, nullptr);
        wconv_job(tl, w_in, INW, 2048, 1024, 416,  win, DM, C_CQ, 0, nullptr);
        zero_rect(win, DM, INW, NZP - INW, 0, DM);
        bf16_t* wup = (bf16_t*)(wl + WL_UP);
        wconv_job(tl, a.in[14] + (size_t)l * 256 * 768, 768, 0, 256, 768, wup, KUP, 0, 0, a.in[12] + l * 256);
        wconv_job(tl, a.in[15] + (size_t)l * 128 * 1024, 1024, 0, 128, 1024, wup, KUP, 768, 256, a.in[13] + l * 128);
        zero_rect(wup, KUP, 0, 768, 256, 128); zero_rect(wup, KUP, 768, 1024, 0, 256);
        wconv_job(tl, a.in[11] + (size_t)l * DM * DM, DM, 0, 1024, 1024, (bf16_t*)(wl + WL_PCAT), 2048, 0, 0, nullptr);
        wconv_job(tl, a.in[18] + (size_t)l * 512 * DM, DM, 0, 512, 1024, (bf16_t*)(wl + WL_PCAT), 2048, 0, 1024, nullptr);
        wconv_job(tl, a.in[21] + (size_t)l * 512 * DM, DM, 0, 512, 1024, (bf16_t*)(wl + WL_PCAT), 2048, 0, 1536, nullptr);
        wconv_job(tl, a.in[23] + (size_t)l * DM * DM, DM, 0, 1024, 1024, (bf16_t*)(wl + WL_OUT), 1024, 0, 0, nullptr);
        for (int nb = 0; nb < 8; ++nb) {
            wconv_job(tl, a.in[6] + ((size_t)l * 8 + nb) * 128 * 128, 128, 0, 128, 128, (bf16_t*)(wl + WL_GX) + nb * 128 * 128, 128, 0, 0, nullptr);
            wconv_job(tl, a.in[8] + ((size_t)l * 8 + nb) * 128 * 128, 128, 0, 128, 128, (bf16_t*)(wl + WL_GA) + nb * 128 * 128, 128, 0, 0, nullptr);
        }
    }
}

DI void p0_rmsnorm(const float* __restrict__ x, const float* __restrict__ g, bf16_t* xn) {
    const int tid = otid(), lane = tid & 63, gw = obid() * 8 + (tid >> 6), nw = gridDim.x * 8;
    f32x4 gv[4];
#pragma unroll
    for (int i = 0; i < 4; ++i) gv[i] = *(const f32x4*)(g + i * 256 + lane * 4);
    for (int row = gw; row < TC; row += nw) {
        const float* xr = x + (size_t)row * DM; f32x4 v[4]; float ss = 0.f;
#pragma unroll
        for (int i = 0; i < 4; ++i) { v[i] = *(const f32x4*)(xr + i * 256 + lane * 4); ss += v[i][0] * v[i][0] + v[i][1] * v[i][1] + v[i][2] * v[i][2] + v[i][3] * v[i][3]; }
        ss = wave_sum(ss); const float rs = rsqrtf(ss * (1.f / DM) + EPS);
#pragma unroll
        for (int i = 0; i < 4; ++i) { u32x2 w; w.x = pk2(v[i][0] * rs * gv[i][0], v[i][1] * rs * gv[i][1]); w.y = pk2(v[i][2] * rs * gv[i][2], v[i][3] * rs * gv[i][3]);
            *(u32x2*)(xn + (size_t)row * DM + i * 256 + lane * 4) = w; }
    }
}

struct EpiZ {
    static constexpr bool PERM = true, AFTER_DRAIN = false, CHAIN = false;
    bf16_t* O; int ldc; int ncols;
    DI void operator()(const f32x4 (&acc)[2][2][4][2], const pg8::Unit& u, int wr, int wc, int fr, int fq) const {
        const int row0 = u.pm * 256 + wr * 64 + fr, col0 = u.pn * 256 + wc * 32 + 8 * fq;
#pragma unroll
        for (int ai = 0; ai < 2; ++ai)
#pragma unroll
            for (int m = 0; m < 4; ++m) { bf16_t* rowp = O + (size_t)(row0 + ai * 128 + m * 16) * ldc;
#pragma unroll
                for (int bj = 0; bj < 2; ++bj) { const int c = col0 + bj * 128; if (c < ncols) { const f32x4 v0 = acc[ai][bj][m][0], v1 = acc[ai][bj][m][1];
                    u32x4 w; w.x = pk2(v0[0], v0[1]); w.y = pk2(v0[2], v0[3]); w.z = pk2(v1[0], v1[1]); w.w = pk2(v1[2], v1[3]); *(u32x4*)(rowp + c) = w; } } }
    }
};
struct EpiChain {
    static constexpr bool PERM = true, AFTER_DRAIN = false, CHAIN = true; static constexpr int T1 = 16, T2 = 24;
    const bf16_t* Z; const float* bm; bf16_t* MB;
    template <bool FIN> DI void run(f32x4 (&acc)[2][2][4][2], const pg8::Unit& u, int br, int wr, int wc, int fr_, int fq_) const {
        int fr = fr_, fq = fq_; asm volatile("" : "+v"(fr), "+v"(fq));
        const int row0 = u.pm * 256 + wr * 64 + fr, col0 = u.pn * 256 + wc * 32 + 8 * fq;
        const float* bmb = bm + br * 1024; const bf16_t* zb = Z + C_MERGE + br * 1024;
#pragma unroll
        for (int bj = 0; bj < 2; ++bj)
#pragma unroll
            for (int n = 0; n < 2; ++n) { const int c = col0 + bj * 128 + 4 * n;
                f32x4 b = *(const f32x4*)(bmb + c) * (-LOG2E), d = b; if (!FIN) d = *(const f32x4*)(bmb + 1024 + c) * (-LOG2E);
                u32x2 gz[8], hz[8];
#pragma unroll
                for (int q = 0; q < 8; ++q) { const bf16_t* zp = zb + (size_t)(row0 + (q >> 2) * 128 + (q & 3) * 16) * LDZ + c; gz[q] = *(const u32x2*)zp; if (!FIN) hz[q] = *(const u32x2*)(zp + 1024); }
#pragma unroll
                for (int q = 0; q < 8; ++q) { const int ai = q >> 2, m = q & 3; const size_t row = (size_t)(row0 + ai * 128 + m * 16);
                    f32x4 sc;
                    sc[0] = __builtin_amdgcn_rcpf(1.f + __builtin_amdgcn_exp2f(bflo(gz[q].x) * (-LOG2E) + b[0])); sc[1] = __builtin_amdgcn_rcpf(1.f + __builtin_amdgcn_exp2f(bfhi(gz[q].x) * (-LOG2E) + b[1]));
                    sc[2] = __builtin_amdgcn_rcpf(1.f + __builtin_amdgcn_exp2f(bflo(gz[q].y) * (-LOG2E) + b[2])); sc[3] = __builtin_amdgcn_rcpf(1.f + __builtin_amdgcn_exp2f(bfhi(gz[q].y) * (-LOG2E) + b[3]));
                    if (!FIN) {
                        sc[0] *= 1.f + __builtin_amdgcn_exp2f(bflo(hz[q].x) * (-LOG2E) + d[0]); sc[1] *= 1.f + __builtin_amdgcn_exp2f(bfhi(hz[q].x) * (-LOG2E) + d[1]);
                        sc[2] *= 1.f + __builtin_amdgcn_exp2f(bflo(hz[q].y) * (-LOG2E) + d[2]); sc[3] *= 1.f + __builtin_amdgcn_exp2f(bfhi(hz[q].y) * (-LOG2E) + d[3]);
                        acc[ai][bj][m][n] *= sc; asm volatile("" : "+v"(acc[ai][bj][m][n]));
                    } else {
                        const f32x4 v = acc[ai][bj][m][n] * sc; u32x2 w; w.x = pk2(v[0], v[1]); w.y = pk2(v[2], v[3]); *(u32x2*)(MB + row * DM + c) = w; } }
                asm volatile("" ::: "memory"); }
    }
    DI void mid(f32x4 (&acc)[2][2][4][2], const pg8::Unit& u, int t, int wr, int wc, int fr, int fq) const { run<false>(acc, u, t == T1 ? 0 : 1, wr, wc, fr, fq); }
    DI void operator()(f32x4 (&acc)[2][2][4][2], const pg8::Unit& u, int wr, int wc, int fr, int fq) const { run<true>(acc, u, 2, wr, wc, fr, fq); }
};
struct EpiOut {
    static constexpr bool PERM = false, AFTER_DRAIN = false, CHAIN = false;
    const float* X; float* O;
    DI void operator()(const f32x4 (&acc)[2][2][4][2], const pg8::Unit& u, int wr, int wc, int fr, int fq) const {
        const int row0 = u.pm * 256 + wr * 64 + fr, col0 = u.pn * 256 + wc * 32 + 4 * fq;
#pragma unroll
        for (int ai = 0; ai < 2; ++ai)
#pragma unroll
            for (int mp = 0; mp < 2; ++mp) {
                f32x4 xv[2][2][2];
#pragma unroll
                for (int mm = 0; mm < 2; ++mm) { const size_t ro = (size_t)(row0 + ai * 128 + (mp * 2 + mm) * 16) * DM + col0;
#pragma unroll
                    for (int bj = 0; bj < 2; ++bj)
#pragma unroll
                        for (int n = 0; n < 2; ++n) xv[mm][bj][n] = *(const f32x4*)(X + ro + bj * 128 + n * 16); }
#pragma unroll
                for (int mm = 0; mm < 2; ++mm) { const size_t ro = (size_t)(row0 + ai * 128 + (mp * 2 + mm) * 16) * DM + col0;
#pragma unroll
                    for (int bj = 0; bj < 2; ++bj)
#pragma unroll
                        for (int n = 0; n < 2; ++n) *(f32x4*)(O + ro + bj * 128 + n * 16) = xv[mm][bj][n] + acc[ai][bj][mp * 2 + mm][n]; }
                asm volatile("" ::: "memory"); }
    }
};

#define UNPK8(W_, d, o, sc_) { const u32x4 w_ = (W_); d[o + 0] = bflo(w_.x) * (sc_); d[o + 1] = bfhi(w_.x) * (sc_); d[o + 2] = bflo(w_.y) * (sc_); d[o + 3] = bfhi(w_.y) * (sc_); d[o + 4] = bflo(w_.z) * (sc_); d[o + 5] = bfhi(w_.z) * (sc_); d[o + 6] = bflo(w_.w) * (sc_); d[o + 7] = bfhi(w_.w) * (sc_); }
DI void dil_prep(bf16_t* z, const int* __restrict__ pos, const float* __restrict__ gq, const float* __restrict__ gk) {
    const int tid = otid(), lane = tid & 63, gw = obid() * 8 + (tid >> 6), nw = gridDim.x * 8, j = lane & 7, hsub = lane >> 3;
    float inv[8], gqo[8], gqp[8], gko[8], gkp[8];
#pragma unroll
    for (int e = 0; e < 8; ++e) { inv[e] = __builtin_amdgcn_exp2f(-(float)(8 * (j & 3) + e) * (LOG2_THETA / 32.f));
        gqo[e] = gq[j * 8 + e]; gqp[e] = gq[(j ^ 4) * 8 + e]; gko[e] = gk[j * 8 + e]; gkp[e] = gk[(j ^ 4) * 8 + e]; }
    const float sgn = (j < 4) ? -1.f : 1.f;
    for (int wi0 = gw; wi0 < TC * 6; wi0 += 8 * nw) {
        u32x4 wv[8];
#pragma unroll
        for (int b = 0; b < 8; ++b) { const int wi = wi0 + b * nw; wv[b] = (u32x4){0u, 0u, 0u, 0u};
            if (wi < TC * 6) { const int tok = wi / 6, grp = wi - tok * 6; wv[b] = *(const u32x4*)(z + (size_t)tok * LDZ + (grp < 3 ? C_DQ + grp * 512 : C_DK + (grp - 3) * 512) + hsub * 64 + j * 8); } }
#pragma unroll
        for (int b = 0; b < 8; ++b) { const int wi = wi0 + b * nw; if (wi < TC * 6) {
            const int tok = wi / 6, grp = wi - tok * 6; const bool isq = grp < 3;
            bf16_t* p = z + (size_t)tok * LDZ + (isq ? C_DQ + grp * 512 : C_DK + (grp - 3) * 512) + hsub * 64 + j * 8;
            const u32x4 w = wv[b]; u32x4 q;
            q.x = __shfl_xor(w.x, 4); q.y = __shfl_xor(w.y, 4); q.z = __shfl_xor(w.z, 4); q.w = __shfl_xor(w.w, 4);
            float v[8], u[8]; UNPK8(w, v, 0, 1.f) UNPK8(q, u, 0, 1.f)
            float ss = 0.f;
#pragma unroll
            for (int e = 0; e < 8; ++e) ss += v[e] * v[e];
            ss += __shfl_xor(ss, 1); ss += __shfl_xor(ss, 2); ss += __shfl_xor(ss, 4);
            const float rs = rsqrtf(ss * (1.f / 64.f) + EPS) * (isq ? 0.125f * LOG2E : 1.f);
            const float fp = (float)pos[tok];
            float o[8];
#pragma unroll
            for (int e = 0; e < 8; ++e) { float sn, cs; sincos_rev(fp * inv[e], sn, cs);
                const float a = v[e] * rs * (isq ? gqo[e] : gko[e]), bb = u[e] * rs * (isq ? gqp[e] : gkp[e]); o[e] = a * cs + sgn * bb * sn; }
            u32x4 r; r.x = pk2(o[0], o[1]); r.y = pk2(o[2], o[3]); r.z = pk2(o[4], o[5]); r.w = pk2(o[6], o[7]);
            *(u32x4*)p = r; } }
    }
}

DI float ssq8(u32x4 w) { return bflo(w.x) * bflo(w.x) + bfhi(w.x) * bfhi(w.x) + bflo(w.y) * bflo(w.y) + bfhi(w.y) * bfhi(w.y) + bflo(w.z) * bflo(w.z) + bfhi(w.z) * bfhi(w.z) + bflo(w.w) * bflo(w.w) + bfhi(w.w) * bfhi(w.w); }
DI u32x4 scale8(u32x4 w, float s, const float* __restrict__ g) { u32x4 o; o.x = pk2(bflo(w.x) * s * g[0], bfhi(w.x) * s * g[1]); o.y = pk2(bflo(w.y) * s * g[2], bfhi(w.y) * s * g[3]);
    o.z = pk2(bflo(w.z) * s * g[4], bfhi(w.z) * s * g[5]); o.w = pk2(bflo(w.w) * s * g[6], bfhi(w.w) * s * g[7]); return o; }
DI void rope16(float (&v)[32], const float* __restrict__ g, float fp) {
#pragma unroll
    for (int i = 0; i < 16; ++i) { const float inv = exp2f(-(float)i * (LOG2_THETA / 16.f)); float sn, cs; sincos_rev(fp * inv, sn, cs);
        const float x1 = v[i] * g[i], x2 = v[16 + i] * g[16 + i]; v[i] = x1 * cs - x2 * sn; v[16 + i] = x2 * cs + x1 * sn; }
}
DI void mla_finalize(unsigned char* lds, const bf16_t* z, bf16_t* qf, bf16_t* kvr, bf16_t* kf, const int* __restrict__ pos, const float* __restrict__ gqn_g, const float* __restrict__ gkn_g) {
    float* rst = (float*)lds;
    float* gl = rst + 128; const float* gqn = gl; const float* gkn = gl + 96;
    for (int grp = obid(); grp < TC / 64; grp += gridDim.x) {
        const int tid = otid(), lane = tid & 63, wid = tid >> 6;
        const int t0 = grp * 64;
        const int tl_ = tid >> 3, hd = tid & 7, tok = t0 + tl_;
        bf16_t* pq = qf + (size_t)tok * LDQ + hd * 96; bf16_t* pkv = kvr + (size_t)tok * LDQ + hd * 128; const bf16_t* pkr = z + (size_t)tok * LDZ + C_KR; bf16_t* pk = kf + (size_t)tok * 768 + hd * 96;
        u32x4 rq[12];
#pragma unroll
        for (int c = 0; c < 12; ++c) rq[c] = *(const u32x4*)(pq + c * 8);
        const float fp = (float)pos[tok];
        if (tid < 192) gl[tid] = (tid < 96) ? gqn_g[tid] : gkn_g[tid - 96];
        u32x2 la[8]; unsigned lb[8];
#pragma unroll
        for (int i = 0; i < 8; ++i) { const bf16_t* zr = z + (size_t)(t0 + wid * 8 + i) * LDZ; la[i] = *(const u32x2*)(zr + C_CQ + lane * 4); lb[i] = *(const unsigned*)(zr + C_CKV + lane * 2); }
        __syncthreads();
#pragma unroll
        for (int i = 0; i < 8; ++i) {
            float s1 = bflo(la[i].x) * bflo(la[i].x) + bfhi(la[i].x) * bfhi(la[i].x) + bflo(la[i].y) * bflo(la[i].y) + bfhi(la[i].y) * bfhi(la[i].y), s2 = bflo(lb[i]) * bflo(lb[i]) + bfhi(lb[i]) * bfhi(lb[i]);
            s1 = wave_sum(s1); s2 = wave_sum(s2);
            if (lane == 0) { rst[(wid * 8 + i) * 2] = rsqrtf(s1 * (1.f / 256.f) + EPS); rst[(wid * 8 + i) * 2 + 1] = rsqrtf(s2 * (1.f / 128.f) + EPS); } }
        __syncthreads();
        const float rcq = rst[tl_ * 2], rckv = rst[tl_ * 2 + 1];
        {
            float ss = 0.f;
#pragma unroll
            for (int c = 0; c < 12; ++c) ss += ssq8(rq[c]);
            ss *= rcq * rcq;
            const float rs = rsqrtf(ss * (1.f / 96.f) + EPS) * rcq * (0.10206207261596575f * LOG2E);
#pragma unroll
            for (int c = 0; c < 8; ++c) *(u32x4*)(pq + c * 8) = scale8(rq[c], rs, gqn + c * 8);
            float v[32];
#pragma unroll
            for (int c = 0; c < 4; ++c) { UNPK8(rq[8 + c], v, c * 8, rs) }
            rope16(v, gqn + 64, fp);
#pragma unroll
            for (int c = 0; c < 4; ++c) { u32x4 w; w.x = pk2(v[c * 8 + 0], v[c * 8 + 1]); w.y = pk2(v[c * 8 + 2], v[c * 8 + 3]); w.z = pk2(v[c * 8 + 4], v[c * 8 + 5]); w.w = pk2(v[c * 8 + 6], v[c * 8 + 7]);
                *(u32x4*)(pq + 64 + c * 8) = w; }
        }
        asm volatile("" ::: "memory");
        {
            u32x4 rk[8], rv[8], rr[4];
#pragma unroll
            for (int c = 0; c < 8; ++c) { rk[c] = *(const u32x4*)(pkv + c * 8); rv[c] = *(const u32x4*)(pkv + 64 + c * 8); }
#pragma unroll
            for (int c = 0; c < 4; ++c) rr[c] = *(const u32x4*)(pkr + c * 8);
            float ss = 0.f, sr = 0.f;
#pragma unroll
            for (int c = 0; c < 8; ++c) ss += ssq8(rk[c]);
#pragma unroll
            for (int c = 0; c < 4; ++c) sr += ssq8(rr[c]);
            ss = ss * rckv * rckv + sr;
            const float rs = rsqrtf(ss * (1.f / 96.f) + EPS);
#pragma unroll
            for (int c = 0; c < 8; ++c) *(u32x4*)(pk + c * 8) = scale8(rk[c], rs * rckv, gkn + c * 8);
            float v[32];
#pragma unroll
            for (int c = 0; c < 4; ++c) { UNPK8(rr[c], v, c * 8, rs) }
            rope16(v, gkn + 64, fp);
#pragma unroll
            for (int c = 0; c < 4; ++c) { u32x4 w; w.x = pk2(v[c * 8 + 0], v[c * 8 + 1]); w.y = pk2(v[c * 8 + 2], v[c * 8 + 3]); w.z = pk2(v[c * 8 + 4], v[c * 8 + 5]); w.w = pk2(v[c * 8 + 6], v[c * 8 + 7]);
                *(u32x4*)(pk + 64 + c * 8) = w; }
#pragma unroll
            for (int c = 0; c < 8; ++c) { u32x4 w = rv[c];
                w.x = pk2(bflo(w.x) * rckv, bfhi(w.x) * rckv); w.y = pk2(bflo(w.y) * rckv, bfhi(w.y) * rckv); w.z = pk2(bflo(w.z) * rckv, bfhi(w.z) * rckv); w.w = pk2(bflo(w.w) * rckv, bfhi(w.w) * rckv);
                *(u32x4*)(pkv + 64 + c * 8) = w; }
        }
    }
}

DI void dil_combine(bf16_t* z, const float* __restrict__ lse) {
    const int tot = TC * 64, stride = gridDim.x * 512;
    for (int it0 = obid() * 512 + otid(); it0 < tot; it0 += 2 * stride) {
        u32x4 A[2], B[2], C[2], Gt[2]; float L0[2], L1[2], L2[2];
#pragma unroll
        for (int b = 0; b < 2; ++b) { const int it = it0 + b * stride; if (it < tot) { const int tok = it >> 6, hd = (it >> 3) & 7, dc = it & 7; const bf16_t* zr = z + (size_t)tok * LDZ;
            L0[b] = lse[(size_t)tok * 8 + hd]; L1[b] = lse[(size_t)TC * 8 + (size_t)tok * 8 + hd]; L2[b] = lse[(size_t)2 * TC * 8 + (size_t)tok * 8 + hd];
            A[b] = *(const u32x4*)(zr + C_DQ + (0 * 8 + hd) * 64 + dc * 8); B[b] = *(const u32x4*)(zr + C_DQ + (1 * 8 + hd) * 64 + dc * 8); C[b] = *(const u32x4*)(zr + C_DQ + (2 * 8 + hd) * 64 + dc * 8);
            Gt[b] = *(const u32x4*)(zr + C_DILG + hd * 64 + dc * 8); } }
#pragma unroll
        for (int b = 0; b < 2; ++b) { const int it = it0 + b * stride; if (it < tot) { const int tok = it >> 6, hd = (it >> 3) & 7, dc = it & 7;
            const float l0 = L0[b], l1 = L1[b], l2 = L2[b];
            const float mx = fmaxf(l0, fmaxf(l1, l2)); float w0 = fexp_(l0 - mx), w1 = fexp_(l1 - mx), w2 = fexp_(l2 - mx); const float iw = __builtin_amdgcn_rcpf(w0 + w1 + w2); w0 *= iw; w1 *= iw; w2 *= iw;
            const u32x4 a = A[b], bq = B[b], c = C[b], g = Gt[b]; u32x4 o;
#define CMB(F) { const float e0 = (w0 * bflo(a.F) + w1 * bflo(bq.F) + w2 * bflo(c.F)) * siluf_(bflo(g.F)), e1 = (w0 * bfhi(a.F) + w1 * bfhi(bq.F) + w2 * bfhi(c.F)) * siluf_(bfhi(g.F)); o.F = pk2(e0, e1); }
            CMB(x) CMB(y) CMB(z) CMB(w)
#undef CMB
            *(u32x4*)(z + (size_t)tok * LDZ + C_DILG + hd * 64 + dc * 8) = o; } }
    }
}

struct LruP { const float* conv_w; const float* conv_b; const float* b_gx; const float* b_ga; const float* lam; const bf16_t* wgx; const bf16_t* wga; };
constexpr int L_XS = 0, L_XCB = 18432, L_XC = L_XCB + 17408, L_HB = L_XC + 32768, L_CW = L_HB + 32768, L_EX = L_CW + 5 * 128 * 4, L_END = L_EX + 2 * 128 * 8;
static_assert(L_END <= LDS_BYTES, "lru lds");
template <bool FINAL> DI void lru_unit(unsigned char* lds, bf16_t* z, float* agg, const LruP& P, int bl, int n, int grp) {
    const int tid0 = otid();
    bf16_t* xs = (bf16_t*)(lds + L_XS); bf16_t* xcb = (bf16_t*)(lds + L_XCB); float* xc = (float*)(lds + L_XC); float* hb = (float*)(lds + L_HB);
    float* cw = (float*)(lds + L_CW); float2* ex = (float2*)(lds + L_EX);
    __syncthreads();
    const int tid = tid0, lane = tid & 63, wid = tid >> 6, r = lane & 31, h = lane >> 5, ct = wid & 3, rt = wid >> 2;
    for (int i = tid; i < 640; i += 512) cw[i] = (i < 512) ? P.conv_w[(i >> 7) * 1024 + n * 128 + (i & 127)] : P.conv_b[n * 128 + (i & 127)];
    bf16x8 bx[8], ba[8];
    { const bf16_t* wx = P.wgx + (size_t)n * 16384 + (size_t)(ct * 32 + r) * 128 + 8 * h; const bf16_t* wa = P.wga + (size_t)n * 16384 + (size_t)(ct * 32 + r) * 128 + 8 * h;
#pragma unroll
      for (int s = 0; s < 8; ++s) { bx[s] = *(const bf16x8*)(wx + 16 * s); ba[s] = *(const bf16x8*)(wa + 16 * s); } }
    const int ch = ct * 32 + r, chg = n * 128 + ch; const float bgx = P.b_gx[chg], bga = P.b_ga[chg]; const float sp = __logf(1.f + __expf(-P.lam[chg]));
    float hrun = 0.f, Arun = 1.f;
    if (FINAL) {
#pragma unroll
        for (int g2 = 0; g2 < 7; ++g2) if (g2 < grp) { const float2 ab = *(const float2*)(agg + ((size_t)(bl * 8 + g2) * 1024 + chg) * 2); hrun = ab.x * hrun + ab.y; } }
    const size_t rowb = (size_t)bl * SEQ;
    u32x4 xr[3], gr[2];
#define LRU_XLOAD(J) { _Pragma("unroll") for (int q = 0; q < 3; ++q) { const int c = tid + q * 512; const int i = c >> 4, cc = c & 15; const int p = (J) * 64 - 3 + i; \
        xr[q] = (u32x4){0u, 0u, 0u, 0u}; if (c < 67 * 16 && p >= 0) xr[q] = *(const u32x4*)(z + (rowb + p) * LDZ + C_LRUX + n * 128 + cc * 8); } }
#pragma unroll
    for (int s = 0; s < 8; ++s) asm volatile("" :: "v"(bx[s]), "v"(ba[s]));
    asm volatile("" :: "v"(bgx), "v"(bga), "v"(sp), "v"(hrun));
    LRU_XLOAD(grp * 8)
    __syncthreads();
#pragma unroll 1
    for (int jt = 0; jt < 8; ++jt) {
        int tq = tid0; asm volatile("" : "+v"(tq));
        const int tid = tq, lane = tid & 63, wid = tid >> 6, r = lane & 31, h = lane >> 5, ct = wid & 3, rt = wid >> 2, ch = ct * 32 + r;
        const int j = grp * 8 + jt; const size_t row0 = rowb + (size_t)j * 64;
#pragma unroll
        for (int q = 0; q < 3; ++q) { const int c = tid + q * 512; if (c < 67 * 16) *(u32x4*)(xs + (c >> 4) * 136 + (c & 15) * 8) = xr[q]; }
        lds_barrier();
        if (jt + 1 < 8) LRU_XLOAD(j + 1)
        if (FINAL) {
#pragma unroll
            for (int q = 0; q < 2; ++q) { const int c = tid + q * 512; gr[q] = *(const u32x4*)(z + (row0 + (c >> 4)) * LDZ + C_LRUG + n * 128 + (c & 15) * 8); } }
        {
            const int i = tid >> 3, c0 = (tid & 7) * 16; float acc[16];
#pragma unroll
            for (int q = 0; q < 4; ++q) { const f32x4 b = *(const f32x4*)(cw + 512 + c0 + q * 4); acc[q * 4] = b[0]; acc[q * 4 + 1] = b[1]; acc[q * 4 + 2] = b[2]; acc[q * 4 + 3] = b[3]; }
#pragma unroll
            for (int k = 0; k < 4; ++k) {
                const u32x4 xa = *(const u32x4*)(xs + (i + k) * 136 + c0), xb = *(const u32x4*)(xs + (i + k) * 136 + c0 + 8);
                const float xv[16] = {bflo(xa.x), bfhi(xa.x), bflo(xa.y), bfhi(xa.y), bflo(xa.z), bfhi(xa.z), bflo(xa.w), bfhi(xa.w), bflo(xb.x), bfhi(xb.x), bflo(xb.y), bfhi(xb.y), bflo(xb.z), bfhi(xb.z), bflo(xb.w), bfhi(xb.w)};
#pragma unroll
                for (int q = 0; q < 4; ++q) { const f32x4 w = *(const f32x4*)(cw + k * 128 + c0 + q * 4);
                    acc[q * 4] += w[0] * xv[q * 4]; acc[q * 4 + 1] += w[1] * xv[q * 4 + 1]; acc[q * 4 + 2] += w[2] * xv[q * 4 + 2]; acc[q * 4 + 3] += w[3] * xv[q * 4 + 3]; } }
#pragma unroll
            for (int q = 0; q < 4; ++q) *(f32x4*)(xc + i * 128 + c0 + q * 4) = (f32x4){acc[q * 4], acc[q * 4 + 1], acc[q * 4 + 2], acc[q * 4 + 3]};
            u32x4 w0, w1; w0.x = pk2(acc[0], acc[1]); w0.y = pk2(acc[2], acc[3]); w0.z = pk2(acc[4], acc[5]); w0.w = pk2(acc[6], acc[7]);
            w1.x = pk2(acc[8], acc[9]); w1.y = pk2(acc[10], acc[11]); w1.z = pk2(acc[12], acc[13]); w1.w = pk2(acc[14], acc[15]);
            *(u32x4*)(xcb + i * 136 + c0) = w0; *(u32x4*)(xcb + i * 136 + c0 + 8) = w1;
        }
        lds_barrier();
        float av[16], bv[16], Ao[4], Ho[4], Ap[4], Hp[4];
        {
            f32x16 gx, ga;
#pragma unroll
            for (int i = 0; i < 16; ++i) { gx[i] = 0.f; ga[i] = 0.f; }
#pragma unroll
            for (int s = 0; s < 8; ++s) { const bf16x8 a = *(const bf16x8*)(xcb + (rt * 32 + r) * 136 + 16 * s + 8 * h); gx = MFMA32(a, bx[s], gx); ga = MFMA32(a, ba[s], ga); }
#pragma unroll
            for (int i = 0; i < 16; ++i) { const int tk = rt * 32 + crow(i, h);
                const float vgx = sigmoidf_(gx[i] + bgx), vga = sigmoidf_(ga[i] + bga); const float la = -8.f * vga * sp; av[i] = fexp_(la);
                const float mult = __builtin_amdgcn_sqrtf(fmaxf(1.f - av[i] * av[i], 0.f));
                bv[i] = mult * vgx * xc[tk * 128 + ch]; }
        }
#pragma unroll
        for (int g = 0; g < 4; ++g) { float H = 0.f, A = 1.f;
#pragma unroll
            for (int k = 0; k < 4; ++k) { H = av[4 * g + k] * H + bv[4 * g + k]; A *= av[4 * g + k]; }
            Ao[g] = A; Ho[g] = H; Ap[g] = __shfl_xor(A, 32); Hp[g] = __shfl_xor(H, 32); }
        {   float c = 0.f, At = 1.f;
#pragma unroll
            for (int g = 0; g < 4; ++g) { const float A1 = h ? Ap[g] : Ao[g], H1 = h ? Hp[g] : Ho[g], A2 = h ? Ao[g] : Ap[g], H2 = h ? Ho[g] : Hp[g]; c = A1 * c + H1; c = A2 * c + H2; At *= A1 * A2; }
            if (h == 0) ex[rt * 128 + ch] = make_float2(At, c); }
        lds_barrier();
        {   const float2 e0 = ex[ch], e1 = ex[128 + ch]; const float hmid = e0.x * hrun + e0.y;
            float c = rt ? hmid : hrun;
            hrun = e1.x * hmid + e1.y; Arun *= e0.x * e1.x;
            if (FINAL) {
#pragma unroll
                for (int g = 0; g < 4; ++g) { const float A1 = h ? Ap[g] : Ao[g], H1 = h ? Hp[g] : Ho[g], A2 = h ? Ao[g] : Ap[g], H2 = h ? Ho[g] : Hp[g];
                    const float c1 = A1 * c + H1; float hh = h ? c1 : c; c = A2 * c1 + H2;
#pragma unroll
                    for (int k = 0; k < 4; ++k) { hh = av[4 * g + k] * hh + bv[4 * g + k]; hb[(rt * 32 + 8 * g + 4 * h + k) * 128 + ch] = hh; } } } }
        if (FINAL) {
            lds_barrier();
#pragma unroll
            for (int q = 0; q < 2; ++q) { const int c = tid + q * 512; const int i = c >> 4, cc = c & 15; bf16_t* gp = z + (row0 + i) * LDZ + C_LRUG + n * 128 + cc * 8; const u32x4 g = gr[q];
                const f32x4 h0 = *(const f32x4*)(hb + i * 128 + cc * 8), h1 = *(const f32x4*)(hb + i * 128 + cc * 8 + 4); u32x4 o;
                o.x = pk2(h0[0] * siluf_(bflo(g.x)), h0[1] * siluf_(bfhi(g.x))); o.y = pk2(h0[2] * siluf_(bflo(g.y)), h0[3] * siluf_(bfhi(g.y)));
                o.z = pk2(h1[0] * siluf_(bflo(g.z)), h1[1] * siluf_(bfhi(g.z))); o.w = pk2(h1[2] * siluf_(bflo(g.w)), h1[3] * siluf_(bfhi(g.w))); *(u32x4*)gp = o; }
        }
    }
#undef LRU_XLOAD
    if (!FINAL && h == 0 && rt == 0) *(float2*)(agg + ((size_t)(bl * 8 + grp) * 1024 + chg) * 2) = make_float2(Arun, hrun);
}

typedef short s16x4 __attribute__((ext_vector_type(4)));
DI s16x4 vtr(const bf16_t* p) { return __builtin_amdgcn_ds_read_tr16_b64_v4i16((__attribute__((address_space(3))) s16x4*)p); }
template <int DK, bool WIN, bool MLA>
DI void attn_unit(unsigned char* lds, const bf16_t* Qb, size_t qs, const bf16_t* Kb, size_t ks, const bf16_t* Vb, size_t vs, int q0, bf16_t* Ob, size_t os, float* lsep, size_t lses, const float CS) {
    constexpr int KLD = DK + 8, VLD = 96, KC = DK / 8, NKR = (128 * KC) / 512, KBYTES = 128 * KLD * 2, BUFB = KBYTES + 128 * VLD * 2;
    static_assert((128 * KC) % 512 == 0 && 2 * BUFB <= LDS_BYTES, "attention staging");
    const int tid = otid(), lane = tid & 63, wid = tid >> 6, r = lane & 31, h = lane >> 5;
    const int qw = q0 + 32 * wid;
    bf16x8 qf[DK / 16];
    { const bf16_t* qrow = Qb + (size_t)(qw + r) * qs + 8 * h;
#pragma unroll
      for (int s = 0; s < DK / 16; ++s) qf[s] = *(const bf16x8*)(qrow + 16 * s); }
    f32x16 o[2];
#pragma unroll
    for (int i = 0; i < 16; ++i) { o[0][i] = 0.f; o[1][i] = 0.f; }
    float lrow = 0.f;
    const int kt_lo = WIN ? (q0 >= 128 ? (q0 - 128) / 128 : 0) : 0, kt_hi = (q0 + 255) / 128, ntile = kt_hi - kt_lo + 1;
    const int kfrag = r * KLD + 8 * h, vfrag = (4 * h + ((lane & 15) >> 2)) * VLD + 16 * ((lane >> 4) & 1) + 4 * (lane & 3);
    u32x4 kreg[NKR], vreg[2];
#define ATT_GLOAD(KT) { const size_t kb = (size_t)(KT) * 128; \
        _Pragma("unroll") for (int q_ = 0; q_ < NKR; ++q_) { const int c_ = tid + q_ * 512; kreg[q_] = *(const u32x4*)(Kb + (kb + c_ / KC) * ks + (c_ % KC) * 8); } \
        _Pragma("unroll") for (int q_ = 0; q_ < 2; ++q_) { const int c_ = tid + q_ * 512; vreg[q_] = *(const u32x4*)(Vb + (kb + (c_ >> 3)) * vs + (c_ & 7) * 8); } }
#define ATT_LWRITE(SLOT) { bf16_t* kp_ = (bf16_t*)(lds + (SLOT) * BUFB); bf16_t* vp_ = (bf16_t*)(lds + (SLOT) * BUFB + KBYTES); \
        _Pragma("unroll") for (int q_ = 0; q_ < NKR; ++q_) { const int c_ = tid + q_ * 512; *(u32x4*)(kp_ + (c_ / KC) * KLD + (c_ % KC) * 8) = kreg[q_]; } \
        _Pragma("unroll") for (int q_ = 0; q_ < 2; ++q_) { const int c_ = tid + q_ * 512; *(u32x4*)(vp_ + (c_ >> 3) * VLD + (c_ & 7) * 8) = vreg[q_]; } }
    ATT_GLOAD(kt_lo)
#pragma unroll
    for (int s = 0; s < DK / 16; ++s) asm volatile("" :: "v"(qf[s]));
    __syncthreads();
    ATT_LWRITE(0)
    if (ntile > 1) ATT_GLOAD(kt_lo + 1)
#pragma unroll 1
    for (int it = 0; it < ntile; ++it) {
        const int kbase = (kt_lo + it) * 128;
        lds_barrier();
        if (it + 1 < ntile) { ATT_LWRITE((it + 1) & 1) if (it + 2 < ntile) ATT_GLOAD(kt_lo + it + 2) }
        const bf16_t* Ks = (const bf16_t*)(lds + (it & 1) * BUFB) + kfrag; const bf16_t* Vs = (const bf16_t*)(lds + (it & 1) * BUFB + KBYTES) + vfrag;
        const int qi = qw + r;
#pragma unroll
        for (int hp = 0; hp < 2; ++hp) {
            const int kb = kbase + 64 * hp;
            const bool active = (kb <= qw + 31) && (!WIN || kb + 63 >= qw - 128);
            if (active) {
                f32x16 x[2];
#pragma unroll
                for (int i = 0; i < 16; ++i) { x[0][i] = -CS; x[1][i] = -CS; }
#pragma unroll
                for (int s = 0; s < DK / 16; ++s) { const bf16x8 a0 = *(const bf16x8*)(Ks + (hp * 64) * KLD + 16 * s), a1 = *(const bf16x8*)(Ks + (hp * 64 + 32) * KLD + 16 * s);
                    x[0] = MFMA32(a0, qf[s], x[0]); x[1] = MFMA32(a1, qf[s], x[1]); }
                const bool need_mask = (kb + 63 > qw) || (WIN && kb < qw + 31 - 128);
                if (need_mask) {
#pragma unroll
                    for (int kt2 = 0; kt2 < 2; ++kt2)
#pragma unroll
                        for (int i = 0; i < 16; ++i) { const int key = kb + kt2 * 32 + crow(i, h); const bool ok = (key <= qi) && (!WIN || key >= qi - 128); x[kt2][i] = ok ? x[kt2][i] : -INFINITY; } }
#pragma unroll
                for (int kt2 = 0; kt2 < 2; ++kt2)
#pragma unroll
                    for (int i = 0; i < 16; ++i) { const float p = __builtin_amdgcn_exp2f(x[kt2][i]); x[kt2][i] = p; lrow += p; }
#pragma unroll
                for (int kt2 = 0; kt2 < 2; ++kt2)
#pragma unroll
                    for (int s = 0; s < 2; ++s) {
                        u32x4 pw; pw.x = pk2(x[kt2][8 * s + 0], x[kt2][8 * s + 1]); pw.y = pk2(x[kt2][8 * s + 2], x[kt2][8 * s + 3]); pw.z = pk2(x[kt2][8 * s + 4], x[kt2][8 * s + 5]); pw.w = pk2(x[kt2][8 * s + 6], x[kt2][8 * s + 7]);
                        const bf16x8 pb = __builtin_bit_cast(bf16x8, pw);
#pragma unroll
                        for (int n = 0; n < 2; ++n) { const bf16_t* vp = Vs + (hp * 64 + kt2 * 32 + 16 * s) * VLD + 32 * n;
                            const s16x4 lo = vtr(vp), hi = vtr(vp + 8 * VLD);
                            const bf16x8 av = __builtin_shufflevector(lo, hi, 0, 1, 2, 3, 4, 5, 6, 7);
                            o[n] = MFMA32(av, pb, o[n]); } }
            }
        }
    }
#undef ATT_GLOAD
#undef ATT_LWRITE
    lrow += __shfl_xor(lrow, 32);
    const float inv = __builtin_amdgcn_rcpf(lrow); const size_t orow = (size_t)(qw + r) * os;
    u32x2 gv[2][4];
    if (MLA) {
#pragma unroll
        for (int n = 0; n < 2; ++n)
#pragma unroll
            for (int g4 = 0; g4 < 4; ++g4) gv[n][g4] = *(const u32x2*)(Ob + orow + n * 32 + g4 * 8 + 4 * h); }
#pragma unroll
    for (int n = 0; n < 2; ++n)
#pragma unroll
        for (int g4 = 0; g4 < 4; ++g4) { const int dv = n * 32 + g4 * 8 + 4 * h; bf16_t* op = Ob + orow + dv;
            float e0 = o[n][g4 * 4] * inv, e1 = o[n][g4 * 4 + 1] * inv, e2 = o[n][g4 * 4 + 2] * inv, e3 = o[n][g4 * 4 + 3] * inv;
            if (MLA) { const u32x2 g = gv[n][g4]; e0 *= siluf_(bflo(g.x)); e1 *= siluf_(bfhi(g.x)); e2 *= siluf_(bflo(g.y)); e3 *= siluf_(bfhi(g.y)); }
            u32x2 w; w.x = pk2(e0, e1); w.y = pk2(e2, e3); *(u32x2*)op = w; }
    if (!MLA) { if (h == 0) lsep[(size_t)(qw + r) * lses] = (CS + __log2f(lrow)) * LN2; }
}

DI void gsync(unsigned* ctr, unsigned& target) {
    asm volatile("s_waitcnt vmcnt(0)" ::: "memory");
    __syncthreads();
    target += gridDim.x;
    if (threadIdx.x == 0) {
        __builtin_amdgcn_fence(__ATOMIC_RELEASE, "agent");
        asm volatile("s_waitcnt vmcnt(0)" ::: "memory");
        (void)__hip_atomic_fetch_add(ctr, 1u, __ATOMIC_RELAXED, __HIP_MEMORY_SCOPE_AGENT);
        while (__hip_atomic_load(ctr, __ATOMIC_RELAXED, __HIP_MEMORY_SCOPE_AGENT) < target) __builtin_amdgcn_s_sleep(16);
        __builtin_amdgcn_fence(__ATOMIC_ACQUIRE, "agent");
        asm volatile("s_waitcnt vmcnt(0)" ::: "memory");
    }
    __syncthreads();
}

DI void panel_signal(unsigned* cnt) {
    if (threadIdx.x == 0) { __builtin_amdgcn_fence(__ATOMIC_RELEASE, "agent"); asm volatile("s_waitcnt vmcnt(0)" ::: "memory");
        (void)__hip_atomic_fetch_add(cnt, 1u, __ATOMIC_RELAXED, __HIP_MEMORY_SCOPE_AGENT); }
}
DI void panel_wait(unsigned* cnt, unsigned target) {
    if (threadIdx.x == 0) { while (__hip_atomic_load(cnt, __ATOMIC_RELAXED, __HIP_MEMORY_SCOPE_AGENT) < target) __builtin_amdgcn_s_sleep(8);
        __builtin_amdgcn_fence(__ATOMIC_ACQUIRE, "agent"); asm volatile("s_waitcnt vmcnt(0)" ::: "memory"); }
    __syncthreads();
}

__global__ void __launch_bounds__(512, 2) hybrid_fwd(Args a) {
    extern __shared__ __attribute__((aligned(16))) unsigned char lds_raw[];
    cg::grid_group grid = cg::this_grid();
    unsigned char* lds = lds_raw; PG8_LAS unsigned char* ldsl = (PG8_LAS unsigned char*)lds_raw;
    const int G = gridDim.x;
#define bx obid()
    unsigned char* ws = a.ws;
    bf16_t* z = (bf16_t*)(ws + WS_Z); unsigned char* sc = ws + WS_S;
    bf16_t* xn = (bf16_t*)(sc + S_XN); bf16_t* qf = (bf16_t*)(sc + S_QF); bf16_t* kvr = qf + 768; bf16_t* kf = (bf16_t*)(sc + S_KF);
    float* agg = (float*)(sc + S_AGG); float* lse = (float*)(sc + S_LSE); float* mrg = (float*)(sc + S_MRG); bf16_t* mb = (bf16_t*)(sc + S_MB);
    const int* positions = (const int*)a.in[1];

    unsigned* gctr = (unsigned*)(ws + WS_CTL); unsigned gtarget = 0;
    if (blockIdx.x == 0 && threadIdx.x < 129) __hip_atomic_store(gctr + 64 * threadIdx.x, 0u, __ATOMIC_RELAXED, __HIP_MEMORY_SCOPE_AGENT);
    unsigned* cntA = gctr + 64; unsigned* cntB = gctr + 64 * 65; const bool fullgrid = (G == 256);
    unsigned long long tacc = 0, tprev = 0; if (PROBE_K >= 0) tprev = __builtin_amdgcn_s_memrealtime();
    prologue_weights(a, lds);
    if (PROBE_K == 0) { grid.sync(); PSTAMP(0); }
#pragma unroll 1
    for (int l = 0; l < DEPTH; ++l) {
#pragma unroll 1
        for (int c = 0; c < NCHUNK; ++c) {
            int lo = l; asm volatile("" : "+s"(lo));
            const unsigned char* wl = ws + WS_W + (size_t)lo * WL_SIZE;
            const size_t roff = (size_t)c * TC;
            const float* xin = (l == 0 ? a.in[0] : a.out) + roff * DM; float* xout = a.out + roff * DM; const int* pos = positions + roff;
            p0_rmsnorm(xin, a.in[2] + lo * DM, xn);
            if (l == 0 && c == 0) grid.sync(); else gsync(gctr, gtarget);
            PSTAMP(1);
            { pg8::Gemm g; g.A = xn; g.Bt = (const bf16_t*)(wl + WL_IN); g.M = TC; g.N = NZP; g.K = DM; g.lda = DM;
              pg8::StaticOrder S; S.init(TC, NZP, G, bx); EpiZ E; E.O = z; E.ldc = LDZ; E.ncols = INW;
              pg8::gemm_phase<EpiZ, pg8::StaticOrder, true, true>(ldsl, g, S, E); }
            gsync(gctr, gtarget); PSTAMP(2);
            { pg8::Gemm g; g.A = z + C_CQ; g.Bt = (const bf16_t*)(wl + WL_UP); g.M = TC; g.N = NUP; g.K = KUP; g.lda = LDZ;
              pg8::StaticOrder S; S.init(TC, NUP, G, bx); EpiZ E; E.O = qf; E.ldc = LDQ; E.ncols = NUP;
              pg8::gemm_phase<EpiZ, pg8::StaticOrder, true, true>(ldsl, g, S, E);
              if (fullgrid) { pg8::Unit uu; for (int i = 0; S.next(i, uu); ++i) if (uu.pn >= 0) panel_signal(cntB + 64 * uu.pm); } }
            __syncthreads();
            const bool lru_first = (bx & 1) != 0;
            if (!lru_first) dil_prep(z, pos, a.in[19] + lo * 64, a.in[20] + lo * 64);
            LruP lp; lp.conv_w = a.in[4] + (size_t)lo * 4 * 1024; lp.conv_b = a.in[5] + lo * 1024; lp.b_gx = a.in[7] + lo * 1024; lp.b_ga = a.in[9] + lo * 1024; lp.lam = a.in[10] + lo * 1024;
            lp.wgx = (const bf16_t*)(wl + WL_GX); lp.wga = (const bf16_t*)(wl + WL_GA);
            for (int u = bx; u < NB * 64; u += G) lru_unit<false>(lds, z, agg, lp, u >> 6, (u >> 3) & 7, u & 7);
            if (lru_first) { __syncthreads(); dil_prep(z, pos, a.in[19] + lo * 64, a.in[20] + lo * 64); }
            if (fullgrid) panel_wait(cntB + 64 * (bx >> 2), 7u * (unsigned)(l * NCHUNK + c + 1)); else gsync(gctr, gtarget);
            PSTAMP(3);
            mla_finalize(lds, z, qf, kvr, kf, pos, a.in[16] + lo * 96, a.in[17] + lo * 96);
            gsync(gctr, gtarget); PSTAMP(4);
            float cs_mla, cs_dil;
            { float mq = 0.f, mk = 0.f, dq_ = 0.f, dk_ = 0.f; const float* g1 = a.in[16] + lo * 96; const float* g2 = a.in[17] + lo * 96; const float* g3 = a.in[19] + lo * 64; const float* g4 = a.in[20] + lo * 64;
              for (int i = 0; i < 96; ++i) { mq = fmaxf(mq, fabsf(g1[i])); mk = fmaxf(mk, fabsf(g2[i])); }
              for (int i = 0; i < 64; ++i) { dq_ = fmaxf(dq_, fabsf(g3[i])); dk_ = fmaxf(dk_, fabsf(g4[i])); }
              cs_mla = 96.f * 0.10206207261596575f * LOG2E * mq * mk; cs_dil = 64.f * 0.125f * LOG2E * dq_ * dk_; }
            for (int u = bx; u < 512 + NB * 384; u += G) {
                if (u < 512) {
                    int qb, bh; if (u < 256) { qb = 15 - (u >> 5); bh = u & 31; } else { qb = (u - 256) >> 5; bh = (u - 256) & 31; }
                    const int bl = bh >> 3, hd = bh & 7; const size_t t0 = (size_t)bl * SEQ;
                    attn_unit<96, false, true>(lds, qf + t0 * LDQ + hd * 96, LDQ, kf + t0 * 768 + hd * 96, 768, kvr + t0 * LDQ + hd * 128 + 64, LDQ, qb * 256,
                                               z + t0 * LDZ + C_MLAG + hd * 64, LDZ, nullptr, 0, cs_mla);
                } else {
                    const int v = u - 512, bl = v / 384, w = v % 384, gi = w >> 7, w2 = w & 127, hd = w2 >> 4, rem = w2 & 15;
                    const int d = 1 << (2 * gi), npairs = 16 >> (2 * gi), r = rem / npairs, pair = rem % npairs, head = gi * 8 + hd;
                    const size_t brow = (size_t)bl * SEQ + r; bf16_t* zb = z + brow * LDZ + head * 64; const size_t st = (size_t)d * LDZ;
                    attn_unit<64, true, false>(lds, zb + C_DQ, st, zb + C_DK, st, zb + C_DV, st, pair * 256, zb + C_DQ, st, lse + (size_t)gi * TC * 8 + brow * 8 + hd, (size_t)d * 8, cs_dil);
                }
            }
            gsync(gctr, gtarget); PSTAMP(5);
            dil_combine(z, lse);
            for (int u = bx; u < NB * 64; u += G) lru_unit<true>(lds, z, agg, lp, u >> 6, (u >> 3) & 7, u & 7);
            gsync(gctr, gtarget); PSTAMP(6);
            { pg8::Gemm g; g.A = z + C_LRUG; g.Bt = (const bf16_t*)(wl + WL_PCAT); g.M = TC; g.N = DM; g.K = 2048; g.lda = LDZ;
              pg8::StaticOrder S; S.init(TC, DM, G, bx); EpiChain E; E.Z = z; E.bm = a.in[22] + (size_t)lo * 3072; E.MB = mb;
              pg8::gemm_phase<EpiChain, pg8::StaticOrder, true, true>(ldsl, g, S, E);
              if (fullgrid) { pg8::Unit uu; S.next(0, uu); panel_signal(cntA + 64 * uu.pm); panel_wait(cntA + 64 * uu.pm, 4u * (unsigned)(l * NCHUNK + c + 1)); } }
            if (!fullgrid) gsync(gctr, gtarget);
            PSTAMP(7);
            { pg8::Gemm g; g.A = mb; g.Bt = (const bf16_t*)(wl + WL_OUT); g.M = TC; g.N = DM; g.K = DM; g.lda = DM;
              pg8::StaticOrder S; S.init(TC, DM, G, bx); EpiOut E; E.X = xin; E.O = xout;
              pg8::gemm_phase<EpiOut, pg8::StaticOrder, true, true>(ldsl, g, S, E); }
            __syncthreads();
            if (PROBE_K == 8) { grid.sync(); PSTAMP(8); }
        }
    }
    if (PROBE_K >= 0 && blockIdx.x == 0 && threadIdx.x == 0) { const unsigned long long t0 = __builtin_amdgcn_s_memrealtime(); while (__builtin_amdgcn_s_memrealtime() - t0 < tacc) __builtin_amdgcn_s_sleep(8); }
}

extern "C" void kernel_launch(void* const* d_in, const int* in_sizes, int n_in, void* d_out, int out_size, void* d_ws, size_t ws_size, hipStream_t stream) {
    static int grid_blocks = 0;
    if (!grid_blocks) {
        int dev = 0, cus = 0, per_cu = 0;
        (void)hipGetDevice(&dev);
        (void)hipDeviceGetAttribute(&cus, hipDeviceAttributeMultiprocessorCount, dev);
        if (hipFuncSetAttribute((const void*)hybrid_fwd, hipFuncAttributeMaxDynamicSharedMemorySize, LDS_BYTES) != hipSuccess) fprintf(stderr, "hipFuncSetAttribute failed\n");
        if (hipOccupancyMaxActiveBlocksPerMultiprocessor(&per_cu, (const void*)hybrid_fwd, 512, LDS_BYTES) != hipSuccess || per_cu < 1) per_cu = 1;
        grid_blocks = cus * 1;
        if (ws_size < WS_NEED) fprintf(stderr, "workspace too small: %zu < %zu\n", ws_size, (size_t)WS_NEED);
    }
    if (ws_size < WS_NEED || n_in < 24) return;
    Args a{};
    for (int i = 0; i < 24; ++i) a.in[i] = (const float*)d_in[i];
    a.out = (float*)d_out; a.ws = (unsigned char*)d_ws;
    void* args[] = {&a};
    hipError_t e = hipLaunchCooperativeKernel((const void*)hybrid_fwd, dim3(grid_blocks), dim3(512), args, LDS_BYTES, stream);
    if (e != hipSuccess) fprintf(stderr, "cooperative launch failed: %s (grid %d)\n", hipGetErrorString(e), grid_blocks);
}
```

```cpp
#include <hip/hip_runtime.h>
#include <hip/hip_cooperative_groups.h>
#include <cstdio>
#include <cstdint>
namespace cg = cooperative_groups;
__device__ __forceinline__ int otid() { int t = threadIdx.x; asm volatile("" : "+v"(t)); return t; }
__device__ __forceinline__ int obid() { int b = blockIdx.x; asm volatile("" : "+s"(b)); return b; }
namespace pg8 {
#define PG8_LAS __attribute__((address_space(3)))
typedef unsigned short bf16_t;
typedef short bf16x8 __attribute__((ext_vector_type(8)));
typedef float f32x4 __attribute__((ext_vector_type(4)));
typedef unsigned u32x4 __attribute__((ext_vector_type(4)));
constexpr int BM = 256, BK = 64, HALF = 128, HTB = HALF * BK * 2  , STAGE_BYTES = 8 * HTB, NXCD = 8, WGM = 8;

__host__ __device__ __forceinline__ int lds_byte(int r, int c) { const int st = (r >> 4) * 2 + (c >> 5), rr = r & 15, cc = c & 31, ob = rr * 64 + cc * 2; return st * 1024 + (ob ^ (((ob >> 9) & 1) << 5)); }
__host__ __device__ __forceinline__ void stage_rc(int b, int& R, int& C) { const int st = b / 1024, sb = b % 1024, swz = sb ^ (((sb >> 9) & 1) << 5); R = (st >> 1) * 16 + swz / 64; C = (st & 1) * 32 + (swz % 64) / 2; }
__host__ __device__ __forceinline__ int perm32(int rho) { const int n = rho >> 4, i = rho & 15; return 8 * (i >> 2) + 4 * n + (i & 3); }

struct Unit { int pm, pn; };
struct Gemm { const bf16_t* A; const bf16_t* Bt; int M, N, K, lda; };

struct StaticOrder {
    int nM, nN, nwg, G, c;
    __host__ __device__ void init(int M, int N, int G_, int c_) { nM = M / BM; nN = N / BM; nwg = nM * nN; G = G_; c = c_; }
    __host__ __device__ bool next(int i, Unit& u) const {
        const long L = (long)i * G + c; if (L >= nwg) return false;
        int wgid = (int)L; { const int q = nwg / NXCD, r = nwg % NXCD, xcd = wgid % NXCD, off = wgid / NXCD; wgid = (xcd < r ? xcd * (q + 1) : r * (q + 1) + (xcd - r) * q) + off; }
        const int nig = WGM * nN, gid = wgid / nig, fm = gid * WGM, gsz = (nM - fm) < WGM ? (nM - fm) : WGM;
        u.pm = fm + ((wgid % nig) % gsz); u.pn = (wgid % nig) / gsz; return true;
    }
    __device__ __forceinline__ void a_ready(const Unit&) const {}
    __device__ __forceinline__ void done(const Unit&) const {}
};
__device__ __forceinline__ unsigned cvt_pk_bf16(float lo, float hi) { unsigned r; asm volatile("v_cvt_pk_bf16_f32 %0, %1, %2" : "=v"(r) : "v"(lo), "v"(hi)); return r; }
template <class Epi, class Sched, bool ALIGN_EPI = false, bool SP2 = false>
__device__ __forceinline__ void gemm_body(PG8_LAS unsigned char* lds, const Gemm g, const Sched& S, const Epi& E, f32x4 (&acc)[2][2][4][2], const bool zero_init) {
    const int tid = otid(), wid = __builtin_amdgcn_readfirstlane(tid >> 6), lane = tid & 63, wr = wid >> 2, wc = wid & 3, fr = lane & 15, fq = lane >> 4;
    const int K = g.K, nt = K / BK;
    unsigned voffA[2], voffB[2];
#pragma unroll
    for (int i = 0; i < 2; ++i) { int R, C; stage_rc(tid * 16 + i * 8192, R, C); const int Rb = Epi::PERM ? ((R & ~31) + perm32(R & 31)) : R;
        voffA[i] = (unsigned)(R * g.lda + C) * 2u; voffB[i] = (unsigned)(Rb * K + C) * 2u; }
    const size_t kstep = (size_t)(BK * 2);
    const size_t hstepA = (size_t)HALF * g.lda * 2, hstepB = (size_t)HALF * K * 2;
    const size_t tstepA = 2 * hstepA, tstepB = 2 * hstepB;
    const unsigned ldsw = (unsigned)wid * 1024u;
    const int aoff = lds_byte(wr * 64 + fr, fq * 8), boff = lds_byte(wc * 32 + fr, fq * 8);
#define PG8_SA(b, h) (((b) * 2 + (h)) * HTB)
#define PG8_SB(b, h) ((4 + (b) * 2 + (h)) * HTB)
#define PG8_STAGE(bufoff, gbase, voff) do { _Pragma("unroll") for (int _i = 0; _i < 2; ++_i) \
        __builtin_amdgcn_global_load_lds((const unsigned*)((const char*)(gbase) + (voff)[_i]), (PG8_LAS unsigned*)(lds + (bufoff) + ldsw + _i * 8192), 16, 0, 0); } while (0)
#define PG8_LDA(dst, b, h) do { _Pragma("unroll") for (int m = 0; m < 4; ++m) _Pragma("unroll") for (int k = 0; k < 2; ++k) dst[m][k] = *(const PG8_LAS bf16x8*)(lds + PG8_SA(b, h) + aoff + m * 2048 + k * 1024); } while (0)
#define PG8_LDB(dst, b, h) do { _Pragma("unroll") for (int n = 0; n < 2; ++n) _Pragma("unroll") for (int k = 0; k < 2; ++k) dst[n][k] = *(const PG8_LAS bf16x8*)(lds + PG8_SB(b, h) + boff + n * 2048 + k * 1024); } while (0)
#define PG8_MMA(ai, bj, At, Bt) do { __builtin_amdgcn_s_setprio(1); _Pragma("unroll") for (int m = 0; m < 4; ++m) _Pragma("unroll") for (int n = 0; n < 2; ++n) _Pragma("unroll") for (int k = 0; k < 2; ++k) \
        acc[ai][bj][m][n] = __builtin_amdgcn_mfma_f32_16x16x32_bf16(Bt[n][k], At[m][k], acc[ai][bj][m][n], 0, 0, 0); __builtin_amdgcn_s_setprio(0); } while (0)
#define PG8_WAIT_V(n) asm volatile("s_waitcnt vmcnt(" #n ")" ::: "memory")
#define PG8_WAIT_L(n) asm volatile("s_waitcnt lgkmcnt(" #n ")" ::: "memory")
#define PG8_BAR __builtin_amdgcn_s_barrier()
#define PG8_SCHED __builtin_amdgcn_sched_barrier(0)
    Unit cur, nxt; int ui = 0;
    if (!S.next(0, cur)) return;
    if (zero_init) {
#pragma unroll
    for (int a = 0; a < 2; ++a)
#pragma unroll
        for (int b = 0; b < 2; ++b)
#pragma unroll
            for (int m = 0; m < 4; ++m)
#pragma unroll
                for (int n = 0; n < 2; ++n) acc[a][b][m][n] = (f32x4){0.f, 0.f, 0.f, 0.f};
    }
    bf16x8 At[4][2], B0[2][2], B1[2][2];
    const char* cA = (const char*)g.A + (size_t)cur.pm * tstepA; const char* cB = (const char*)g.Bt + (size_t)cur.pn * tstepB;
    S.a_ready(cur);
    if constexpr (SP2) {
        PG8_STAGE(PG8_SB(0, 0), cB, voffB); PG8_STAGE(PG8_SB(0, 1), cB + hstepB, voffB); PG8_STAGE(PG8_SA(0, 0), cA, voffA); PG8_STAGE(PG8_SA(0, 1), cA + hstepA, voffA);
        if (wr == 1) PG8_BAR;
        PG8_WAIT_V(2); PG8_BAR;
        PG8_STAGE(PG8_SB(1, 0), cB + kstep, voffB); PG8_STAGE(PG8_SA(1, 0), cA + kstep, voffA); PG8_STAGE(PG8_SB(1, 1), cB + hstepB + kstep, voffB);
        PG8_WAIT_V(6); PG8_BAR;
    } else {
        PG8_STAGE(PG8_SB(0, 0), cB, voffB); PG8_STAGE(PG8_SA(0, 0), cA, voffA); PG8_STAGE(PG8_SB(0, 1), cB + hstepB, voffB); PG8_STAGE(PG8_SA(0, 1), cA + hstepA, voffA);
        if (wr == 1) PG8_BAR;
        PG8_WAIT_V(4); PG8_BAR;
        PG8_STAGE(PG8_SB(1, 0), cB + kstep, voffB); PG8_STAGE(PG8_SA(1, 0), cA + kstep, voffA); PG8_STAGE(PG8_SB(1, 1), cB + hstepB + kstep, voffB);
        PG8_WAIT_V(6); PG8_BAR;
    }
    for (;;) {
        const bool has_next = S.next(ui + 1, nxt);
        const char* nA = has_next ? (const char*)g.A + (size_t)nxt.pm * tstepA : cA; const char* nB = has_next ? (const char*)g.Bt + (size_t)nxt.pn * tstepB : cB;
#pragma unroll 1
        for (int t = 0; t < nt; t += 2) {
            if constexpr (Epi::CHAIN) { if (t == Epi::T1 || t == Epi::T2) E.mid(acc, cur, t, wr, wc, fr, fq); }
            const bool last = (t == nt - 2);
            const char* a1 = cA + (size_t)(t + 1) * kstep;
            const char* a2 = last ? nA : cA + (size_t)(t + 2) * kstep; const char* b2 = last ? nB : cB + (size_t)(t + 2) * kstep;
            const char* a3 = a2 + kstep; const char* b3 = b2 + kstep;
            if (last && has_next) S.a_ready(nxt);
            if constexpr (SP2) {
            PG8_LDB(B0, 0, 0); PG8_LDB(B1, 0, 1); PG8_SCHED; PG8_LDA(At, 0, 0); PG8_STAGE(PG8_SA(1, 1), a1 + hstepA, voffA);
            PG8_WAIT_V(8); PG8_WAIT_L(0); PG8_BAR; PG8_MMA(0, 0, At, B0); PG8_MMA(0, 1, At, B1); PG8_BAR; PG8_SCHED;
            PG8_LDA(At, 0, 1); PG8_STAGE(PG8_SB(0, 0), b2, voffB); PG8_STAGE(PG8_SB(0, 1), b2 + hstepB, voffB); PG8_STAGE(PG8_SA(0, 0), a2, voffA);
            PG8_WAIT_V(8); PG8_WAIT_L(0); PG8_BAR; PG8_MMA(1, 0, At, B0); PG8_MMA(1, 1, At, B1); PG8_BAR; PG8_SCHED;
            PG8_LDB(B0, 1, 0); PG8_LDB(B1, 1, 1); PG8_SCHED; PG8_LDA(At, 1, 0); PG8_STAGE(PG8_SA(0, 1), a2 + hstepA, voffA);
            PG8_WAIT_V(8); PG8_WAIT_L(0); PG8_BAR; PG8_MMA(0, 0, At, B0); PG8_MMA(0, 1, At, B1); PG8_BAR; PG8_SCHED;
            PG8_LDA(At, 1, 1); PG8_STAGE(PG8_SB(1, 0), b3, voffB); PG8_STAGE(PG8_SB(1, 1), b3 + hstepB, voffB); PG8_STAGE(PG8_SA(1, 0), a3, voffA);
            PG8_WAIT_V(8); PG8_WAIT_L(0); PG8_BAR; PG8_MMA(1, 0, At, B0); PG8_MMA(1, 1, At, B1); PG8_BAR; PG8_SCHED;
            } else {
            PG8_LDB(B0, 0, 0); PG8_SCHED; PG8_LDA(At, 0, 0); PG8_STAGE(PG8_SA(1, 1), a1 + hstepA, voffA);
            PG8_WAIT_L(8); PG8_BAR; PG8_WAIT_L(0); PG8_MMA(0, 0, At, B0); PG8_BAR; PG8_SCHED;
            PG8_LDB(B1, 0, 1); PG8_STAGE(PG8_SB(0, 0), b2, voffB);
            PG8_BAR; PG8_WAIT_L(0); PG8_MMA(0, 1, At, B1); PG8_BAR;
            PG8_LDA(At, 0, 1); PG8_STAGE(PG8_SA(0, 0), a2, voffA);
            PG8_BAR; PG8_WAIT_L(0); PG8_MMA(1, 0, At, B0); PG8_BAR; PG8_SCHED;
            PG8_STAGE(PG8_SB(0, 1), b2 + hstepB, voffB);
            PG8_WAIT_V(6); PG8_BAR; PG8_MMA(1, 1, At, B1); PG8_BAR;
            PG8_LDB(B0, 1, 0); PG8_SCHED; PG8_LDA(At, 1, 0); PG8_STAGE(PG8_SA(0, 1), a2 + hstepA, voffA);
            PG8_WAIT_L(8); PG8_BAR; PG8_WAIT_L(0); PG8_MMA(0, 0, At, B0); PG8_BAR; PG8_SCHED;
            PG8_LDB(B1, 1, 1); PG8_STAGE(PG8_SB(1, 0), b3, voffB);
            PG8_BAR; PG8_WAIT_L(0); PG8_MMA(0, 1, At, B1); PG8_BAR;
            PG8_LDA(At, 1, 1); PG8_STAGE(PG8_SA(1, 0), a3, voffA);
            PG8_BAR; PG8_WAIT_L(0); PG8_MMA(1, 0, At, B0); PG8_BAR; PG8_SCHED;
            PG8_STAGE(PG8_SB(1, 1), b3 + hstepB, voffB);
            PG8_WAIT_V(6); PG8_BAR; PG8_MMA(1, 1, At, B1); PG8_BAR;
            }
        }
        if constexpr (ALIGN_EPI) { if (wr == 0) PG8_BAR; }
        if constexpr (!Epi::AFTER_DRAIN) { E(acc, cur, wr, wc, fr, fq); S.done(cur); }
        if (!has_next) break;
#pragma unroll
        for (int a = 0; a < 2; ++a)
#pragma unroll
            for (int b = 0; b < 2; ++b)
#pragma unroll
                for (int m = 0; m < 4; ++m)
#pragma unroll
                    for (int n = 0; n < 2; ++n) acc[a][b][m][n] = (f32x4){0.f, 0.f, 0.f, 0.f};
        cur = nxt; cA = nA; cB = nB; ++ui;
        if constexpr (ALIGN_EPI) { if (wr == 1) PG8_BAR; }
    }
    PG8_WAIT_V(0);
    if constexpr (!ALIGN_EPI) { if (wr == 0) PG8_BAR; }
    PG8_BAR;
    if constexpr (Epi::AFTER_DRAIN) { E.fused(acc, cur, wr, wc, fr, fq, lds, wid, lane); S.done(cur); }
#undef PG8_SA
#undef PG8_SB
#undef PG8_STAGE
#undef PG8_LDA
#undef PG8_LDB
#undef PG8_MMA
#undef PG8_WAIT_V
#undef PG8_WAIT_L
#undef PG8_BAR
#undef PG8_SCHED
}
template <class Epi, class Sched, bool ALIGN_EPI = false, bool SP2 = false>
__device__ __forceinline__ void gemm_phase(PG8_LAS unsigned char* lds, const Gemm g, const Sched& S, const Epi& E) {
    f32x4 acc[2][2][4][2];
    gemm_body<Epi, Sched, ALIGN_EPI, SP2>(lds, g, S, E, acc, true);
}
struct OneUnit { Unit u;
    __device__ __forceinline__ bool next(int i, Unit& o) const { if (i) return false; o = u; return true; }
    __device__ __forceinline__ void a_ready(const Unit&) const {}
    __device__ __forceinline__ void done(const Unit&) const {} };
}

typedef unsigned short bf16_t;
using pg8::bf16x8; using pg8::f32x4; using pg8::u32x4;
typedef float f32x16 __attribute__((ext_vector_type(16)));
typedef unsigned u32x2 __attribute__((ext_vector_type(2)));
#define DI __device__ __forceinline__
#define MFMA32(a, b, c) __builtin_amdgcn_mfma_f32_32x32x16_bf16((a), (b), (c), 0, 0, 0)

constexpr int SEQ = 4096, BATCH = 8, DM = 1024, DEPTH = 2;
constexpr int NB = 4, TC = NB * SEQ, NCHUNK = BATCH / NB;
constexpr int INW = 11168, LDZ = 11168, NZP = 11264;
constexpr int C_LRUX = 0, C_LRUG = 1024, C_MLAG = 2048, C_DILG = 2560, C_DQ = 3072, C_DK = 4608, C_DV = 6144, C_MERGE = 7680, C_CQ = 10752, C_CKV = 11008, C_KR = 11136;
constexpr float EPS = 1e-6f, LOG2E = 1.4426950408889634f, LN2 = 0.6931471805599453f, LOG2_THETA = 13.287712379549449f;
constexpr int NUP = 1792, KUP = 384;

constexpr size_t W_IN_B = (size_t)NZP * DM * 2, W_UP_B = (size_t)NUP * KUP * 2, W_SQ_B = (size_t)DM * DM * 2, W_HF_B = (size_t)DM * 512 * 2, W_G_B = (size_t)8 * 128 * 128 * 2;
constexpr size_t WL_IN = 0, WL_UP = WL_IN + W_IN_B, WL_PCAT = WL_UP + W_UP_B  , WL_OUT = WL_PCAT + W_SQ_B + 2 * W_HF_B,
                 WL_GX = WL_OUT + W_SQ_B, WL_GA = WL_GX + W_G_B, WL_SIZE = WL_GA + W_G_B;
constexpr size_t WS_W = 0, WS_Z = WS_W + 2 * WL_SIZE, WS_S = WS_Z + (size_t)TC * LDZ * 2;
constexpr size_t S_XN = 0;
constexpr int LDQ = 1792;
constexpr size_t S_QF = 0, S_KF = S_QF + (size_t)TC * LDQ * 2, S_AGG = S_KF + (size_t)TC * 768 * 2,
                 S_LSE = S_AGG + (size_t)(TC / 64) * 1024 * 8, S_P23_END = S_LSE + (size_t)3 * TC * 8 * 4;
constexpr size_t S_MRG = 0, S_MB = S_MRG + (size_t)TC * DM * 4, S_END = S_MB + (size_t)TC * DM * 2;
static_assert(S_P23_END <= S_END, "scratch");
constexpr size_t WS_CTL = WS_S + S_END;
constexpr size_t WS_NEED = WS_CTL + 256 * 129;
static_assert(WS_NEED <= 536870912ull, "workspace");
static_assert(WS_Z % 256 == 0 && WS_S % 256 == 0 && WL_SIZE % 256 == 0, "align");
constexpr int LDS_BYTES = 139264;

DI float bflo(unsigned w) { return __uint_as_float(w << 16); }
DI float bfhi(unsigned w) { return __uint_as_float(w & 0xffff0000u); }
DI unsigned pk2(float lo, float hi) { typedef float f2_t __attribute__((ext_vector_type(2))); typedef __bf16 b2_t __attribute__((ext_vector_type(2)));
    f2_t v = {lo, hi}; b2_t b = __builtin_convertvector(v, b2_t); return __builtin_bit_cast(unsigned, b); }
DI float sigmoidf_(float x) { return __builtin_amdgcn_rcpf(1.f + __builtin_amdgcn_exp2f(-LOG2E * x)); }
DI float siluf_(float x) { return x * sigmoidf_(x); }
DI float fexp_(float x) { return __builtin_amdgcn_exp2f(LOG2E * x); }
DI float wave_sum(float v) {
#pragma unroll
    for (int m = 1; m < 64; m <<= 1) v += __shfl_xor(v, m);
    return v; }
DI void lds_barrier() { asm volatile("s_waitcnt lgkmcnt(0)\n\ts_barrier" ::: "memory"); }
DI int crow(int i, int h) { return (i & 3) + 8 * (i >> 2) + 4 * h; }
DI void sincos_rev(float ang, float& s, float& c) { float rev = ang * 0.15915494309189535f; rev = rev - floorf(rev); s = __builtin_amdgcn_sinf(rev); c = __builtin_amdgcn_cosf(rev); }

struct Args { const float* in[24]; float* out; unsigned char* ws; };
#ifndef PROBE_K
#define PROBE_K (-1)
#endif
#define PSTAMP(k) do { if (PROBE_K >= 0) { const unsigned long long now_ = __builtin_amdgcn_s_memrealtime(); if ((k) == PROBE_K) tacc += now_ - tprev; tprev = now_; } } while (0)

DI void wconv_job(float* tl, const float* __restrict__ src, int lds_, int n0s, int nrows, int ncols, bf16_t* dst, int ldd, int n0d, int k0d, const float* __restrict__ scale, int& base) {
    const int tid = otid(), ntn = (ncols + 127) / 128, ntk = nrows / 64, nt = ntn * ntk;
    f32x4 pv[4];
#define WC_LOAD(T) { const int tn_ = (T) % ntn, k0_ = ((T) / ntn) * 64, n4_ = tn_ * 128 + (tid & 31) * 4; _Pragma("unroll") for (int i = 0; i < 4; ++i) { const int kk = i * 16 + (tid >> 5); \
        f32x4 v = (f32x4){0.f, 0.f, 0.f, 0.f}; if (n4_ < ncols) v = *(const f32x4*)(src + (size_t)(k0_ + kk) * lds_ + n0s + n4_); if (scale) v *= scale[k0_ + kk]; pv[i] = v; } }
    const int G_ = gridDim.x; int t = (obid() + G_ - base % G_) % G_; base += nt;
    if (t < nt) WC_LOAD(t)
    for (; t < nt; t += gridDim.x) {
        const int tn = t % ntn, k0 = (t / ntn) * 64;
#pragma unroll
        for (int i = 0; i < 4; ++i) *(f32x4*)(tl + (i * 16 + (tid >> 5)) * 132 + (tid & 31) * 4) = pv[i];
        __syncthreads();
        if (t + (int)gridDim.x < nt) WC_LOAD(t + gridDim.x)
        { const int n = tid >> 2, kq = tid & 3; const float* tp = tl + (kq * 16) * 132 + n;
          if (tn * 128 + n < ncols) { u32x4 w0, w1;
            w0.x = pk2(tp[0 * 132], tp[1 * 132]); w0.y = pk2(tp[2 * 132], tp[3 * 132]); w0.z = pk2(tp[4 * 132], tp[5 * 132]); w0.w = pk2(tp[6 * 132], tp[7 * 132]);
            w1.x = pk2(tp[8 * 132], tp[9 * 132]); w1.y = pk2(tp[10 * 132], tp[11 * 132]); w1.z = pk2(tp[12 * 132], tp[13 * 132]); w1.w = pk2(tp[14 * 132], tp[15 * 132]);
            bf16_t* dp = dst + (size_t)(n0d + tn * 128 + n) * ldd + k0d + k0 + kq * 16; *(u32x4*)dp = w0; *(u32x4*)(dp + 8) = w1; } }
        lds_barrier();
    }
#undef WC_LOAD
}
DI void zero_rect(bf16_t* dst, int ldd, int n0, int nn, int k0, int nk) {
    const int per = nk / 8, tot = nn * per;
    for (int i = obid() * 512 + otid(); i < tot; i += gridDim.x * 512) { const int n = i / per, c = i % per;
        *(u32x4*)(dst + (size_t)(n0 + n) * ldd + k0 + c * 8) = (u32x4){0u, 0u, 0u, 0u}; }
}
DI void prologue_weights(const Args& a, unsigned char* lds) {
    float* tl = (float*)lds; int base = 0;
    for (int l = 0; l < DEPTH; ++l) {
        unsigned char* wl = a.ws + WS_W + (size_t)l * WL_SIZE;
        bf16_t* win = (bf16_t*)(wl + WL_IN); const float* w_in = a.in[3] + (size_t)l * DM * INW;
        wconv_job(tl, w_in, INW, 0,    1024, 2048, win, DM, C_LRUX, 0, nullptr, base);
        wconv_job(tl, w_in, INW, 2464, 1024, 512,  win, DM, C_MLAG, 0, nullptr, base);
        wconv_job(tl, w_in, INW, 7584, 1024, 512,  win, DM, C_DILG, 0, nullptr, base);
        wconv_job(tl, w_in, INW, 2976, 1024, 4608, win, DM, C_DQ, 0, nullptr, base);
        wconv_job(tl, w_in, INW, 8096, 1024, 3072, win, DM, C_MERGE, 0, nullptr, base);
        wconv_job(tl, w_in, INW, 2048, 1024, 416,  win, DM, C_CQ, 0, nullptr, base);
        zero_rect(win, DM, INW, NZP - INW, 0, DM);
        bf16_t* wup = (bf16_t*)(wl + WL_UP);
        wconv_job(tl, a.in[14] + (size_t)l * 256 * 768, 768, 0, 256, 768, wup, KUP, 0, 0, a.in[12] + l * 256, base);
        wconv_job(tl, a.in[15] + (size_t)l * 128 * 1024, 1024, 0, 128, 1024, wup, KUP, 768, 256, a.in[13] + l * 128, base);
        zero_rect(wup, KUP, 0, 768, 256, 128); zero_rect(wup, KUP, 768, 1024, 0, 256);
        wconv_job(tl, a.in[11] + (size_t)l * DM * DM, DM, 0, 1024, 1024, (bf16_t*)(wl + WL_PCAT), 2048, 0, 0, nullptr, base);
        wconv_job(tl, a.in[18] + (size_t)l * 512 * DM, DM, 0, 512, 1024, (bf16_t*)(wl + WL_PCAT), 2048, 0, 1024, nullptr, base);
        wconv_job(tl, a.in[21] + (size_t)l * 512 * DM, DM, 0, 512, 1024, (bf16_t*)(wl + WL_PCAT), 2048, 0, 1536, nullptr, base);
        wconv_job(tl, a.in[23] + (size_t)l * DM * DM, DM, 0, 1024, 1024, (bf16_t*)(wl + WL_OUT), 1024, 0, 0, nullptr, base);
        for (int nb = 0; nb < 8; ++nb) {
            wconv_job(tl, a.in[6] + ((size_t)l * 8 + nb) * 128 * 128, 128, 0, 128, 128, (bf16_t*)(wl + WL_GX) + nb * 128 * 128, 128, 0, 0, nullptr, base);
            wconv_job(tl, a.in[8] + ((size_t)l * 8 + nb) * 128 * 128, 128, 0, 128, 128, (bf16_t*)(wl + WL_GA) + nb * 128 * 128, 128, 0, 0, nullptr, base);
        }
    }
}

DI void p0_rmsnorm(const float* __restrict__ x, const float* __restrict__ g, bf16_t* xn) {
    const int tid = otid(), lane = tid & 63, gw = obid() * 8 + (tid >> 6), nw = gridDim.x * 8;
    f32x4 gv[4];
#pragma unroll
    for (int i = 0; i < 4; ++i) gv[i] = *(const f32x4*)(g + i * 256 + lane * 4);
    for (int row = gw; row < TC; row += nw) {
        const float* xr = x + (size_t)row * DM; f32x4 v[4]; float ss = 0.f;
#pragma unroll
        for (int i = 0; i < 4; ++i) { v[i] = *(const f32x4*)(xr + i * 256 + lane * 4); ss += v[i][0] * v[i][0] + v[i][1] * v[i][1] + v[i][2] * v[i][2] + v[i][3] * v[i][3]; }
        ss = wave_sum(ss); const float rs = rsqrtf(ss * (1.f / DM) + EPS);
#pragma unroll
        for (int i = 0; i < 4; ++i) { u32x2 w; w.x = pk2(v[i][0] * rs * gv[i][0], v[i][1] * rs * gv[i][1]); w.y = pk2(v[i][2] * rs * gv[i][2], v[i][3] * rs * gv[i][3]);
            *(u32x2*)(xn + (size_t)row * DM + i * 256 + lane * 4) = w; }
    }
}

struct EpiZ {
    static constexpr bool PERM = true, AFTER_DRAIN = false, CHAIN = false;
    bf16_t* O; int ldc; int ncols;
    DI void operator()(const f32x4 (&acc)[2][2][4][2], const pg8::Unit& u, int wr, int wc, int fr, int fq) const {
        const int row0 = u.pm * 256 + wr * 64 + fr, col0 = u.pn * 256 + wc * 32 + 8 * fq;
#pragma unroll
        for (int ai = 0; ai < 2; ++ai)
#pragma unroll
            for (int m = 0; m < 4; ++m) { bf16_t* rowp = O + (size_t)(row0 + ai * 128 + m * 16) * ldc;
#pragma unroll
                for (int bj = 0; bj < 2; ++bj) { const int c = col0 + bj * 128; if (c < ncols) { const f32x4 v0 = acc[ai][bj][m][0], v1 = acc[ai][bj][m][1];
                    u32x4 w; w.x = pk2(v0[0], v0[1]); w.y = pk2(v0[2], v0[3]); w.z = pk2(v1[0], v1[1]); w.w = pk2(v1[2], v1[3]); *(u32x4*)(rowp + c) = w; } } }
    }
};
struct EpiChain {
    static constexpr bool PERM = true, AFTER_DRAIN = false, CHAIN = true; static constexpr int T1 = 16, T2 = 24;
    const bf16_t* Z; const float* bm; bf16_t* MB;
    template <bool FIN> DI void run(f32x4 (&acc)[2][2][4][2], const pg8::Unit& u, int br, int wr, int wc, int fr_, int fq_) const {
        int fr = fr_, fq = fq_; asm volatile("" : "+v"(fr), "+v"(fq));
        const int row0 = u.pm * 256 + wr * 64 + fr, col0 = u.pn * 256 + wc * 32 + 8 * fq;
        const float* bmb = bm + br * 1024; const bf16_t* zb = Z + C_MERGE + br * 1024;
#pragma unroll
        for (int bj = 0; bj < 2; ++bj)
#pragma unroll
            for (int n = 0; n < 2; ++n) { const int c = col0 + bj * 128 + 4 * n;
                f32x4 b = *(const f32x4*)(bmb + c) * (-LOG2E), d = b; if (!FIN) d = *(const f32x4*)(bmb + 1024 + c) * (-LOG2E);
                u32x2 gz[8], hz[8];
#pragma unroll
                for (int q = 0; q < 8; ++q) { const bf16_t* zp = zb + (size_t)(row0 + (q >> 2) * 128 + (q & 3) * 16) * LDZ + c; gz[q] = *(const u32x2*)zp; if (!FIN) hz[q] = *(const u32x2*)(zp + 1024); }
#pragma unroll
                for (int q = 0; q < 8; ++q) { const int ai = q >> 2, m = q & 3; const size_t row = (size_t)(row0 + ai * 128 + m * 16);
                    f32x4 sc;
                    sc[0] = __builtin_amdgcn_rcpf(1.f + __builtin_amdgcn_exp2f(bflo(gz[q].x) * (-LOG2E) + b[0])); sc[1] = __builtin_amdgcn_rcpf(1.f + __builtin_amdgcn_exp2f(bfhi(gz[q].x) * (-LOG2E) + b[1]));
                    sc[2] = __builtin_amdgcn_rcpf(1.f + __builtin_amdgcn_exp2f(bflo(gz[q].y) * (-LOG2E) + b[2])); sc[3] = __builtin_amdgcn_rcpf(1.f + __builtin_amdgcn_exp2f(bfhi(gz[q].y) * (-LOG2E) + b[3]));
                    if (!FIN) {
                        sc[0] *= 1.f + __builtin_amdgcn_exp2f(bflo(hz[q].x) * (-LOG2E) + d[0]); sc[1] *= 1.f + __builtin_amdgcn_exp2f(bfhi(hz[q].x) * (-LOG2E) + d[1]);
                        sc[2] *= 1.f + __builtin_amdgcn_exp2f(bflo(hz[q].y) * (-LOG2E) + d[2]); sc[3] *= 1.f + __builtin_amdgcn_exp2f(bfhi(hz[q].y) * (-LOG2E) + d[3]);
                        acc[ai][bj][m][n] *= sc; asm volatile("" : "+v"(acc[ai][bj][m][n]));
                    } else {
                        const f32x4 v = acc[ai][bj][m][n] * sc; u32x2 w; w.x = pk2(v[0], v[1]); w.y = pk2(v[2], v[3]); *(u32x2*)(MB + row * DM + c) = w; } }
                asm volatile("" ::: "memory"); }
    }
    DI void mid(f32x4 (&acc)[2][2][4][2], const pg8::Unit& u, int t, int wr, int wc, int fr, int fq) const { run<false>(acc, u, t == T1 ? 0 : 1, wr, wc, fr, fq); }
    DI void operator()(f32x4 (&acc)[2][2][4][2], const pg8::Unit& u, int wr, int wc, int fr, int fq) const { run<true>(acc, u, 2, wr, wc, fr, fq); }
};
struct EpiOut {
    static constexpr bool PERM = false, AFTER_DRAIN = false, CHAIN = false;
    const float* X; float* O;
    DI void operator()(const f32x4 (&acc)[2][2][4][2], const pg8::Unit& u, int wr, int wc, int fr, int fq) const {
        const int row0 = u.pm * 256 + wr * 64 + fr, col0 = u.pn * 256 + wc * 32 + 4 * fq;
#pragma unroll
        for (int ai = 0; ai < 2; ++ai)
#pragma unroll
            for (int mp = 0; mp < 2; ++mp) {
                f32x4 xv[2][2][2];
#pragma unroll
                for (int mm = 0; mm < 2; ++mm) { const size_t ro = (size_t)(row0 + ai * 128 + (mp * 2 + mm) * 16) * DM + col0;
#pragma unroll
                    for (int bj = 0; bj < 2; ++bj)
#pragma unroll
                        for (int n = 0; n < 2; ++n) xv[mm][bj][n] = *(const f32x4*)(X + ro + bj * 128 + n * 16); }
#pragma unroll
                for (int mm = 0; mm < 2; ++mm) { const size_t ro = (size_t)(row0 + ai * 128 + (mp * 2 + mm) * 16) * DM + col0;
#pragma unroll
                    for (int bj = 0; bj < 2; ++bj)
#pragma unroll
                        for (int n = 0; n < 2; ++n) *(f32x4*)(O + ro + bj * 128 + n * 16) = xv[mm][bj][n] + acc[ai][bj][mp * 2 + mm][n]; }
                asm volatile("" ::: "memory"); }
    }
};

#define UNPK8(W_, d, o, sc_) { const u32x4 w_ = (W_); d[o + 0] = bflo(w_.x) * (sc_); d[o + 1] = bfhi(w_.x) * (sc_); d[o + 2] = bflo(w_.y) * (sc_); d[o + 3] = bfhi(w_.y) * (sc_); d[o + 4] = bflo(w_.z) * (sc_); d[o + 5] = bfhi(w_.z) * (sc_); d[o + 6] = bflo(w_.w) * (sc_); d[o + 7] = bfhi(w_.w) * (sc_); }
DI void dil_prep(bf16_t* z, const int* __restrict__ pos, const float* __restrict__ gq, const float* __restrict__ gk) {
    const int tid = otid(), lane = tid & 63, gw = obid() * 8 + (tid >> 6), nw = gridDim.x * 8, j = lane & 7, hsub = lane >> 3;
    float inv[8], gqo[8], gqp[8], gko[8], gkp[8];
#pragma unroll
    for (int e = 0; e < 8; ++e) { inv[e] = __builtin_amdgcn_exp2f(-(float)(8 * (j & 3) + e) * (LOG2_THETA / 32.f));
        gqo[e] = gq[j * 8 + e]; gqp[e] = gq[(j ^ 4) * 8 + e]; gko[e] = gk[j * 8 + e]; gkp[e] = gk[(j ^ 4) * 8 + e]; }
    const float sgn = (j < 4) ? -1.f : 1.f;
    for (int wi0 = gw; wi0 < TC * 6; wi0 += 8 * nw) {
        u32x4 wv[8];
#pragma unroll
        for (int b = 0; b < 8; ++b) { const int wi = wi0 + b * nw; wv[b] = (u32x4){0u, 0u, 0u, 0u};
            if (wi < TC * 6) { const int tok = wi / 6, grp = wi - tok * 6; wv[b] = *(const u32x4*)(z + (size_t)tok * LDZ + (grp < 3 ? C_DQ + grp * 512 : C_DK + (grp - 3) * 512) + hsub * 64 + j * 8); } }
#pragma unroll
        for (int b = 0; b < 8; ++b) { const int wi = wi0 + b * nw; if (wi < TC * 6) {
            const int tok = wi / 6, grp = wi - tok * 6; const bool isq = grp < 3;
            bf16_t* p = z + (size_t)tok * LDZ + (isq ? C_DQ + grp * 512 : C_DK + (grp - 3) * 512) + hsub * 64 + j * 8;
            const u32x4 w = wv[b]; u32x4 q;
            q.x = __shfl_xor(w.x, 4); q.y = __shfl_xor(w.y, 4); q.z = __shfl_xor(w.z, 4); q.w = __shfl_xor(w.w, 4);
            float v[8], u[8]; UNPK8(w, v, 0, 1.f) UNPK8(q, u, 0, 1.f)
            float ss = 0.f;
#pragma unroll
            for (int e = 0; e < 8; ++e) ss += v[e] * v[e];
            ss += __shfl_xor(ss, 1); ss += __shfl_xor(ss, 2); ss += __shfl_xor(ss, 4);
            const float rs = rsqrtf(ss * (1.f / 64.f) + EPS) * (isq ? 0.125f * LOG2E : 1.f);
            const float fp = (float)pos[tok];
            float o[8];
#pragma unroll
            for (int e = 0; e < 8; ++e) { float sn, cs; sincos_rev(fp * inv[e], sn, cs);
                const float a = v[e] * rs * (isq ? gqo[e] : gko[e]), bb = u[e] * rs * (isq ? gqp[e] : gkp[e]); o[e] = a * cs + sgn * bb * sn; }
            u32x4 r; r.x = pk2(o[0], o[1]); r.y = pk2(o[2], o[3]); r.z = pk2(o[4], o[5]); r.w = pk2(o[6], o[7]);
            *(u32x4*)p = r; } }
    }
}

DI float ssq8(u32x4 w) { return bflo(w.x) * bflo(w.x) + bfhi(w.x) * bfhi(w.x) + bflo(w.y) * bflo(w.y) + bfhi(w.y) * bfhi(w.y) + bflo(w.z) * bflo(w.z) + bfhi(w.z) * bfhi(w.z) + bflo(w.w) * bflo(w.w) + bfhi(w.w) * bfhi(w.w); }
DI u32x4 scale8(u32x4 w, float s, const float* __restrict__ g) { u32x4 o; o.x = pk2(bflo(w.x) * s * g[0], bfhi(w.x) * s * g[1]); o.y = pk2(bflo(w.y) * s * g[2], bfhi(w.y) * s * g[3]);
    o.z = pk2(bflo(w.z) * s * g[4], bfhi(w.z) * s * g[5]); o.w = pk2(bflo(w.w) * s * g[6], bfhi(w.w) * s * g[7]); return o; }
DI void rope16(float (&v)[32], const float* __restrict__ g, float fp) {
#pragma unroll
    for (int i = 0; i < 16; ++i) { const float inv = exp2f(-(float)i * (LOG2_THETA / 16.f)); float sn, cs; sincos_rev(fp * inv, sn, cs);
        const float x1 = v[i] * g[i], x2 = v[16 + i] * g[16 + i]; v[i] = x1 * cs - x2 * sn; v[16 + i] = x2 * cs + x1 * sn; }
}
DI void mla_finalize(unsigned char* lds, const bf16_t* z, bf16_t* qf, bf16_t* kvr, bf16_t* kf, const int* __restrict__ pos, const float* __restrict__ gqn_g, const float* __restrict__ gkn_g) {
    float* rst = (float*)lds;
    float* gl = rst + 128; const float* gqn = gl; const float* gkn = gl + 96;
    for (int grp = obid(); grp < TC / 64; grp += gridDim.x) {
        const int tid = otid(), lane = tid & 63, wid = tid >> 6;
        const int t0 = grp * 64;
        const int tl_ = tid >> 3, hd = tid & 7, tok = t0 + tl_;
        bf16_t* pq = qf + (size_t)tok * LDQ + hd * 96; bf16_t* pkv = kvr + (size_t)tok * LDQ + hd * 128; const bf16_t* pkr = z + (size_t)tok * LDZ + C_KR; bf16_t* pk = kf + (size_t)tok * 768 + hd * 96;
        u32x4 rq[12];
#pragma unroll
        for (int c = 0; c < 12; ++c) rq[c] = *(const u32x4*)(pq + c * 8);
        const float fp = (float)pos[tok];
        if (tid < 192) gl[tid] = (tid < 96) ? gqn_g[tid] : gkn_g[tid - 96];
        u32x2 la[8]; unsigned lb[8];
#pragma unroll
        for (int i = 0; i < 8; ++i) { const bf16_t* zr = z + (size_t)(t0 + wid * 8 + i) * LDZ; la[i] = *(const u32x2*)(zr + C_CQ + lane * 4); lb[i] = *(const unsigned*)(zr + C_CKV + lane * 2); }
        __syncthreads();
#pragma unroll
        for (int i = 0; i < 8; ++i) {
            float s1 = bflo(la[i].x) * bflo(la[i].x) + bfhi(la[i].x) * bfhi(la[i].x) + bflo(la[i].y) * bflo(la[i].y) + bfhi(la[i].y) * bfhi(la[i].y), s2 = bflo(lb[i]) * bflo(lb[i]) + bfhi(lb[i]) * bfhi(lb[i]);
            s1 = wave_sum(s1); s2 = wave_sum(s2);
            if (lane == 0) { rst[(wid * 8 + i) * 2] = rsqrtf(s1 * (1.f / 256.f) + EPS); rst[(wid * 8 + i) * 2 + 1] = rsqrtf(s2 * (1.f / 128.f) + EPS); } }
        __syncthreads();
        const float rcq = rst[tl_ * 2], rckv = rst[tl_ * 2 + 1];
        {
            float ss = 0.f;
#pragma unroll
            for (int c = 0; c < 12; ++c) ss += ssq8(rq[c]);
            ss *= rcq * rcq;
            const float rs = rsqrtf(ss * (1.f / 96.f) + EPS) * rcq * (0.10206207261596575f * LOG2E);
#pragma unroll
            for (int c = 0; c < 8; ++c) *(u32x4*)(pq + c * 8) = scale8(rq[c], rs, gqn + c * 8);
            float v[32];
#pragma unroll
            for (int c = 0; c < 4; ++c) { UNPK8(rq[8 + c], v, c * 8, rs) }
            rope16(v, gqn + 64, fp);
#pragma unroll
            for (int c = 0; c < 4; ++c) { u32x4 w; w.x = pk2(v[c * 8 + 0], v[c * 8 + 1]); w.y = pk2(v[c * 8 + 2], v[c * 8 + 3]); w.z = pk2(v[c * 8 + 4], v[c * 8 + 5]); w.w = pk2(v[c * 8 + 6], v[c * 8 + 7]);
                *(u32x4*)(pq + 64 + c * 8) = w; }
        }
        asm volatile("" ::: "memory");
        {
            u32x4 rk[8], rv[8], rr[4];
#pragma unroll
            for (int c = 0; c < 8; ++c) { rk[c] = *(const u32x4*)(pkv + c * 8); rv[c] = *(const u32x4*)(pkv + 64 + c * 8); }
#pragma unroll
            for (int c = 0; c < 4; ++c) rr[c] = *(const u32x4*)(pkr + c * 8);
            float ss = 0.f, sr = 0.f;
#pragma unroll
            for (int c = 0; c < 8; ++c) ss += ssq8(rk[c]);
#pragma unroll
            for (int c = 0; c < 4; ++c) sr += ssq8(rr[c]);
            ss = ss * rckv * rckv + sr;
            const float rs = rsqrtf(ss * (1.f / 96.f) + EPS);
#pragma unroll
            for (int c = 0; c < 8; ++c) *(u32x4*)(pk + c * 8) = scale8(rk[c], rs * rckv, gkn + c * 8);
            float v[32];
#pragma unroll
            for (int c = 0; c < 4; ++c) { UNPK8(rr[c], v, c * 8, rs) }
            rope16(v, gkn + 64, fp);
#pragma unroll
            for (int c = 0; c < 4; ++c) { u32x4 w; w.x = pk2(v[c * 8 + 0], v[c * 8 + 1]); w.y = pk2(v[c * 8 + 2], v[c * 8 + 3]); w.z = pk2(v[c * 8 + 4], v[c * 8 + 5]); w.w = pk2(v[c * 8 + 6], v[c * 8 + 7]);
                *(u32x4*)(pk + 64 + c * 8) = w; }
#pragma unroll
            for (int c = 0; c < 8; ++c) { u32x4 w = rv[c];
                w.x = pk2(bflo(w.x) * rckv, bfhi(w.x) * rckv); w.y = pk2(bflo(w.y) * rckv, bfhi(w.y) * rckv); w.z = pk2(bflo(w.z) * rckv, bfhi(w.z) * rckv); w.w = pk2(bflo(w.w) * rckv, bfhi(w.w) * rckv);
                *(u32x4*)(pkv + 64 + c * 8) = w; }
        }
    }
}

DI void dil_combine(bf16_t* z, const float* __restrict__ lse) {
    const int tot = TC * 64, stride = gridDim.x * 512;
    for (int it0 = obid() * 512 + otid(); it0 < tot; it0 += 2 * stride) {
        u32x4 A[2], B[2], C[2], Gt[2]; float L0[2], L1[2], L2[2];
#pragma unroll
        for (int b = 0; b < 2; ++b) { const int it = it0 + b * stride; if (it < tot) { const int tok = it >> 6, hd = (it >> 3) & 7, dc = it & 7; const bf16_t* zr = z + (size_t)tok * LDZ;
            L0[b] = lse[(size_t)tok * 8 + hd]; L1[b] = lse[(size_t)TC * 8 + (size_t)tok * 8 + hd]; L2[b] = lse[(size_t)2 * TC * 8 + (size_t)tok * 8 + hd];
            A[b] = *(const u32x4*)(zr + C_DQ + (0 * 8 + hd) * 64 + dc * 8); B[b] = *(const u32x4*)(zr + C_DQ + (1 * 8 + hd) * 64 + dc * 8); C[b] = *(const u32x4*)(zr + C_DQ + (2 * 8 + hd) * 64 + dc * 8);
            Gt[b] = *(const u32x4*)(zr + C_DILG + hd * 64 + dc * 8); } }
#pragma unroll
        for (int b = 0; b < 2; ++b) { const int it = it0 + b * stride; if (it < tot) { const int tok = it >> 6, hd = (it >> 3) & 7, dc = it & 7;
            const float l0 = L0[b], l1 = L1[b], l2 = L2[b];
            const float mx = fmaxf(l0, fmaxf(l1, l2)); float w0 = fexp_(l0 - mx), w1 = fexp_(l1 - mx), w2 = fexp_(l2 - mx); const float iw = __builtin_amdgcn_rcpf(w0 + w1 + w2); w0 *= iw; w1 *= iw; w2 *= iw;
            const u32x4 a = A[b], bq = B[b], c = C[b], g = Gt[b]; u32x4 o;
#define CMB(F) { const float e0 = (w0 * bflo(a.F) + w1 * bflo(bq.F) + w2 * bflo(c.F)) * siluf_(bflo(g.F)), e1 = (w0 * bfhi(a.F) + w1 * bfhi(bq.F) + w2 * bfhi(c.F)) * siluf_(bfhi(g.F)); o.F = pk2(e0, e1); }
            CMB(x) CMB(y) CMB(z) CMB(w)
#undef CMB
            *(u32x4*)(z + (size_t)tok * LDZ + C_DILG + hd * 64 + dc * 8) = o; } }
    }
}

struct LruP { const float* conv_w; const float* conv_b; const float* b_gx; const float* b_ga; const float* lam; const bf16_t* wgx; const bf16_t* wga; };
constexpr int L_XS = 0, L_XCB = 18432, L_XC = L_XCB + 17408, L_HB = L_XC + 32768, L_CW = L_HB + 32768, L_EX = L_CW + 5 * 128 * 4, L_END = L_EX + 2 * 128 * 8;
static_assert(L_END <= LDS_BYTES, "lru lds");
template <bool FINAL> DI void lru_unit(unsigned char* lds, bf16_t* z, float* agg, const LruP& P, int bl, int n, int grp) {
    const int tid0 = otid();
    bf16_t* xs = (bf16_t*)(lds + L_XS); bf16_t* xcb = (bf16_t*)(lds + L_XCB); float* xc = (float*)(lds + L_XC); float* hb = (float*)(lds + L_HB);
    float* cw = (float*)(lds + L_CW); float2* ex = (float2*)(lds + L_EX);
    __syncthreads();
    const int tid = tid0, lane = tid & 63, wid = tid >> 6, r = lane & 31, h = lane >> 5, ct = wid & 3, rt = wid >> 2;
    for (int i = tid; i < 640; i += 512) cw[i] = (i < 512) ? P.conv_w[(i >> 7) * 1024 + n * 128 + (i & 127)] : P.conv_b[n * 128 + (i & 127)];
    bf16x8 bx[8], ba[8];
    { const bf16_t* wx = P.wgx + (size_t)n * 16384 + (size_t)(ct * 32 + r) * 128 + 8 * h; const bf16_t* wa = P.wga + (size_t)n * 16384 + (size_t)(ct * 32 + r) * 128 + 8 * h;
#pragma unroll
      for (int s = 0; s < 8; ++s) { bx[s] = *(const bf16x8*)(wx + 16 * s); ba[s] = *(const bf16x8*)(wa + 16 * s); } }
    const int ch = ct * 32 + r, chg = n * 128 + ch; const float bgx = P.b_gx[chg], bga = P.b_ga[chg]; const float sp = __logf(1.f + __expf(-P.lam[chg]));
    float hrun = 0.f, Arun = 1.f;
    if (FINAL) {
#pragma unroll
        for (int g2 = 0; g2 < 7; ++g2) if (g2 < grp) { const float2 ab = *(const float2*)(agg + ((size_t)(bl * 8 + g2) * 1024 + chg) * 2); hrun = ab.x * hrun + ab.y; } }
    const size_t rowb = (size_t)bl * SEQ;
    u32x4 xr[3], gr[2];
#define LRU_XLOAD(J) { _Pragma("unroll") for (int q = 0; q < 3; ++q) { const int c = tid + q * 512; const int i = c >> 4, cc = c & 15; const int p = (J) * 64 - 3 + i; \
        xr[q] = (u32x4){0u, 0u, 0u, 0u}; if (c < 67 * 16 && p >= 0) xr[q] = *(const u32x4*)(z + (rowb + p) * LDZ + C_LRUX + n * 128 + cc * 8); } }
#pragma unroll
    for (int s = 0; s < 8; ++s) asm volatile("" :: "v"(bx[s]), "v"(ba[s]));
    asm volatile("" :: "v"(bgx), "v"(bga), "v"(sp), "v"(hrun));
    LRU_XLOAD(grp * 8)
    __syncthreads();
#pragma unroll 1
    for (int jt = 0; jt < 8; ++jt) {
        int tq = tid0; asm volatile("" : "+v"(tq));
        const int tid = tq, lane = tid & 63, wid = tid >> 6, r = lane & 31, h = lane >> 5, ct = wid & 3, rt = wid >> 2, ch = ct * 32 + r;
        const int j = grp * 8 + jt; const size_t row0 = rowb + (size_t)j * 64;
#pragma unroll
        for (int q = 0; q < 3; ++q) { const int c = tid + q * 512; if (c < 67 * 16) *(u32x4*)(xs + (c >> 4) * 136 + (c & 15) * 8) = xr[q]; }
        lds_barrier();
        if (jt + 1 < 8) LRU_XLOAD(j + 1)
        if (FINAL) {
#pragma unroll
            for (int q = 0; q < 2; ++q) { const int c = tid + q * 512; gr[q] = *(const u32x4*)(z + (row0 + (c >> 4)) * LDZ + C_LRUG + n * 128 + (c & 15) * 8); } }
        {
            const int i = tid >> 3, c0 = (tid & 7) * 16; float acc[16];
#pragma unroll
            for (int q = 0; q < 4; ++q) { const f32x4 b = *(const f32x4*)(cw + 512 + c0 + q * 4); acc[q * 4] = b[0]; acc[q * 4 + 1] = b[1]; acc[q * 4 + 2] = b[2]; acc[q * 4 + 3] = b[3]; }
#pragma unroll
            for (int k = 0; k < 4; ++k) {
                const u32x4 xa = *(const u32x4*)(xs + (i + k) * 136 + c0), xb = *(const u32x4*)(xs + (i + k) * 136 + c0 + 8);
                const float xv[16] = {bflo(xa.x), bfhi(xa.x), bflo(xa.y), bfhi(xa.y), bflo(xa.z), bfhi(xa.z), bflo(xa.w), bfhi(xa.w), bflo(xb.x), bfhi(xb.x), bflo(xb.y), bfhi(xb.y), bflo(xb.z), bfhi(xb.z), bflo(xb.w), bfhi(xb.w)};
#pragma unroll
                for (int q = 0; q < 4; ++q) { const f32x4 w = *(const f32x4*)(cw + k * 128 + c0 + q * 4);
                    acc[q * 4] += w[0] * xv[q * 4]; acc[q * 4 + 1] += w[1] * xv[q * 4 + 1]; acc[q * 4 + 2] += w[2] * xv[q * 4 + 2]; acc[q * 4 + 3] += w[3] * xv[q * 4 + 3]; } }
#pragma unroll
            for (int q = 0; q < 4; ++q) *(f32x4*)(xc + i * 128 + c0 + q * 4) = (f32x4){acc[q * 4], acc[q * 4 + 1], acc[q * 4 + 2], acc[q * 4 + 3]};
            u32x4 w0, w1; w0.x = pk2(acc[0], acc[1]); w0.y = pk2(acc[2], acc[3]); w0.z = pk2(acc[4], acc[5]); w0.w = pk2(acc[6], acc[7]);
            w1.x = pk2(acc[8], acc[9]); w1.y = pk2(acc[10], acc[11]); w1.z = pk2(acc[12], acc[13]); w1.w = pk2(acc[14], acc[15]);
            *(u32x4*)(xcb + i * 136 + c0) = w0; *(u32x4*)(xcb + i * 136 + c0 + 8) = w1;
        }
        lds_barrier();
        float av[16], bv[16], Ao[4], Ho[4], Ap[4], Hp[4];
        {
            f32x16 gx, ga;
#pragma unroll
            for (int i = 0; i < 16; ++i) { gx[i] = 0.f; ga[i] = 0.f; }
#pragma unroll
            for (int s = 0; s < 8; ++s) { const bf16x8 a = *(const bf16x8*)(xcb + (rt * 32 + r) * 136 + 16 * s + 8 * h); gx = MFMA32(a, bx[s], gx); ga = MFMA32(a, ba[s], ga); }
#pragma unroll
            for (int i = 0; i < 16; ++i) { const int tk = rt * 32 + crow(i, h);
                const float vgx = sigmoidf_(gx[i] + bgx), vga = sigmoidf_(ga[i] + bga); const float la = -8.f * vga * sp; av[i] = fexp_(la);
                const float mult = __builtin_amdgcn_sqrtf(fmaxf(1.f - av[i] * av[i], 0.f));
                bv[i] = mult * vgx * xc[tk * 128 + ch]; }
        }
#pragma unroll
        for (int g = 0; g < 4; ++g) { float H = 0.f, A = 1.f;
#pragma unroll
            for (int k = 0; k < 4; ++k) { H = av[4 * g + k] * H + bv[4 * g + k]; A *= av[4 * g + k]; }
            Ao[g] = A; Ho[g] = H; Ap[g] = __shfl_xor(A, 32); Hp[g] = __shfl_xor(H, 32); }
        {   float c = 0.f, At = 1.f;
#pragma unroll
            for (int g = 0; g < 4; ++g) { const float A1 = h ? Ap[g] : Ao[g], H1 = h ? Hp[g] : Ho[g], A2 = h ? Ao[g] : Ap[g], H2 = h ? Ho[g] : Hp[g]; c = A1 * c + H1; c = A2 * c + H2; At *= A1 * A2; }
            if (h == 0) ex[rt * 128 + ch] = make_float2(At, c); }
        lds_barrier();
        {   const float2 e0 = ex[ch], e1 = ex[128 + ch]; const float hmid = e0.x * hrun + e0.y;
            float c = rt ? hmid : hrun;
            hrun = e1.x * hmid + e1.y; Arun *= e0.x * e1.x;
            if (FINAL) {
#pragma unroll
                for (int g = 0; g < 4; ++g) { const float A1 = h ? Ap[g] : Ao[g], H1 = h ? Hp[g] : Ho[g], A2 = h ? Ao[g] : Ap[g], H2 = h ? Ho[g] : Hp[g];
                    const float c1 = A1 * c + H1; float hh = h ? c1 : c; c = A2 * c1 + H2;
#pragma unroll
                    for (int k = 0; k < 4; ++k) { hh = av[4 * g + k] * hh + bv[4 * g + k]; hb[(rt * 32 + 8 * g + 4 * h + k) * 128 + ch] = hh; } } } }
        if (FINAL) {
            lds_barrier();
#pragma unroll
            for (int q = 0; q < 2; ++q) { const int c = tid + q * 512; const int i = c >> 4, cc = c & 15; bf16_t* gp = z + (row0 + i) * LDZ + C_LRUG + n * 128 + cc * 8; const u32x4 g = gr[q];
                const f32x4 h0 = *(const f32x4*)(hb + i * 128 + cc * 8), h1 = *(const f32x4*)(hb + i * 128 + cc * 8 + 4); u32x4 o;
                o.x = pk2(h0[0] * siluf_(bflo(g.x)), h0[1] * siluf_(bfhi(g.x))); o.y = pk2(h0[2] * siluf_(bflo(g.y)), h0[3] * siluf_(bfhi(g.y)));
                o.z = pk2(h1[0] * siluf_(bflo(g.z)), h1[1] * siluf_(bfhi(g.z))); o.w = pk2(h1[2] * siluf_(bflo(g.w)), h1[3] * siluf_(bfhi(g.w))); *(u32x4*)gp = o; }
        }
    }
#undef LRU_XLOAD
    if (!FINAL && h == 0 && rt == 0) *(float2*)(agg + ((size_t)(bl * 8 + grp) * 1024 + chg) * 2) = make_float2(Arun, hrun);
}

typedef short s16x4 __attribute__((ext_vector_type(4)));
DI s16x4 vtr(const bf16_t* p) { return __builtin_amdgcn_ds_read_tr16_b64_v4i16((__attribute__((address_space(3))) s16x4*)p); }
template <int DK, bool WIN, bool MLA>
DI void attn_unit(unsigned char* lds, const bf16_t* Qb, size_t qs, const bf16_t* Kb, size_t ks, const bf16_t* Vb, size_t vs, int q0, bf16_t* Ob, size_t os, float* lsep, size_t lses, const float CS) {
    constexpr int KLD = DK + 8, VLD = 96, KC = DK / 8, NKR = (128 * KC) / 512, KBYTES = 128 * KLD * 2, BUFB = KBYTES + 128 * VLD * 2;
    static_assert((128 * KC) % 512 == 0 && 2 * BUFB <= LDS_BYTES, "attention staging");
    const int tid = otid(), lane = tid & 63, wid = tid >> 6, r = lane & 31, h = lane >> 5;
    const int qw = q0 + 32 * wid;
    bf16x8 qf[DK / 16];
    { const bf16_t* qrow = Qb + (size_t)(qw + r) * qs + 8 * h;
#pragma unroll
      for (int s = 0; s < DK / 16; ++s) qf[s] = *(const bf16x8*)(qrow + 16 * s); }
    f32x16 o[2];
#pragma unroll
    for (int i = 0; i < 16; ++i) { o[0][i] = 0.f; o[1][i] = 0.f; }
    float lrow = 0.f;
    const int kt_lo = WIN ? (q0 >= 128 ? (q0 - 128) / 128 : 0) : 0, kt_hi = (q0 + 255) / 128, ntile = kt_hi - kt_lo + 1;
    const int kfrag = r * KLD + 8 * h, vfrag = (4 * h + ((lane & 15) >> 2)) * VLD + 16 * ((lane >> 4) & 1) + 4 * (lane & 3);
    u32x4 kreg[NKR], vreg[2];
#define ATT_GLOAD(KT) { const size_t kb = (size_t)(KT) * 128; \
        _Pragma("unroll") for (int q_ = 0; q_ < NKR; ++q_) { const int c_ = tid + q_ * 512; kreg[q_] = *(const u32x4*)(Kb + (kb + c_ / KC) * ks + (c_ % KC) * 8); } \
        _Pragma("unroll") for (int q_ = 0; q_ < 2; ++q_) { const int c_ = tid + q_ * 512; vreg[q_] = *(const u32x4*)(Vb + (kb + (c_ >> 3)) * vs + (c_ & 7) * 8); } }
#define ATT_LWRITE(SLOT) { bf16_t* kp_ = (bf16_t*)(lds + (SLOT) * BUFB); bf16_t* vp_ = (bf16_t*)(lds + (SLOT) * BUFB + KBYTES); \
        _Pragma("unroll") for (int q_ = 0; q_ < NKR; ++q_) { const int c_ = tid + q_ * 512; *(u32x4*)(kp_ + (c_ / KC) * KLD + (c_ % KC) * 8) = kreg[q_]; } \
        _Pragma("unroll") for (int q_ = 0; q_ < 2; ++q_) { const int c_ = tid + q_ * 512; *(u32x4*)(vp_ + (c_ >> 3) * VLD + (c_ & 7) * 8) = vreg[q_]; } }
    ATT_GLOAD(kt_lo)
#pragma unroll
    for (int s = 0; s < DK / 16; ++s) asm volatile("" :: "v"(qf[s]));
    __syncthreads();
    ATT_LWRITE(0)
    if (ntile > 1) ATT_GLOAD(kt_lo + 1)
#pragma unroll 1
    for (int it = 0; it < ntile; ++it) {
        const int kbase = (kt_lo + it) * 128;
        lds_barrier();
        if (it + 1 < ntile) { ATT_LWRITE((it + 1) & 1) if (it + 2 < ntile) ATT_GLOAD(kt_lo + it + 2) }
        const bf16_t* Ks = (const bf16_t*)(lds + (it & 1) * BUFB) + kfrag; const bf16_t* Vs = (const bf16_t*)(lds + (it & 1) * BUFB + KBYTES) + vfrag;
        const int qi = qw + r;
#pragma unroll
        for (int hp = 0; hp < 2; ++hp) {
            const int kb = kbase + 64 * hp;
            const bool active = (kb <= qw + 31) && (!WIN || kb + 63 >= qw - 128);
            if (active) {
                f32x16 x[2];
#pragma unroll
                for (int i = 0; i < 16; ++i) { x[0][i] = -CS; x[1][i] = -CS; }
#pragma unroll
                for (int s = 0; s < DK / 16; ++s) { const bf16x8 a0 = *(const bf16x8*)(Ks + (hp * 64) * KLD + 16 * s), a1 = *(const bf16x8*)(Ks + (hp * 64 + 32) * KLD + 16 * s);
                    x[0] = MFMA32(a0, qf[s], x[0]); x[1] = MFMA32(a1, qf[s], x[1]); }
                const bool need_mask = (kb + 63 > qw) || (WIN && kb < qw + 31 - 128);
                if (need_mask) {
#pragma unroll
                    for (int kt2 = 0; kt2 < 2; ++kt2)
#pragma unroll
                        for (int i = 0; i < 16; ++i) { const int key = kb + kt2 * 32 + crow(i, h); const bool ok = (key <= qi) && (!WIN || key >= qi - 128); x[kt2][i] = ok ? x[kt2][i] : -INFINITY; } }
#pragma unroll
                for (int kt2 = 0; kt2 < 2; ++kt2)
#pragma unroll
                    for (int i = 0; i < 16; ++i) { const float p = __builtin_amdgcn_exp2f(x[kt2][i]); x[kt2][i] = p; lrow += p; }
#pragma unroll
                for (int kt2 = 0; kt2 < 2; ++kt2)
#pragma unroll
                    for (int s = 0; s < 2; ++s) {
                        u32x4 pw; pw.x = pk2(x[kt2][8 * s + 0], x[kt2][8 * s + 1]); pw.y = pk2(x[kt2][8 * s + 2], x[kt2][8 * s + 3]); pw.z = pk2(x[kt2][8 * s + 4], x[kt2][8 * s + 5]); pw.w = pk2(x[kt2][8 * s + 6], x[kt2][8 * s + 7]);
                        const bf16x8 pb = __builtin_bit_cast(bf16x8, pw);
#pragma unroll
                        for (int n = 0; n < 2; ++n) { const bf16_t* vp = Vs + (hp * 64 + kt2 * 32 + 16 * s) * VLD + 32 * n;
                            const s16x4 lo = vtr(vp), hi = vtr(vp + 8 * VLD);
                            const bf16x8 av = __builtin_shufflevector(lo, hi, 0, 1, 2, 3, 4, 5, 6, 7);
                            o[n] = MFMA32(av, pb, o[n]); } }
            }
        }
    }
#undef ATT_GLOAD
#undef ATT_LWRITE
    lrow += __shfl_xor(lrow, 32);
    const float inv = __builtin_amdgcn_rcpf(lrow); const size_t orow = (size_t)(qw + r) * os;
    u32x2 gv[2][4];
    if (MLA) {
#pragma unroll
        for (int n = 0; n < 2; ++n)
#pragma unroll
            for (int g4 = 0; g4 < 4; ++g4) gv[n][g4] = *(const u32x2*)(Ob + orow + n * 32 + g4 * 8 + 4 * h); }
#pragma unroll
    for (int n = 0; n < 2; ++n)
#pragma unroll
        for (int g4 = 0; g4 < 4; ++g4) { const int dv = n * 32 + g4 * 8 + 4 * h; bf16_t* op = Ob + orow + dv;
            float e0 = o[n][g4 * 4] * inv, e1 = o[n][g4 * 4 + 1] * inv, e2 = o[n][g4 * 4 + 2] * inv, e3 = o[n][g4 * 4 + 3] * inv;
            if (MLA) { const u32x2 g = gv[n][g4]; e0 *= siluf_(bflo(g.x)); e1 *= siluf_(bfhi(g.x)); e2 *= siluf_(bflo(g.y)); e3 *= siluf_(bfhi(g.y)); }
            u32x2 w; w.x = pk2(e0, e1); w.y = pk2(e2, e3); *(u32x2*)op = w; }
    if (!MLA) { if (h == 0) lsep[(size_t)(qw + r) * lses] = (CS + __log2f(lrow)) * LN2; }
}

DI void gsync(unsigned* ctr, unsigned& target) {
    asm volatile("s_waitcnt vmcnt(0)" ::: "memory");
    __syncthreads();
    target += gridDim.x;
    if (threadIdx.x == 0) {
        __builtin_amdgcn_fence(__ATOMIC_RELEASE, "agent");
        asm volatile("s_waitcnt vmcnt(0)" ::: "memory");
        (void)__hip_atomic_fetch_add(ctr, 1u, __ATOMIC_RELAXED, __HIP_MEMORY_SCOPE_AGENT);
        while (__hip_atomic_load(ctr, __ATOMIC_RELAXED, __HIP_MEMORY_SCOPE_AGENT) < target) __builtin_amdgcn_s_sleep(16);
        __builtin_amdgcn_fence(__ATOMIC_ACQUIRE, "agent");
        asm volatile("s_waitcnt vmcnt(0)" ::: "memory");
    }
    __syncthreads();
}

DI void panel_signal(unsigned* cnt) {
    if (threadIdx.x == 0) { __builtin_amdgcn_fence(__ATOMIC_RELEASE, "agent"); asm volatile("s_waitcnt vmcnt(0)" ::: "memory");
        (void)__hip_atomic_fetch_add(cnt, 1u, __ATOMIC_RELAXED, __HIP_MEMORY_SCOPE_AGENT); }
}
DI void panel_wait(unsigned* cnt, unsigned target) {
    if (threadIdx.x == 0) { while (__hip_atomic_load(cnt, __ATOMIC_RELAXED, __HIP_MEMORY_SCOPE_AGENT) < target) __builtin_amdgcn_s_sleep(8);
        __builtin_amdgcn_fence(__ATOMIC_ACQUIRE, "agent"); asm volatile("s_waitcnt vmcnt(0)" ::: "memory"); }
    __syncthreads();
}

__global__ void __launch_bounds__(512, 2) hybrid_fwd(Args a) {
    extern __shared__ __attribute__((aligned(16))) unsigned char lds_raw[];
    cg::grid_group grid = cg::this_grid();
    unsigned char* lds = lds_raw; PG8_LAS unsigned char* ldsl = (PG8_LAS unsigned char*)lds_raw;
    const int G = gridDim.x;
#define bx obid()
    unsigned char* ws = a.ws;
    bf16_t* z = (bf16_t*)(ws + WS_Z); unsigned char* sc = ws + WS_S;
    bf16_t* xn = (bf16_t*)(sc + S_XN); bf16_t* qf = (bf16_t*)(sc + S_QF); bf16_t* kvr = qf + 768; bf16_t* kf = (bf16_t*)(sc + S_KF);
    float* agg = (float*)(sc + S_AGG); float* lse = (float*)(sc + S_LSE); float* mrg = (float*)(sc + S_MRG); bf16_t* mb = (bf16_t*)(sc + S_MB);
    const int* positions = (const int*)a.in[1];

    unsigned* gctr = (unsigned*)(ws + WS_CTL); unsigned gtarget = 0;
    if (blockIdx.x == 0 && threadIdx.x < 129) __hip_atomic_store(gctr + 64 * threadIdx.x, 0u, __ATOMIC_RELAXED, __HIP_MEMORY_SCOPE_AGENT);
    unsigned* cntA = gctr + 64; unsigned* cntB = gctr + 64 * 65; const bool fullgrid = (G == 256);
    unsigned long long tacc = 0, tprev = 0; if (PROBE_K >= 0) tprev = __builtin_amdgcn_s_memrealtime();
    prologue_weights(a, lds);
    if (PROBE_K == 0) { grid.sync(); PSTAMP(0); }
#pragma unroll 1
    for (int l = 0; l < DEPTH; ++l) {
#pragma unroll 1
        for (int c = 0; c < NCHUNK; ++c) {
            int lo = l; asm volatile("" : "+s"(lo));
            const unsigned char* wl = ws + WS_W + (size_t)lo * WL_SIZE;
            const size_t roff = (size_t)c * TC;
            const float* xin = (l == 0 ? a.in[0] : a.out) + roff * DM; float* xout = a.out + roff * DM; const int* pos = positions + roff;
            p0_rmsnorm(xin, a.in[2] + lo * DM, xn);
            if (l == 0 && c == 0) grid.sync(); else gsync(gctr, gtarget);
            PSTAMP(1);
            { pg8::Gemm g; g.A = xn; g.Bt = (const bf16_t*)(wl + WL_IN); g.M = TC; g.N = NZP; g.K = DM; g.lda = DM;
              pg8::StaticOrder S; S.init(TC, NZP, G, bx); EpiZ E; E.O = z; E.ldc = LDZ; E.ncols = INW;
              pg8::gemm_phase<EpiZ, pg8::StaticOrder, true, true>(ldsl, g, S, E); }
            gsync(gctr, gtarget); PSTAMP(2);
            { pg8::Gemm g; g.A = z + C_CQ; g.Bt = (const bf16_t*)(wl + WL_UP); g.M = TC; g.N = NUP; g.K = KUP; g.lda = LDZ;
              pg8::StaticOrder S; S.init(TC, NUP, G, bx); EpiZ E; E.O = qf; E.ldc = LDQ; E.ncols = NUP;
              pg8::gemm_phase<EpiZ, pg8::StaticOrder, true, true>(ldsl, g, S, E);
              if (fullgrid) { pg8::Unit uu; for (int i = 0; S.next(i, uu); ++i) if (uu.pn >= 0) panel_signal(cntB + 64 * uu.pm); } }
            __syncthreads();
            const bool lru_first = (bx & 1) != 0;
            if (!lru_first) dil_prep(z, pos, a.in[19] + lo * 64, a.in[20] + lo * 64);
            LruP lp; lp.conv_w = a.in[4] + (size_t)lo * 4 * 1024; lp.conv_b = a.in[5] + lo * 1024; lp.b_gx = a.in[7] + lo * 1024; lp.b_ga = a.in[9] + lo * 1024; lp.lam = a.in[10] + lo * 1024;
            lp.wgx = (const bf16_t*)(wl + WL_GX); lp.wga = (const bf16_t*)(wl + WL_GA);
            for (int u = bx; u < NB * 64; u += G) lru_unit<false>(lds, z, agg, lp, u >> 6, (u >> 3) & 7, u & 7);
            if (lru_first) { __syncthreads(); dil_prep(z, pos, a.in[19] + lo * 64, a.in[20] + lo * 64); }
            if (fullgrid) panel_wait(cntB + 64 * (bx >> 2), 7u * (unsigned)(l * NCHUNK + c + 1)); else gsync(gctr, gtarget);
            PSTAMP(3);
            mla_finalize(lds, z, qf, kvr, kf, pos, a.in[16] + lo * 96, a.in[17] + lo * 96);
            gsync(gctr, gtarget); PSTAMP(4);
            float cs_mla, cs_dil;
            { float mq = 0.f, mk = 0.f, dq_ = 0.f, dk_ = 0.f; const float* g1 = a.in[16] + lo * 96; const float* g2 = a.in[17] + lo * 96; const float* g3 = a.in[19] + lo * 64; const float* g4 = a.in[20] + lo * 64;
              for (int i = 0; i < 96; ++i) { mq = fmaxf(mq, fabsf(g1[i])); mk = fmaxf(mk, fabsf(g2[i])); }
              for (int i = 0; i < 64; ++i) { dq_ = fmaxf(dq_, fabsf(g3[i])); dk_ = fmaxf(dk_, fabsf(g4[i])); }
              cs_mla = 96.f * 0.10206207261596575f * LOG2E * mq * mk; cs_dil = 64.f * 0.125f * LOG2E * dq_ * dk_; }
            for (int u = bx; u < 512 + NB * 384; u += G) {
                if (u < 512) {
                    int qb, bh; if (u < 256) { qb = 15 - (u >> 5); bh = u & 31; } else { qb = (u - 256) >> 5; bh = (u - 256) & 31; }
                    const int bl = bh >> 3, hd = bh & 7; const size_t t0 = (size_t)bl * SEQ;
                    attn_unit<96, false, true>(lds, qf + t0 * LDQ + hd * 96, LDQ, kf + t0 * 768 + hd * 96, 768, kvr + t0 * LDQ + hd * 128 + 64, LDQ, qb * 256,
                                               z + t0 * LDZ + C_MLAG + hd * 64, LDZ, nullptr, 0, cs_mla);
                } else {
                    const int v = u - 512, bl = v / 384, w = v % 384, gi = w >> 7, w2 = w & 127, hd = w2 >> 4, rem = w2 & 15;
                    const int d = 1 << (2 * gi), npairs = 16 >> (2 * gi), r = rem / npairs, pair = rem % npairs, head = gi * 8 + hd;
                    const size_t brow = (size_t)bl * SEQ + r; bf16_t* zb = z + brow * LDZ + head * 64; const size_t st = (size_t)d * LDZ;
                    attn_unit<64, true, false>(lds, zb + C_DQ, st, zb + C_DK, st, zb + C_DV, st, pair * 256, zb + C_DQ, st, lse + (size_t)gi * TC * 8 + brow * 8 + hd, (size_t)d * 8, cs_dil);
                }
            }
            gsync(gctr, gtarget); PSTAMP(5);
            dil_combine(z, lse);
            for (int u = bx; u < NB * 64; u += G) lru_unit<true>(lds, z, agg, lp, u >> 6, (u >> 3) & 7, u & 7);
            gsync(gctr, gtarget); PSTAMP(6);
            { pg8::Gemm g; g.A = z + C_LRUG; g.Bt = (const bf16_t*)(wl + WL_PCAT); g.M = TC; g.N = DM; g.K = 2048; g.lda = LDZ;
              pg8::StaticOrder S; S.init(TC, DM, G, bx); EpiChain E; E.Z = z; E.bm = a.in[22] + (size_t)lo * 3072; E.MB = mb;
              pg8::gemm_phase<EpiChain, pg8::StaticOrder, true, true>(ldsl, g, S, E);
              if (fullgrid) { pg8::Unit uu; S.next(0, uu); panel_signal(cntA + 64 * uu.pm); panel_wait(cntA + 64 * uu.pm, 4u * (unsigned)(l * NCHUNK + c + 1)); } }
            if (!fullgrid) gsync(gctr, gtarget);
            PSTAMP(7);
            { pg8::Gemm g; g.A = mb; g.Bt = (const bf16_t*)(wl + WL_OUT); g.M = TC; g.N = DM; g.K = DM; g.lda = DM;
              pg8::StaticOrder S; S.init(TC, DM, G, bx); EpiOut E; E.X = xin; E.O = xout;
              pg8::gemm_phase<EpiOut, pg8::StaticOrder, true, true>(ldsl, g, S, E); }
            __syncthreads();
            if (PROBE_K == 8) { grid.sync(); PSTAMP(8); }
        }
    }
    if (PROBE_K >= 0 && blockIdx.x == 0 && threadIdx.x == 0) { const unsigned long long t0 = __builtin_amdgcn_s_memrealtime(); while (__builtin_amdgcn_s_memrealtime() - t0 < tacc) __builtin_amdgcn_s_sleep(8); }
}

extern "C" void kernel_launch(void* const* d_in, const int* in_sizes, int n_in, void* d_out, int out_size, void* d_ws, size_t ws_size, hipStream_t stream) {
    static int grid_blocks = 0;
    if (!grid_blocks) {
        int dev = 0, cus = 0, per_cu = 0;
        (void)hipGetDevice(&dev);
        (void)hipDeviceGetAttribute(&cus, hipDeviceAttributeMultiprocessorCount, dev);
        if (hipFuncSetAttribute((const void*)hybrid_fwd, hipFuncAttributeMaxDynamicSharedMemorySize, LDS_BYTES) != hipSuccess) fprintf(stderr, "hipFuncSetAttribute failed\n");
        if (hipOccupancyMaxActiveBlocksPerMultiprocessor(&per_cu, (const void*)hybrid_fwd, 512, LDS_BYTES) != hipSuccess || per_cu < 1) per_cu = 1;
        grid_blocks = cus * 1;
        if (ws_size < WS_NEED) fprintf(stderr, "workspace too small: %zu < %zu\n", ws_size, (size_t)WS_NEED);
    }
    if (ws_size < WS_NEED || n_in < 24) return;
    Args a{};
    for (int i = 0; i < 24; ++i) a.in[i] = (const float*)d_in[i];
    a.out = (float*)d_out; a.ws = (unsigned char*)d_ws;
    void* args[] = {&a};
    hipError_t e = hipLaunchCooperativeKernel((const void*)hybrid_fwd, dim3(grid_blocks), dim3(512), args, LDS_BYTES, stream);
    if (e != hipSuccess) fprintf(stderr, "cooperative launch failed: %s (grid %d)\n", hipGetErrorString(e), grid_blocks);
}
```

```cpp
#include <hip/hip_runtime.h>
#include <hip/hip_cooperative_groups.h>
#include <cstdio>
#include <cstdint>
namespace cg = cooperative_groups;
__device__ __forceinline__ int otid() { int t = threadIdx.x; asm volatile("" : "+v"(t)); return t; }
__device__ __forceinline__ int obid() { int b = blockIdx.x; asm volatile("" : "+s"(b)); return b; }
namespace pg8 {
#define PG8_LAS __attribute__((address_space(3)))
typedef unsigned short bf16_t;
typedef short bf16x8 __attribute__((ext_vector_type(8)));
typedef float f32x4 __attribute__((ext_vector_type(4)));
typedef unsigned u32x4 __attribute__((ext_vector_type(4)));
constexpr int BM = 256, BK = 64, HALF = 128, HTB = HALF * BK * 2  , STAGE_BYTES = 8 * HTB, NXCD = 8, WGM = 8;

__host__ __device__ __forceinline__ int lds_byte(int r, int c) { const int st = (r >> 4) * 2 + (c >> 5), rr = r & 15, cc = c & 31, ob = rr * 64 + cc * 2; return st * 1024 + (ob ^ (((ob >> 9) & 1) << 5)); }
__host__ __device__ __forceinline__ void stage_rc(int b, int& R, int& C) { const int st = b / 1024, sb = b % 1024, swz = sb ^ (((sb >> 9) & 1) << 5); R = (st >> 1) * 16 + swz / 64; C = (st & 1) * 32 + (swz % 64) / 2; }
__host__ __device__ __forceinline__ int perm32(int rho) { const int n = rho >> 4, i = rho & 15; return 8 * (i >> 2) + 4 * n + (i & 3); }

struct Unit { int pm, pn; };
struct Gemm { const bf16_t* A; const bf16_t* Bt; int M, N, K, lda; };

struct StaticOrder {
    int nM, nN, nwg, G, c;
    __host__ __device__ void init(int M, int N, int G_, int c_) { nM = M / BM; nN = N / BM; nwg = nM * nN; G = G_; c = c_; }
    __host__ __device__ bool next(int i, Unit& u) const {
        const long L = (long)i * G + c; if (L >= nwg) return false;
        int wgid = (int)L; { const int q = nwg / NXCD, r = nwg % NXCD, xcd = wgid % NXCD, off = wgid / NXCD; wgid = (xcd < r ? xcd * (q + 1) : r * (q + 1) + (xcd - r) * q) + off; }
        const int nig = WGM * nN, gid = wgid / nig, fm = gid * WGM, gsz = (nM - fm) < WGM ? (nM - fm) : WGM;
        u.pm = fm + ((wgid % nig) % gsz); u.pn = (wgid % nig) / gsz; return true;
    }
    __device__ __forceinline__ void a_ready(const Unit&) const {}
    __device__ __forceinline__ void done(const Unit&) const {}
};
__device__ __forceinline__ unsigned cvt_pk_bf16(float lo, float hi) { unsigned r; asm volatile("v_cvt_pk_bf16_f32 %0, %1, %2" : "=v"(r) : "v"(lo), "v"(hi)); return r; }
template <class Epi, class Sched, bool ALIGN_EPI = false, bool SP2 = false>
__device__ __forceinline__ void gemm_body(PG8_LAS unsigned char* lds, const Gemm g, const Sched& S, const Epi& E, f32x4 (&acc)[2][2][4][2], const bool zero_init) {
    const int tid = otid(), wid = __builtin_amdgcn_readfirstlane(tid >> 6), lane = tid & 63, wr = wid >> 2, wc = wid & 3, fr = lane & 15, fq = lane >> 4;
    const int K = g.K, nt = K / BK;
    unsigned voffA[2], voffB[2];
#pragma unroll
    for (int i = 0; i < 2; ++i) { int R, C; stage_rc(tid * 16 + i * 8192, R, C); const int Rb = Epi::PERM ? ((R & ~31) + perm32(R & 31)) : R;
        voffA[i] = (unsigned)(R * g.lda + C) * 2u; voffB[i] = (unsigned)(Rb * K + C) * 2u; }
    const size_t kstep = (size_t)(BK * 2);
    const size_t hstepA = (size_t)HALF * g.lda * 2, hstepB = (size_t)HALF * K * 2;
    const size_t tstepA = 2 * hstepA, tstepB = 2 * hstepB;
    const unsigned ldsw = (unsigned)wid * 1024u;
    const int aoff = lds_byte(wr * 64 + fr, fq * 8), boff = lds_byte(wc * 32 + fr, fq * 8);
#define PG8_SA(b, h) (((b) * 2 + (h)) * HTB)
#define PG8_SB(b, h) ((4 + (b) * 2 + (h)) * HTB)
#define PG8_STAGE(bufoff, gbase, voff) do { _Pragma("unroll") for (int _i = 0; _i < 2; ++_i) \
        __builtin_amdgcn_global_load_lds((const unsigned*)((const char*)(gbase) + (voff)[_i]), (PG8_LAS unsigned*)(lds + (bufoff) + ldsw + _i * 8192), 16, 0, 0); } while (0)
#define PG8_LDA(dst, b, h) do { _Pragma("unroll") for (int m = 0; m < 4; ++m) _Pragma("unroll") for (int k = 0; k < 2; ++k) dst[m][k] = *(const PG8_LAS bf16x8*)(lds + PG8_SA(b, h) + aoff + m * 2048 + k * 1024); } while (0)
#define PG8_LDB(dst, b, h) do { _Pragma("unroll") for (int n = 0; n < 2; ++n) _Pragma("unroll") for (int k = 0; k < 2; ++k) dst[n][k] = *(const PG8_LAS bf16x8*)(lds + PG8_SB(b, h) + boff + n * 2048 + k * 1024); } while (0)
#define PG8_MMA(ai, bj, At, Bt) do { __builtin_amdgcn_s_setprio(1); _Pragma("unroll") for (int m = 0; m < 4; ++m) _Pragma("unroll") for (int n = 0; n < 2; ++n) _Pragma("unroll") for (int k = 0; k < 2; ++k) \
        acc[ai][bj][m][n] = __builtin_amdgcn_mfma_f32_16x16x32_bf16(Bt[n][k], At[m][k], acc[ai][bj][m][n], 0, 0, 0); __builtin_amdgcn_s_setprio(0); } while (0)
#define PG8_WAIT_V(n) asm volatile("s_waitcnt vmcnt(" #n ")" ::: "memory")
#define PG8_WAIT_L(n) asm volatile("s_waitcnt lgkmcnt(" #n ")" ::: "memory")
#define PG8_BAR __builtin_amdgcn_s_barrier()
#define PG8_SCHED __builtin_amdgcn_sched_barrier(0)
    Unit cur, nxt; int ui = 0;
    if (!S.next(0, cur)) return;
    if (zero_init) {
#pragma unroll
    for (int a = 0; a < 2; ++a)
#pragma unroll
        for (int b = 0; b < 2; ++b)
#pragma unroll
            for (int m = 0; m < 4; ++m)
#pragma unroll
                for (int n = 0; n < 2; ++n) acc[a][b][m][n] = (f32x4){0.f, 0.f, 0.f, 0.f};
    }
    bf16x8 At[4][2], B0[2][2], B1[2][2];
    const char* cA = (const char*)g.A + (size_t)cur.pm * tstepA; const char* cB = (const char*)g.Bt + (size_t)cur.pn * tstepB;
    S.a_ready(cur);
    if constexpr (SP2) {
        PG8_STAGE(PG8_SB(0, 0), cB, voffB); PG8_STAGE(PG8_SB(0, 1), cB + hstepB, voffB); PG8_STAGE(PG8_SA(0, 0), cA, voffA); PG8_STAGE(PG8_SA(0, 1), cA + hstepA, voffA);
        if (wr == 1) PG8_BAR;
        PG8_WAIT_V(2); PG8_BAR;
        PG8_STAGE(PG8_SB(1, 0), cB + kstep, voffB); PG8_STAGE(PG8_SA(1, 0), cA + kstep, voffA); PG8_STAGE(PG8_SB(1, 1), cB + hstepB + kstep, voffB);
        PG8_WAIT_V(6); PG8_BAR;
    } else {
        PG8_STAGE(PG8_SB(0, 0), cB, voffB); PG8_STAGE(PG8_SA(0, 0), cA, voffA); PG8_STAGE(PG8_SB(0, 1), cB + hstepB, voffB); PG8_STAGE(PG8_SA(0, 1), cA + hstepA, voffA);
        if (wr == 1) PG8_BAR;
        PG8_WAIT_V(4); PG8_BAR;
        PG8_STAGE(PG8_SB(1, 0), cB + kstep, voffB); PG8_STAGE(PG8_SA(1, 0), cA + kstep, voffA); PG8_STAGE(PG8_SB(1, 1), cB + hstepB + kstep, voffB);
        PG8_WAIT_V(6); PG8_BAR;
    }
    for (;;) {
        const bool has_next = S.next(ui + 1, nxt);
        const char* nA = has_next ? (const char*)g.A + (size_t)nxt.pm * tstepA : cA; const char* nB = has_next ? (const char*)g.Bt + (size_t)nxt.pn * tstepB : cB;
#pragma unroll 1
        for (int t = 0; t < nt; t += 2) {
            if constexpr (Epi::CHAIN) { if (t == Epi::T1 || t == Epi::T2) E.mid(acc, cur, t, wr, wc, fr, fq); }
            const bool last = (t == nt - 2);
            const char* a1 = cA + (size_t)(t + 1) * kstep;
            const char* a2 = last ? nA : cA + (size_t)(t + 2) * kstep; const char* b2 = last ? nB : cB + (size_t)(t + 2) * kstep;
            const char* a3 = a2 + kstep; const char* b3 = b2 + kstep;
            if (last && has_next) S.a_ready(nxt);
            if constexpr (SP2) {
            PG8_LDB(B0, 0, 0); PG8_LDB(B1, 0, 1); PG8_SCHED; PG8_LDA(At, 0, 0); PG8_STAGE(PG8_SA(1, 1), a1 + hstepA, voffA);
            PG8_WAIT_V(8); PG8_WAIT_L(0); PG8_BAR; PG8_MMA(0, 0, At, B0); PG8_MMA(0, 1, At, B1); PG8_BAR; PG8_SCHED;
            PG8_LDA(At, 0, 1); PG8_STAGE(PG8_SB(0, 0), b2, voffB); PG8_STAGE(PG8_SB(0, 1), b2 + hstepB, voffB); PG8_STAGE(PG8_SA(0, 0), a2, voffA);
            PG8_WAIT_V(8); PG8_WAIT_L(0); PG8_BAR; PG8_MMA(1, 0, At, B0); PG8_MMA(1, 1, At, B1); PG8_BAR; PG8_SCHED;
            PG8_LDB(B0, 1, 0); PG8_LDB(B1, 1, 1); PG8_SCHED; PG8_LDA(At, 1, 0); PG8_STAGE(PG8_SA(0, 1), a2 + hstepA, voffA);
            PG8_WAIT_V(8); PG8_WAIT_L(0); PG8_BAR; PG8_MMA(0, 0, At, B0); PG8_MMA(0, 1, At, B1); PG8_BAR; PG8_SCHED;
            PG8_LDA(At, 1, 1); PG8_STAGE(PG8_SB(1, 0), b3, voffB); PG8_STAGE(PG8_SB(1, 1), b3 + hstepB, voffB); PG8_STAGE(PG8_SA(1, 0), a3, voffA);
            PG8_WAIT_V(8); PG8_WAIT_L(0); PG8_BAR; PG8_MMA(1, 0, At, B0); PG8_MMA(1, 1, At, B1); PG8_BAR; PG8_SCHED;
            } else {
            PG8_LDB(B0, 0, 0); PG8_SCHED; PG8_LDA(At, 0, 0); PG8_STAGE(PG8_SA(1, 1), a1 + hstepA, voffA);
            PG8_WAIT_L(8); PG8_BAR; PG8_WAIT_L(0); PG8_MMA(0, 0, At, B0); PG8_BAR; PG8_SCHED;
            PG8_LDB(B1, 0, 1); PG8_STAGE(PG8_SB(0, 0), b2, voffB);
            PG8_BAR; PG8_WAIT_L(0); PG8_MMA(0, 1, At, B1); PG8_BAR;
            PG8_LDA(At, 0, 1); PG8_STAGE(PG8_SA(0, 0), a2, voffA);
            PG8_BAR; PG8_WAIT_L(0); PG8_MMA(1, 0, At, B0); PG8_BAR; PG8_SCHED;
            PG8_STAGE(PG8_SB(0, 1), b2 + hstepB, voffB);
            PG8_WAIT_V(6); PG8_BAR; PG8_MMA(1, 1, At, B1); PG8_BAR;
            PG8_LDB(B0, 1, 0); PG8_SCHED; PG8_LDA(At, 1, 0); PG8_STAGE(PG8_SA(0, 1), a2 + hstepA, voffA);
            PG8_WAIT_L(8); PG8_BAR; PG8_WAIT_L(0); PG8_MMA(0, 0, At, B0); PG8_BAR; PG8_SCHED;
            PG8_LDB(B1, 1, 1); PG8_STAGE(PG8_SB(1, 0), b3, voffB);
            PG8_BAR; PG8_WAIT_L(0); PG8_MMA(0, 1, At, B1); PG8_BAR;
            PG8_LDA(At, 1, 1); PG8_STAGE(PG8_SA(1, 0), a3, voffA);
            PG8_BAR; PG8_WAIT_L(0); PG8_MMA(1, 0, At, B0); PG8_BAR; PG8_SCHED;
            PG8_STAGE(PG8_SB(1, 1), b3 + hstepB, voffB);
            PG8_WAIT_V(6); PG8_BAR; PG8_MMA(1, 1, At, B1); PG8_BAR;
            }
        }
        if constexpr (ALIGN_EPI) { if (wr == 0) PG8_BAR; }
        if constexpr (!Epi::AFTER_DRAIN) { E(acc, cur, wr, wc, fr, fq); S.done(cur); }
        if (!has_next) break;
#pragma unroll
        for (int a = 0; a < 2; ++a)
#pragma unroll
            for (int b = 0; b < 2; ++b)
#pragma unroll
                for (int m = 0; m < 4; ++m)
#pragma unroll
                    for (int n = 0; n < 2; ++n) acc[a][b][m][n] = (f32x4){0.f, 0.f, 0.f, 0.f};
        cur = nxt; cA = nA; cB = nB; ++ui;
        if constexpr (ALIGN_EPI) { if (wr == 1) PG8_BAR; }
    }
    PG8_WAIT_V(0);
    if constexpr (!ALIGN_EPI) { if (wr == 0) PG8_BAR; }
    PG8_BAR;
    if constexpr (Epi::AFTER_DRAIN) { E.fused(acc, cur, wr, wc, fr, fq, lds, wid, lane); S.done(cur); }
#undef PG8_SA
#undef PG8_SB
#undef PG8_STAGE
#undef PG8_LDA
#undef PG8_LDB
#undef PG8_MMA
#undef PG8_WAIT_V
#undef PG8_WAIT_L
#undef PG8_BAR
#undef PG8_SCHED
}
template <class Epi, class Sched, bool ALIGN_EPI = false, bool SP2 = false>
__device__ __forceinline__ void gemm_phase(PG8_LAS unsigned char* lds, const Gemm g, const Sched& S, const Epi& E) {
    f32x4 acc[2][2][4][2];
    gemm_body<Epi, Sched, ALIGN_EPI, SP2>(lds, g, S, E, acc, true);
}
struct OneUnit { Unit u;
    __device__ __forceinline__ bool next(int i, Unit& o) const { if (i) return false; o = u; return true; }
    __device__ __forceinline__ void a_ready(const Unit&) const {}
    __device__ __forceinline__ void done(const Unit&) const {} };
}

typedef unsigned short bf16_t;
using pg8::bf16x8; using pg8::f32x4; using pg8::u32x4;
typedef float f32x16 __attribute__((ext_vector_type(16)));
typedef unsigned u32x2 __attribute__((ext_vector_type(2)));
#define DI __device__ __forceinline__
#define MFMA32(a, b, c) __builtin_amdgcn_mfma_f32_32x32x16_bf16((a), (b), (c), 0, 0, 0)

constexpr int SEQ = 4096, BATCH = 8, DM = 1024, DEPTH = 2;
constexpr int NB = 4, TC = NB * SEQ, NCHUNK = BATCH / NB;
constexpr int INW = 11168, LDZ = 11168, NZP = 11264;
constexpr int C_LRUX = 0, C_LRUG = 1024, C_MLAG = 2048, C_DILG = 2560, C_DQ = 3072, C_DK = 4608, C_DV = 6144, C_MERGE = 7680, C_CQ = 10752, C_CKV = 11008, C_KR = 11136;
constexpr float EPS = 1e-6f, LOG2E = 1.4426950408889634f, LN2 = 0.6931471805599453f, LOG2_THETA = 13.287712379549449f;
constexpr int NUP = 1792, KUP = 384;

constexpr size_t W_IN_B = (size_t)NZP * DM * 2, W_UP_B = (size_t)NUP * KUP * 2, W_SQ_B = (size_t)DM * DM * 2, W_HF_B = (size_t)DM * 512 * 2, W_G_B = (size_t)8 * 128 * 128 * 2;
constexpr size_t WL_IN = 0, WL_UP = WL_IN + W_IN_B, WL_PCAT = WL_UP + W_UP_B  , WL_OUT = WL_PCAT + W_SQ_B + 2 * W_HF_B,
                 WL_GX = WL_OUT + W_SQ_B, WL_GA = WL_GX + W_G_B, WL_SIZE = WL_GA + W_G_B;
constexpr size_t WS_W = 0, WS_Z = WS_W + 2 * WL_SIZE, WS_S = WS_Z + (size_t)TC * LDZ * 2;
constexpr size_t S_XN = 0;
constexpr int LDQ = 1792;
constexpr size_t S_QF = 0, S_KF = S_QF + (size_t)TC * LDQ * 2, S_AGG = S_KF + (size_t)TC * 768 * 2,
                 S_LSE = S_AGG + (size_t)(TC / 64) * 1024 * 8, S_P23_END = S_LSE + (size_t)3 * TC * 8 * 4;
constexpr size_t S_MRG = 0, S_MB = S_MRG + (size_t)TC * DM * 4, S_END = S_MB + (size_t)TC * DM * 2;
static_assert(S_P23_END <= S_END, "scratch");
constexpr size_t WS_CTL = WS_S + S_END;
constexpr size_t WS_NEED = WS_CTL + 256 * 129;
static_assert(WS_NEED <= 536870912ull, "workspace");
static_assert(WS_Z % 256 == 0 && WS_S % 256 == 0 && WL_SIZE % 256 == 0, "align");
constexpr int LDS_BYTES = 139264;

DI float bflo(unsigned w) { return __uint_as_float(w << 16); }
DI float bfhi(unsigned w) { return __uint_as_float(w & 0xffff0000u); }
DI unsigned pk2(float lo, float hi) { typedef float f2_t __attribute__((ext_vector_type(2))); typedef __bf16 b2_t __attribute__((ext_vector_type(2)));
    f2_t v = {lo, hi}; b2_t b = __builtin_convertvector(v, b2_t); return __builtin_bit_cast(unsigned, b); }
DI float sigmoidf_(float x) { return __builtin_amdgcn_rcpf(1.f + __builtin_amdgcn_exp2f(-LOG2E * x)); }
DI float siluf_(float x) { return x * sigmoidf_(x); }
DI float fexp_(float x) { return __builtin_amdgcn_exp2f(LOG2E * x); }
DI float wave_sum(float v) {
#pragma unroll
    for (int m = 1; m < 64; m <<= 1) v += __shfl_xor(v, m);
    return v; }
DI void lds_barrier() { asm volatile("s_waitcnt lgkmcnt(0)\n\ts_barrier" ::: "memory"); }
DI int crow(int i, int h) { return (i & 3) + 8 * (i >> 2) + 4 * h; }
DI void sincos_rev(float ang, float& s, float& c) { float rev = ang * 0.15915494309189535f; rev = rev - floorf(rev); s = __builtin_amdgcn_sinf(rev); c = __builtin_amdgcn_cosf(rev); }

struct Args { const float* in[24]; float* out; unsigned char* ws; };
#ifndef PROBE_K
#define PROBE_K (-1)
#endif
#define PSTAMP(k) do { if (PROBE_K >= 0) { const unsigned long long now_ = __builtin_amdgcn_s_memrealtime(); if ((k) == PROBE_K) tacc += now_ - tprev; tprev = now_; } } while (0)

DI void wconv_job(float* tl, const float* __restrict__ src, int lds_, int n0s, int nrows, int ncols, bf16_t* dst, int ldd, int n0d, int k0d, const float* __restrict__ scale, int& base) {
    const int tid = otid(), ntn = (ncols + 127) / 128, ntk = nrows / 64, nt = ntn * ntk;
    f32x4 pv[4];
#define WC_LOAD(T) { const int tn_ = (T) % ntn, k0_ = ((T) / ntn) * 64, n4_ = tn_ * 128 + (tid & 31) * 4; _Pragma("unroll") for (int i = 0; i < 4; ++i) { const int kk = i * 16 + (tid >> 5); \
        f32x4 v = (f32x4){0.f, 0.f, 0.f, 0.f}; if (n4_ < ncols) v = *(const f32x4*)(src + (size_t)(k0_ + kk) * lds_ + n0s + n4_); if (scale) v *= scale[k0_ + kk]; pv[i] = v; } }
    const int G_ = gridDim.x; int t = (obid() + G_ - base % G_) % G_; base += nt;
    if (t < nt) WC_LOAD(t)
    for (; t < nt; t += gridDim.x) {
        const int tn = t % ntn, k0 = (t / ntn) * 64;
#pragma unroll
        for (int i = 0; i < 4; ++i) *(f32x4*)(tl + (i * 16 + (tid >> 5)) * 132 + (tid & 31) * 4) = pv[i];
        __syncthreads();
        if (t + (int)gridDim.x < nt) WC_LOAD(t + gridDim.x)
        { const int n = tid >> 2, kq = tid & 3; const float* tp = tl + (kq * 16) * 132 + n;
          if (tn * 128 + n < ncols) { u32x4 w0, w1;
            w0.x = pk2(tp[0 * 132], tp[1 * 132]); w0.y = pk2(tp[2 * 132], tp[3 * 132]); w0.z = pk2(tp[4 * 132], tp[5 * 132]); w0.w = pk2(tp[6 * 132], tp[7 * 132]);
            w1.x = pk2(tp[8 * 132], tp[9 * 132]); w1.y = pk2(tp[10 * 132], tp[11 * 132]); w1.z = pk2(tp[12 * 132], tp[13 * 132]); w1.w = pk2(tp[14 * 132], tp[15 * 132]);
            bf16_t* dp = dst + (size_t)(n0d + tn * 128 + n) * ldd + k0d + k0 + kq * 16; *(u32x4*)dp = w0; *(u32x4*)(dp + 8) = w1; } }
        lds_barrier();
    }
#undef WC_LOAD
}
DI void zero_rect(bf16_t* dst, int ldd, int n0, int nn, int k0, int nk) {
    const int per = nk / 8, tot = nn * per;
    for (int i = obid() * 512 + otid(); i < tot; i += gridDim.x * 512) { const int n = i / per, c = i % per;
        *(u32x4*)(dst + (size_t)(n0 + n) * ldd + k0 + c * 8) = (u32x4){0u, 0u, 0u, 0u}; }
}
DI void prologue_weights(const Args& a, unsigned char* lds) {
    float* tl = (float*)lds; int base = 0;
    for (int l = 0; l < DEPTH; ++l) {
        unsigned char* wl = a.ws + WS_W + (size_t)l * WL_SIZE;
        bf16_t* win = (bf16_t*)(wl + WL_IN); const float* w_in = a.in[3] + (size_t)l * DM * INW;
        wconv_job(tl, w_in, INW, 0,    1024, 2048, win, DM, C_LRUX, 0, nullptr, base);
        wconv_job(tl, w_in, INW, 2464, 1024, 512,  win, DM, C_MLAG, 0, nullptr, base);
        wconv_job(tl, w_in, INW, 7584, 1024, 512,  win, DM, C_DILG, 0, nullptr, base);
        wconv_job(tl, w_in, INW, 2976, 1024, 4608, win, DM, C_DQ, 0, nullptr, base);
        wconv_job(tl, w_in, INW, 8096, 1024, 3072, win, DM, C_MERGE, 0, nullptr, base);
        wconv_job(tl, w_in, INW, 2048, 1024, 416,  win, DM, C_CQ, 0, nullptr, base);
        zero_rect(win, DM, INW, NZP - INW, 0, DM);
        bf16_t* wup = (bf16_t*)(wl + WL_UP);
        wconv_job(tl, a.in[14] + (size_t)l * 256 * 768, 768, 0, 256, 768, wup, KUP, 0, 0, a.in[12] + l * 256, base);
        wconv_job(tl, a.in[15] + (size_t)l * 128 * 1024, 1024, 0, 128, 1024, wup, KUP, 768, 256, a.in[13] + l * 128, base);
        zero_rect(wup, KUP, 0, 768, 256, 128); zero_rect(wup, KUP, 768, 1024, 0, 256);
        wconv_job(tl, a.in[11] + (size_t)l * DM * DM, DM, 0, 1024, 1024, (bf16_t*)(wl + WL_PCAT), 2048, 0, 0, nullptr, base);
        wconv_job(tl, a.in[18] + (size_t)l * 512 * DM, DM, 0, 512, 1024, (bf16_t*)(wl + WL_PCAT), 2048, 0, 1024, nullptr, base);
        wconv_job(tl, a.in[21] + (size_t)l * 512 * DM, DM, 0, 512, 1024, (bf16_t*)(wl + WL_PCAT), 2048, 0, 1536, nullptr, base);
        wconv_job(tl, a.in[23] + (size_t)l * DM * DM, DM, 0, 1024, 1024, (bf16_t*)(wl + WL_OUT), 1024, 0, 0, nullptr, base);
        for (int nb = 0; nb < 8; ++nb) {
            wconv_job(tl, a.in[6] + ((size_t)l * 8 + nb) * 128 * 128, 128, 0, 128, 128, (bf16_t*)(wl + WL_GX) + nb * 128 * 128, 128, 0, 0, nullptr, base);
            wconv_job(tl, a.in[8] + ((size_t)l * 8 + nb) * 128 * 128, 128, 0, 128, 128, (bf16_t*)(wl + WL_GA) + nb * 128 * 128, 128, 0, 0, nullptr, base);
        }
    }
}

DI void p0_rmsnorm(const float* __restrict__ x, const float* __restrict__ g, bf16_t* xn) {
    const int tid = otid(), lane = tid & 63, gw = obid() * 8 + (tid >> 6), nw = gridDim.x * 8;
    f32x4 gv[4];
#pragma unroll
    for (int i = 0; i < 4; ++i) gv[i] = *(const f32x4*)(g + i * 256 + lane * 4);
    for (int row = gw; row < TC; row += nw) {
        const float* xr = x + (size_t)row * DM; f32x4 v[4]; float ss = 0.f;
#pragma unroll
        for (int i = 0; i < 4; ++i) { v[i] = *(const f32x4*)(xr + i * 256 + lane * 4); ss += v[i][0] * v[i][0] + v[i][1] * v[i][1] + v[i][2] * v[i][2] + v[i][3] * v[i][3]; }
        ss = wave_sum(ss); const float rs = rsqrtf(ss * (1.f / DM) + EPS);
#pragma unroll
        for (int i = 0; i < 4; ++i) { u32x2 w; w.x = pk2(v[i][0] * rs * gv[i][0], v[i][1] * rs * gv[i][1]); w.y = pk2(v[i][2] * rs * gv[i][2], v[i][3] * rs * gv[i][3]);
            *(u32x2*)(xn + (size_t)row * DM + i * 256 + lane * 4) = w; }
    }
}

struct EpiZ {
    static constexpr bool PERM = true, AFTER_DRAIN = false, CHAIN = false;
    bf16_t* O; int ldc; int ncols;
    DI void operator()(const f32x4 (&acc)[2][2][4][2], const pg8::Unit& u, int wr, int wc, int fr, int fq) const {
        const int row0 = u.pm * 256 + wr * 64 + fr, col0 = u.pn * 256 + wc * 32 + 8 * fq;
#pragma unroll
        for (int ai = 0; ai < 2; ++ai)
#pragma unroll
            for (int m = 0; m < 4; ++m) { bf16_t* rowp = O + (size_t)(row0 + ai * 128 + m * 16) * ldc;
#pragma unroll
                for (int bj = 0; bj < 2; ++bj) { const int c = col0 + bj * 128; if (c < ncols) { const f32x4 v0 = acc[ai][bj][m][0], v1 = acc[ai][bj][m][1];
                    u32x4 w; w.x = pk2(v0[0], v0[1]); w.y = pk2(v0[2], v0[3]); w.z = pk2(v1[0], v1[1]); w.w = pk2(v1[2], v1[3]); *(u32x4*)(rowp + c) = w; } } }
    }
};
struct EpiChain {
    static constexpr bool PERM = true, AFTER_DRAIN = false, CHAIN = true; static constexpr int T1 = 16, T2 = 24;
    const bf16_t* Z; const float* bm; bf16_t* MB;
    template <bool FIN> DI void run(f32x4 (&acc)[2][2][4][2], const pg8::Unit& u, int br, int wr, int wc, int fr_, int fq_) const {
        int fr = fr_, fq = fq_; asm volatile("" : "+v"(fr), "+v"(fq));
        const int row0 = u.pm * 256 + wr * 64 + fr, col0 = u.pn * 256 + wc * 32 + 8 * fq;
        const float* bmb = bm + br * 1024; const bf16_t* zb = Z + C_MERGE + br * 1024;
#pragma unroll
        for (int bj = 0; bj < 2; ++bj)
#pragma unroll
            for (int n = 0; n < 2; ++n) { const int c = col0 + bj * 128 + 4 * n;
                f32x4 b = *(const f32x4*)(bmb + c) * (-LOG2E), d = b; if (!FIN) d = *(const f32x4*)(bmb + 1024 + c) * (-LOG2E);
                u32x2 gz[8], hz[8];
#pragma unroll
                for (int q = 0; q < 8; ++q) { const bf16_t* zp = zb + (size_t)(row0 + (q >> 2) * 128 + (q & 3) * 16) * LDZ + c; gz[q] = *(const u32x2*)zp; if (!FIN) hz[q] = *(const u32x2*)(zp + 1024); }
#pragma unroll
                for (int q = 0; q < 8; ++q) { const int ai = q >> 2, m = q & 3; const size_t row = (size_t)(row0 + ai * 128 + m * 16);
                    f32x4 sc;
                    sc[0] = __builtin_amdgcn_rcpf(1.f + __builtin_amdgcn_exp2f(bflo(gz[q].x) * (-LOG2E) + b[0])); sc[1] = __builtin_amdgcn_rcpf(1.f + __builtin_amdgcn_exp2f(bfhi(gz[q].x) * (-LOG2E) + b[1]));
                    sc[2] = __builtin_amdgcn_rcpf(1.f + __builtin_amdgcn_exp2f(bflo(gz[q].y) * (-LOG2E) + b[2])); sc[3] = __builtin_amdgcn_rcpf(1.f + __builtin_amdgcn_exp2f(bfhi(gz[q].y) * (-LOG2E) + b[3]));
                    if (!FIN) {
                        sc[0] *= 1.f + __builtin_amdgcn_exp2f(bflo(hz[q].x) * (-LOG2E) + d[0]); sc[1] *= 1.f + __builtin_amdgcn_exp2f(bfhi(hz[q].x) * (-LOG2E) + d[1]);
                        sc[2] *= 1.f + __builtin_amdgcn_exp2f(bflo(hz[q].y) * (-LOG2E) + d[2]); sc[3] *= 1.f + __builtin_amdgcn_exp2f(bfhi(hz[q].y) * (-LOG2E) + d[3]);
                        acc[ai][bj][m][n] *= sc; asm volatile("" : "+v"(acc[ai][bj][m][n]));
                    } else {
                        const f32x4 v = acc[ai][bj][m][n] * sc; u32x2 w; w.x = pk2(v[0], v[1]); w.y = pk2(v[2], v[3]); *(u32x2*)(MB + row * DM + c) = w; } }
                asm volatile("" ::: "memory"); }
    }
    DI void mid(f32x4 (&acc)[2][2][4][2], const pg8::Unit& u, int t, int wr, int wc, int fr, int fq) const { run<false>(acc, u, t == T1 ? 0 : 1, wr, wc, fr, fq); }
    DI void operator()(f32x4 (&acc)[2][2][4][2], const pg8::Unit& u, int wr, int wc, int fr, int fq) const { run<true>(acc, u, 2, wr, wc, fr, fq); }
};
struct EpiOut {
    static constexpr bool PERM = false, AFTER_DRAIN = false, CHAIN = false;
    const float* X; float* O;
    DI void operator()(const f32x4 (&acc)[2][2][4][2], const pg8::Unit& u, int wr, int wc, int fr, int fq) const {
        const int row0 = u.pm * 256 + wr * 64 + fr, col0 = u.pn * 256 + wc * 32 + 4 * fq;
#pragma unroll
        for (int ai = 0; ai < 2; ++ai)
#pragma unroll
            for (int mp = 0; mp < 2; ++mp) {
                f32x4 xv[2][2][2];
#pragma unroll
                for (int mm = 0; mm < 2; ++mm) { const size_t ro = (size_t)(row0 + ai * 128 + (mp * 2 + mm) * 16) * DM + col0;
#pragma unroll
                    for (int bj = 0; bj < 2; ++bj)
#pragma unroll
                        for (int n = 0; n < 2; ++n) xv[mm][bj][n] = *(const f32x4*)(X + ro + bj * 128 + n * 16); }
#pragma unroll
                for (int mm = 0; mm < 2; ++mm) { const size_t ro = (size_t)(row0 + ai * 128 + (mp * 2 + mm) * 16) * DM + col0;
#pragma unroll
                    for (int bj = 0; bj < 2; ++bj)
#pragma unroll
                        for (int n = 0; n < 2; ++n) *(f32x4*)(O + ro + bj * 128 + n * 16) = xv[mm][bj][n] + acc[ai][bj][mp * 2 + mm][n]; }
                asm volatile("" ::: "memory"); }
    }
};

#define UNPK8(W_, d, o, sc_) { const u32x4 w_ = (W_); d[o + 0] = bflo(w_.x) * (sc_); d[o + 1] = bfhi(w_.x) * (sc_); d[o + 2] = bflo(w_.y) * (sc_); d[o + 3] = bfhi(w_.y) * (sc_); d[o + 4] = bflo(w_.z) * (sc_); d[o + 5] = bfhi(w_.z) * (sc_); d[o + 6] = bflo(w_.w) * (sc_); d[o + 7] = bfhi(w_.w) * (sc_); }
DI void dil_prep(bf16_t* z, const int* __restrict__ pos, const float* __restrict__ gq, const float* __restrict__ gk) {
    const int tid = otid(), lane = tid & 63, gw = obid() * 8 + (tid >> 6), nw = gridDim.x * 8, j = lane & 7, hsub = lane >> 3;
    float inv[8], gqo[8], gqp[8], gko[8], gkp[8];
#pragma unroll
    for (int e = 0; e < 8; ++e) { inv[e] = __builtin_amdgcn_exp2f(-(float)(8 * (j & 3) + e) * (LOG2_THETA / 32.f));
        gqo[e] = gq[j * 8 + e]; gqp[e] = gq[(j ^ 4) * 8 + e]; gko[e] = gk[j * 8 + e]; gkp[e] = gk[(j ^ 4) * 8 + e]; }
    const float sgn = (j < 4) ? -1.f : 1.f;
    for (int wi0 = gw; wi0 < TC * 6; wi0 += 8 * nw) {
        u32x4 wv[8];
#pragma unroll
        for (int b = 0; b < 8; ++b) { const int wi = wi0 + b * nw; wv[b] = (u32x4){0u, 0u, 0u, 0u};
            if (wi < TC * 6) { const int tok = wi / 6, grp = wi - tok * 6; wv[b] = *(const u32x4*)(z + (size_t)tok * LDZ + (grp < 3 ? C_DQ + grp * 512 : C_DK + (grp - 3) * 512) + hsub * 64 + j * 8); } }
#pragma unroll
        for (int b = 0; b < 8; ++b) { const int wi = wi0 + b * nw; if (wi < TC * 6) {
            const int tok = wi / 6, grp = wi - tok * 6; const bool isq = grp < 3;
            bf16_t* p = z + (size_t)tok * LDZ + (isq ? C_DQ + grp * 512 : C_DK + (grp - 3) * 512) + hsub * 64 + j * 8;
            const u32x4 w = wv[b]; u32x4 q;
            q.x = __shfl_xor(w.x, 4); q.y = __shfl_xor(w.y, 4); q.z = __shfl_xor(w.z, 4); q.w = __shfl_xor(w.w, 4);
            float v[8], u[8]; UNPK8(w, v, 0, 1.f) UNPK8(q, u, 0, 1.f)
            float ss = 0.f;
#pragma unroll
            for (int e = 0; e < 8; ++e) ss += v[e] * v[e];
            ss += __shfl_xor(ss, 1); ss += __shfl_xor(ss, 2); ss += __shfl_xor(ss, 4);
            const float rs = rsqrtf(ss * (1.f / 64.f) + EPS) * (isq ? 0.125f * LOG2E : 1.f);
            const float fp = (float)pos[tok];
            float o[8];
#pragma unroll
            for (int e = 0; e < 8; ++e) { float sn, cs; sincos_rev(fp * inv[e], sn, cs);
                const float a = v[e] * rs * (isq ? gqo[e] : gko[e]), bb = u[e] * rs * (isq ? gqp[e] : gkp[e]); o[e] = a * cs + sgn * bb * sn; }
            u32x4 r; r.x = pk2(o[0], o[1]); r.y = pk2(o[2], o[3]); r.z = pk2(o[4], o[5]); r.w = pk2(o[6], o[7]);
            *(u32x4*)p = r; } }
    }
}

DI float ssq8(u32x4 w) { return bflo(w.x) * bflo(w.x) + bfhi(w.x) * bfhi(w.x) + bflo(w.y) * bflo(w.y) + bfhi(w.y) * bfhi(w.y) + bflo(w.z) * bflo(w.z) + bfhi(w.z) * bfhi(w.z) + bflo(w.w) * bflo(w.w) + bfhi(w.w) * bfhi(w.w); }
DI u32x4 scale8(u32x4 w, float s, const float* __restrict__ g) { u32x4 o; o.x = pk2(bflo(w.x) * s * g[0], bfhi(w.x) * s * g[1]); o.y = pk2(bflo(w.y) * s * g[2], bfhi(w.y) * s * g[3]);
    o.z = pk2(bflo(w.z) * s * g[4], bfhi(w.z) * s * g[5]); o.w = pk2(bflo(w.w) * s * g[6], bfhi(w.w) * s * g[7]); return o; }
DI void rope16(float (&v)[32], const float* __restrict__ g, float fp) {
#pragma unroll
    for (int i = 0; i < 16; ++i) { const float inv = exp2f(-(float)i * (LOG2_THETA / 16.f)); float sn, cs; sincos_rev(fp * inv, sn, cs);
        const float x1 = v[i] * g[i], x2 = v[16 + i] * g[16 + i]; v[i] = x1 * cs - x2 * sn; v[16 + i] = x2 * cs + x1 * sn; }
}
DI void mla_finalize(unsigned char* lds, const bf16_t* z, bf16_t* qf, bf16_t* kvr, bf16_t* kf, const int* __restrict__ pos, const float* __restrict__ gqn_g, const float* __restrict__ gkn_g) {
    float* rst = (float*)lds;
    float* gl = rst + 128; const float* gqn = gl; const float* gkn = gl + 96;
    for (int grp = obid(); grp < TC / 64; grp += gridDim.x) {
        const int tid = otid(), lane = tid & 63, wid = tid >> 6;
        const int t0 = grp * 64;
        const int tl_ = tid >> 3, hd = tid & 7, tok = t0 + tl_;
        bf16_t* pq = qf + (size_t)tok * LDQ + hd * 96; bf16_t* pkv = kvr + (size_t)tok * LDQ + hd * 128; const bf16_t* pkr = z + (size_t)tok * LDZ + C_KR; bf16_t* pk = kf + (size_t)tok * 768 + hd * 96;
        u32x4 rq[12];
#pragma unroll
        for (int c = 0; c < 12; ++c) rq[c] = *(const u32x4*)(pq + c * 8);
        const float fp = (float)pos[tok];
        if (tid < 192) gl[tid] = (tid < 96) ? gqn_g[tid] : gkn_g[tid - 96];
        u32x2 la[8]; unsigned lb[8];
#pragma unroll
        for (int i = 0; i < 8; ++i) { const bf16_t* zr = z + (size_t)(t0 + wid * 8 + i) * LDZ; la[i] = *(const u32x2*)(zr + C_CQ + lane * 4); lb[i] = *(const unsigned*)(zr + C_CKV + lane * 2); }
        __syncthreads();
#pragma unroll
        for (int i = 0; i < 8; ++i) {
            float s1 = bflo(la[i].x) * bflo(la[i].x) + bfhi(la[i].x) * bfhi(la[i].x) + bflo(la[i].y) * bflo(la[i].y) + bfhi(la[i].y) * bfhi(la[i].y), s2 = bflo(lb[i]) * bflo(lb[i]) + bfhi(lb[i]) * bfhi(lb[i]);
            s1 = wave_sum(s1); s2 = wave_sum(s2);
            if (lane == 0) { rst[(wid * 8 + i) * 2] = rsqrtf(s1 * (1.f / 256.f) + EPS); rst[(wid * 8 + i) * 2 + 1] = rsqrtf(s2 * (1.f / 128.f) + EPS); } }
        __syncthreads();
        const float rcq = rst[tl_ * 2], rckv = rst[tl_ * 2 + 1];
        {
            float ss = 0.f;
#pragma unroll
            for (int c = 0; c < 12; ++c) ss += ssq8(rq[c]);
            ss *= rcq * rcq;
            const float rs = rsqrtf(ss * (1.f / 96.f) + EPS) * rcq * (0.10206207261596575f * LOG2E);
#pragma unroll
            for (int c = 0; c < 8; ++c) *(u32x4*)(pq + c * 8) = scale8(rq[c], rs, gqn + c * 8);
            float v[32];
#pragma unroll
            for (int c = 0; c < 4; ++c) { UNPK8(rq[8 + c], v, c * 8, rs) }
            rope16(v, gqn + 64, fp);
#pragma unroll
            for (int c = 0; c < 4; ++c) { u32x4 w; w.x = pk2(v[c * 8 + 0], v[c * 8 + 1]); w.y = pk2(v[c * 8 + 2], v[c * 8 + 3]); w.z = pk2(v[c * 8 + 4], v[c * 8 + 5]); w.w = pk2(v[c * 8 + 6], v[c * 8 + 7]);
                *(u32x4*)(pq + 64 + c * 8) = w; }
        }
        asm volatile("" ::: "memory");
        {
            u32x4 rk[8], rv[8], rr[4];
#pragma unroll
            for (int c = 0; c < 8; ++c) { rk[c] = *(const u32x4*)(pkv + c * 8); rv[c] = *(const u32x4*)(pkv + 64 + c * 8); }
#pragma unroll
            for (int c = 0; c < 4; ++c) rr[c] = *(const u32x4*)(pkr + c * 8);
            float ss = 0.f, sr = 0.f;
#pragma unroll
            for (int c = 0; c < 8; ++c) ss += ssq8(rk[c]);
#pragma unroll
            for (int c = 0; c < 4; ++c) sr += ssq8(rr[c]);
            ss = ss * rckv * rckv + sr;
            const float rs = rsqrtf(ss * (1.f / 96.f) + EPS);
#pragma unroll
            for (int c = 0; c < 8; ++c) *(u32x4*)(pk + c * 8) = scale8(rk[c], rs * rckv, gkn + c * 8);
            float v[32];
#pragma unroll
            for (int c = 0; c < 4; ++c) { UNPK8(rr[c], v, c * 8, rs) }
            rope16(v, gkn + 64, fp);
#pragma unroll
            for (int c = 0; c < 4; ++c) { u32x4 w; w.x = pk2(v[c * 8 + 0], v[c * 8 + 1]); w.y = pk2(v[c * 8 + 2], v[c * 8 + 3]); w.z = pk2(v[c * 8 + 4], v[c * 8 + 5]); w.w = pk2(v[c * 8 + 6], v[c * 8 + 7]);
                *(u32x4*)(pk + 64 + c * 8) = w; }
#pragma unroll
            for (int c = 0; c < 8; ++c) { u32x4 w = rv[c];
                w.x = pk2(bflo(w.x) * rckv, bfhi(w.x) * rckv); w.y = pk2(bflo(w.y) * rckv, bfhi(w.y) * rckv); w.z = pk2(bflo(w.z) * rckv, bfhi(w.z) * rckv); w.w = pk2(bflo(w.w) * rckv, bfhi(w.w) * rckv);
                *(u32x4*)(pkv + 64 + c * 8) = w; }
        }
    }
}

DI void dil_combine(bf16_t* z, const float* __restrict__ lse) {
    const int tot = TC * 64, stride = gridDim.x * 512;
    for (int it0 = obid() * 512 + otid(); it0 < tot; it0 += 2 * stride) {
        u32x4 A[2], B[2], C[2], Gt[2]; float L0[2], L1[2], L2[2];
#pragma unroll
        for (int b = 0; b < 2; ++b) { const int it = it0 + b * stride; if (it < tot) { const int tok = it >> 6, hd = (it >> 3) & 7, dc = it & 7; const bf16_t* zr = z + (size_t)tok * LDZ;
            L0[b] = lse[(size_t)tok * 8 + hd]; L1[b] = lse[(size_t)TC * 8 + (size_t)tok * 8 + hd]; L2[b] = lse[(size_t)2 * TC * 8 + (size_t)tok * 8 + hd];
            A[b] = *(const u32x4*)(zr + C_DQ + (0 * 8 + hd) * 64 + dc * 8); B[b] = *(const u32x4*)(zr + C_DQ + (1 * 8 + hd) * 64 + dc * 8); C[b] = *(const u32x4*)(zr + C_DQ + (2 * 8 + hd) * 64 + dc * 8);
            Gt[b] = *(const u32x4*)(zr + C_DILG + hd * 64 + dc * 8); } }
#pragma unroll
        for (int b = 0; b < 2; ++b) { const int it = it0 + b * stride; if (it < tot) { const int tok = it >> 6, hd = (it >> 3) & 7, dc = it & 7;
            const float l0 = L0[b], l1 = L1[b], l2 = L2[b];
            const float mx = fmaxf(l0, fmaxf(l1, l2)); float w0 = fexp_(l0 - mx), w1 = fexp_(l1 - mx), w2 = fexp_(l2 - mx); const float iw = __builtin_amdgcn_rcpf(w0 + w1 + w2); w0 *= iw; w1 *= iw; w2 *= iw;
            const u32x4 a = A[b], bq = B[b], c = C[b], g = Gt[b]; u32x4 o;
#define CMB(F) { const float e0 = (w0 * bflo(a.F) + w1 * bflo(bq.F) + w2 * bflo(c.F)) * siluf_(bflo(g.F)), e1 = (w0 * bfhi(a.F) + w1 * bfhi(bq.F) + w2 * bfhi(c.F)) * siluf_(bfhi(g.F)); o.F = pk2(e0, e1); }
            CMB(x) CMB(y) CMB(z) CMB(w)
#undef CMB
            *(u32x4*)(z + (size_t)tok * LDZ + C_DILG + hd * 64 + dc * 8) = o; } }
    }
}

struct LruP { const float* conv_w; const float* conv_b; const float* b_gx; const float* b_ga; const float* lam; const bf16_t* wgx; const bf16_t* wga; };
constexpr int L_XS = 0, L_XCB = 18432, L_XC = L_XCB + 17408, L_HB = L_XC + 32768, L_CW = L_HB + 32768, L_EX = L_CW + 5 * 128 * 4, L_END = L_EX + 2 * 128 * 8;
static_assert(L_END <= LDS_BYTES, "lru lds");
template <bool FINAL> DI void lru_unit(unsigned char* lds, bf16_t* z, float* agg, const LruP& P, int bl, int n, int grp) {
    const int tid0 = otid();
    bf16_t* xs = (bf16_t*)(lds + L_XS); bf16_t* xcb = (bf16_t*)(lds + L_XCB); float* xc = (float*)(lds + L_XC); float* hb = (float*)(lds + L_HB);
    float* cw = (float*)(lds + L_CW); float2* ex = (float2*)(lds + L_EX);
    __syncthreads();
    const int tid = tid0, lane = tid & 63, wid = tid >> 6, r = lane & 31, h = lane >> 5, ct = wid & 3, rt = wid >> 2;
    for (int i = tid; i < 640; i += 512) cw[i] = (i < 512) ? P.conv_w[(i >> 7) * 1024 + n * 128 + (i & 127)] : P.conv_b[n * 128 + (i & 127)];
    bf16x8 bx[8], ba[8];
    { const bf16_t* wx = P.wgx + (size_t)n * 16384 + (size_t)(ct * 32 + r) * 128 + 8 * h; const bf16_t* wa = P.wga + (size_t)n * 16384 + (size_t)(ct * 32 + r) * 128 + 8 * h;
#pragma unroll
      for (int s = 0; s < 8; ++s) { bx[s] = *(const bf16x8*)(wx + 16 * s); ba[s] = *(const bf16x8*)(wa + 16 * s); } }
    const int ch = ct * 32 + r, chg = n * 128 + ch; const float bgx = P.b_gx[chg], bga = P.b_ga[chg]; const float sp = __logf(1.f + __expf(-P.lam[chg]));
    float hrun = 0.f, Arun = 1.f;
    if (FINAL) {
#pragma unroll
        for (int g2 = 0; g2 < 7; ++g2) if (g2 < grp) { const float2 ab = *(const float2*)(agg + ((size_t)(bl * 8 + g2) * 1024 + chg) * 2); hrun = ab.x * hrun + ab.y; } }
    const size_t rowb = (size_t)bl * SEQ;
    u32x4 xr[3], gr[2];
#define LRU_XLOAD(J) { _Pragma("unroll") for (int q = 0; q < 3; ++q) { const int c = tid + q * 512; const int i = c >> 4, cc = c & 15; const int p = (J) * 64 - 3 + i; \
        xr[q] = (u32x4){0u, 0u, 0u, 0u}; if (c < 67 * 16 && p >= 0) xr[q] = *(const u32x4*)(z + (rowb + p) * LDZ + C_LRUX + n * 128 + cc * 8); } }
#pragma unroll
    for (int s = 0; s < 8; ++s) asm volatile("" :: "v"(bx[s]), "v"(ba[s]));
    asm volatile("" :: "v"(bgx), "v"(bga), "v"(sp), "v"(hrun));
    LRU_XLOAD(grp * 8)
    __syncthreads();
#pragma unroll 1
    for (int jt = 0; jt < 8; ++jt) {
        int tq = tid0; asm volatile("" : "+v"(tq));
        const int tid = tq, lane = tid & 63, wid = tid >> 6, r = lane & 31, h = lane >> 5, ct = wid & 3, rt = wid >> 2, ch = ct * 32 + r;
        const int j = grp * 8 + jt; const size_t row0 = rowb + (size_t)j * 64;
#pragma unroll
        for (int q = 0; q < 3; ++q) { const int c = tid + q * 512; if (c < 67 * 16) *(u32x4*)(xs + (c >> 4) * 136 + (c & 15) * 8) = xr[q]; }
        lds_barrier();
        if (jt + 1 < 8) LRU_XLOAD(j + 1)
        if (FINAL) {
#pragma unroll
            for (int q = 0; q < 2; ++q) { const int c = tid + q * 512; gr[q] = *(const u32x4*)(z + (row0 + (c >> 4)) * LDZ + C_LRUG + n * 128 + (c & 15) * 8); } }
        {
            const int i = tid >> 3, c0 = (tid & 7) * 16; float acc[16];
#pragma unroll
            for (int q = 0; q < 4; ++q) { const f32x4 b = *(const f32x4*)(cw + 512 + c0 + q * 4); acc[q * 4] = b[0]; acc[q * 4 + 1] = b[1]; acc[q * 4 + 2] = b[2]; acc[q * 4 + 3] = b[3]; }
#pragma unroll
            for (int k = 0; k < 4; ++k) {
                const u32x4 xa = *(const u32x4*)(xs + (i + k) * 136 + c0), xb = *(const u32x4*)(xs + (i + k) * 136 + c0 + 8);
                const float xv[16] = {bflo(xa.x), bfhi(xa.x), bflo(xa.y), bfhi(xa.y), bflo(xa.z), bfhi(xa.z), bflo(xa.w), bfhi(xa.w), bflo(xb.x), bfhi(xb.x), bflo(xb.y), bfhi(xb.y), bflo(xb.z), bfhi(xb.z), bflo(xb.w), bfhi(xb.w)};
#pragma unroll
                for (int q = 0; q < 4; ++q) { const f32x4 w = *(const f32x4*)(cw + k * 128 + c0 + q * 4);
                    acc[q * 4] += w[0] * xv[q * 4]; acc[q * 4 + 1] += w[1] * xv[q * 4 + 1]; acc[q * 4 + 2] += w[2] * xv[q * 4 + 2]; acc[q * 4 + 3] += w[3] * xv[q * 4 + 3]; } }
#pragma unroll
            for (int q = 0; q < 4; ++q) *(f32x4*)(xc + i * 128 + c0 + q * 4) = (f32x4){acc[q * 4], acc[q * 4 + 1], acc[q * 4 + 2], acc[q * 4 + 3]};
            u32x4 w0, w1; w0.x = pk2(acc[0], acc[1]); w0.y = pk2(acc[2], acc[3]); w0.z = pk2(acc[4], acc[5]); w0.w = pk2(acc[6], acc[7]);
            w1.x = pk2(acc[8], acc[9]); w1.y = pk2(acc[10], acc[11]); w1.z = pk2(acc[12], acc[13]); w1.w = pk2(acc[14], acc[15]);
            *(u32x4*)(xcb + i * 136 + c0) = w0; *(u32x4*)(xcb + i * 136 + c0 + 8) = w1;
        }
        lds_barrier();
        float av[16], bv[16], Ao[4], Ho[4], Ap[4], Hp[4];
        {
            f32x16 gx, ga;
#pragma unroll
            for (int i = 0; i < 16; ++i) { gx[i] = 0.f; ga[i] = 0.f; }
#pragma unroll
            for (int s = 0; s < 8; ++s) { const bf16x8 a = *(const bf16x8*)(xcb + (rt * 32 + r) * 136 + 16 * s + 8 * h); gx = MFMA32(a, bx[s], gx); ga = MFMA32(a, ba[s], ga); }
#pragma unroll
            for (int i = 0; i < 16; ++i) { const int tk = rt * 32 + crow(i, h);
                const float vgx = sigmoidf_(gx[i] + bgx), vga = sigmoidf_(ga[i] + bga); const float la = -8.f * vga * sp; av[i] = fexp_(la);
                const float mult = __builtin_amdgcn_sqrtf(fmaxf(1.f - av[i] * av[i], 0.f));
                bv[i] = mult * vgx * xc[tk * 128 + ch]; }
        }
#pragma unroll
        for (int g = 0; g < 4; ++g) { float H = 0.f, A = 1.f;
#pragma unroll
            for (int k = 0; k < 4; ++k) { H = av[4 * g + k] * H + bv[4 * g + k]; A *= av[4 * g + k]; }
            Ao[g] = A; Ho[g] = H; Ap[g] = __shfl_xor(A, 32); Hp[g] = __shfl_xor(H, 32); }
        {   float c = 0.f, At = 1.f;
#pragma unroll
            for (int g = 0; g < 4; ++g) { const float A1 = h ? Ap[g] : Ao[g], H1 = h ? Hp[g] : Ho[g], A2 = h ? Ao[g] : Ap[g], H2 = h ? Ho[g] : Hp[g]; c = A1 * c + H1; c = A2 * c + H2; At *= A1 * A2; }
            if (h == 0) ex[rt * 128 + ch] = make_float2(At, c); }
        lds_barrier();
        {   const float2 e0 = ex[ch], e1 = ex[128 + ch]; const float hmid = e0.x * hrun + e0.y;
            float c = rt ? hmid : hrun;
            hrun = e1.x * hmid + e1.y; Arun *= e0.x * e1.x;
            if (FINAL) {
#pragma unroll
                for (int g = 0; g < 4; ++g) { const float A1 = h ? Ap[g] : Ao[g], H1 = h ? Hp[g] : Ho[g], A2 = h ? Ao[g] : Ap[g], H2 = h ? Ho[g] : Hp[g];
                    const float c1 = A1 * c + H1; float hh = h ? c1 : c; c = A2 * c1 + H2;
#pragma unroll
                    for (int k = 0; k < 4; ++k) { hh = av[4 * g + k] * hh + bv[4 * g + k]; hb[(rt * 32 + 8 * g + 4 * h + k) * 128 + ch] = hh; } } } }
        if (FINAL) {
            lds_barrier();
#pragma unroll
            for (int q = 0; q < 2; ++q) { const int c = tid + q * 512; const int i = c >> 4, cc = c & 15; bf16_t* gp = z + (row0 + i) * LDZ + C_LRUG + n * 128 + cc * 8; const u32x4 g = gr[q];
                const f32x4 h0 = *(const f32x4*)(hb + i * 128 + cc * 8), h1 = *(const f32x4*)(hb + i * 128 + cc * 8 + 4); u32x4 o;
                o.x = pk2(h0[0] * siluf_(bflo(g.x)), h0[1] * siluf_(bfhi(g.x))); o.y = pk2(h0[2] * siluf_(bflo(g.y)), h0[3] * siluf_(bfhi(g.y)));
                o.z = pk2(h1[0] * siluf_(bflo(g.z)), h1[1] * siluf_(bfhi(g.z))); o.w = pk2(h1[2] * siluf_(bflo(g.w)), h1[3] * siluf_(bfhi(g.w))); *(u32x4*)gp = o; }
        }
    }
#undef LRU_XLOAD
    if (!FINAL && h == 0 && rt == 0) *(float2*)(agg + ((size_t)(bl * 8 + grp) * 1024 + chg) * 2) = make_float2(Arun, hrun);
}

typedef short s16x4 __attribute__((ext_vector_type(4)));
DI s16x4 vtr(const bf16_t* p) { return __builtin_amdgcn_ds_read_tr16_b64_v4i16((__attribute__((address_space(3))) s16x4*)p); }
template <int DK, bool WIN, bool MLA>
DI void attn_unit(unsigned char* lds, const bf16_t* Qb, size_t qs, const bf16_t* Kb, size_t ks, const bf16_t* Vb, size_t vs, int q0, bf16_t* Ob, size_t os, float* lsep, size_t lses, const float CS) {
    constexpr int KLD = DK + 8, VLD = 96, KC = DK / 8, NKR = (128 * KC) / 512, KBYTES = 128 * KLD * 2, BUFB = KBYTES + 128 * VLD * 2;
    static_assert((128 * KC) % 512 == 0 && 2 * BUFB <= LDS_BYTES, "attention staging");
    const int tid = otid(), lane = tid & 63, wid = tid >> 6, r = lane & 31, h = lane >> 5;
    const int qw = q0 + 32 * wid;
    bf16x8 qf[DK / 16];
    { const bf16_t* qrow = Qb + (size_t)(qw + r) * qs + 8 * h;
#pragma unroll
      for (int s = 0; s < DK / 16; ++s) qf[s] = *(const bf16x8*)(qrow + 16 * s); }
    f32x16 o[2];
#pragma unroll
    for (int i = 0; i < 16; ++i) { o[0][i] = 0.f; o[1][i] = 0.f; }
    float lrow = 0.f;
    const int kt_lo = WIN ? (q0 >= 128 ? (q0 - 128) / 128 : 0) : 0, kt_hi = (q0 + 255) / 128, ntile = kt_hi - kt_lo + 1;
    const int kfrag = r * KLD + 8 * h, vfrag = (4 * h + ((lane & 15) >> 2)) * VLD + 16 * ((lane >> 4) & 1) + 4 * (lane & 3);
    u32x4 kreg[NKR], vreg[2];
#define ATT_GLOAD(KT) { const size_t kb = (size_t)(KT) * 128; \
        _Pragma("unroll") for (int q_ = 0; q_ < NKR; ++q_) { const int c_ = tid + q_ * 512; kreg[q_] = *(const u32x4*)(Kb + (kb + c_ / KC) * ks + (c_ % KC) * 8); } \
        _Pragma("unroll") for (int q_ = 0; q_ < 2; ++q_) { const int c_ = tid + q_ * 512; vreg[q_] = *(const u32x4*)(Vb + (kb + (c_ >> 3)) * vs + (c_ & 7) * 8); } }
#define ATT_LWRITE(SLOT) { bf16_t* kp_ = (bf16_t*)(lds + (SLOT) * BUFB); bf16_t* vp_ = (bf16_t*)(lds + (SLOT) * BUFB + KBYTES); \
        _Pragma("unroll") for (int q_ = 0; q_ < NKR; ++q_) { const int c_ = tid + q_ * 512; *(u32x4*)(kp_ + (c_ / KC) * KLD + (c_ % KC) * 8) = kreg[q_]; } \
        _Pragma("unroll") for (int q_ = 0; q_ < 2; ++q_) { const int c_ = tid + q_ * 512; *(u32x4*)(vp_ + (c_ >> 3) * VLD + (c_ & 7) * 8) = vreg[q_]; } }
    ATT_GLOAD(kt_lo)
#pragma unroll
    for (int s = 0; s < DK / 16; ++s) asm volatile("" :: "v"(qf[s]));
    __syncthreads();
    ATT_LWRITE(0)
    if (ntile > 1) ATT_GLOAD(kt_lo + 1)
#pragma unroll 1
    for (int it = 0; it < ntile; ++it) {
        const int kbase = (kt_lo + it) * 128;
        lds_barrier();
        if (it + 1 < ntile) { ATT_LWRITE((it + 1) & 1) if (it + 2 < ntile) ATT_GLOAD(kt_lo + it + 2) }
        const bf16_t* Ks = (const bf16_t*)(lds + (it & 1) * BUFB) + kfrag; const bf16_t* Vs = (const bf16_t*)(lds + (it & 1) * BUFB + KBYTES) + vfrag;
        const int qi = qw + r;
#pragma unroll
        for (int hp = 0; hp < 2; ++hp) {
            const int kb = kbase + 64 * hp;
            const bool active = (kb <= qw + 31) && (!WIN || kb + 63 >= qw - 128);
            if (active) {
                f32x16 x[2];
#pragma unroll
                for (int i = 0; i < 16; ++i) { x[0][i] = -CS; x[1][i] = -CS; }
#pragma unroll
                for (int s = 0; s < DK / 16; ++s) { const bf16x8 a0 = *(const bf16x8*)(Ks + (hp * 64) * KLD + 16 * s), a1 = *(const bf16x8*)(Ks + (hp * 64 + 32) * KLD + 16 * s);
                    x[0] = MFMA32(a0, qf[s], x[0]); x[1] = MFMA32(a1, qf[s], x[1]); }
                const bool need_mask = (kb + 63 > qw) || (WIN && kb < qw + 31 - 128);
                if (need_mask) {
#pragma unroll
                    for (int kt2 = 0; kt2 < 2; ++kt2)
#pragma unroll
                        for (int i = 0; i < 16; ++i) { const int key = kb + kt2 * 32 + crow(i, h); const bool ok = (key <= qi) && (!WIN || key >= qi - 128); x[kt2][i] = ok ? x[kt2][i] : -INFINITY; } }
#pragma unroll
                for (int kt2 = 0; kt2 < 2; ++kt2)
#pragma unroll
                    for (int i = 0; i < 16; ++i) { const float p = __builtin_amdgcn_exp2f(x[kt2][i]); x[kt2][i] = p; lrow += p; }
#pragma unroll
                for (int kt2 = 0; kt2 < 2; ++kt2)
#pragma unroll
                    for (int s = 0; s < 2; ++s) {
                        u32x4 pw; pw.x = pk2(x[kt2][8 * s + 0], x[kt2][8 * s + 1]); pw.y = pk2(x[kt2][8 * s + 2], x[kt2][8 * s + 3]); pw.z = pk2(x[kt2][8 * s + 4], x[kt2][8 * s + 5]); pw.w = pk2(x[kt2][8 * s + 6], x[kt2][8 * s + 7]);
                        const bf16x8 pb = __builtin_bit_cast(bf16x8, pw);
#pragma unroll
                        for (int n = 0; n < 2; ++n) { const bf16_t* vp = Vs + (hp * 64 + kt2 * 32 + 16 * s) * VLD + 32 * n;
                            const s16x4 lo = vtr(vp), hi = vtr(vp + 8 * VLD);
                            const bf16x8 av = __builtin_shufflevector(lo, hi, 0, 1, 2, 3, 4, 5, 6, 7);
                            o[n] = MFMA32(av, pb, o[n]); } }
            }
        }
    }
#undef ATT_GLOAD
#undef ATT_LWRITE
    lrow += __shfl_xor(lrow, 32);
    const float inv = __builtin_amdgcn_rcpf(lrow); const size_t orow = (size_t)(qw + r) * os;
    u32x2 gv[2][4];
    if (MLA) {
#pragma unroll
        for (int n = 0; n < 2; ++n)
#pragma unroll
            for (int g4 = 0; g4 < 4; ++g4) gv[n][g4] = *(const u32x2*)(Ob + orow + n * 32 + g4 * 8 + 4 * h); }
#pragma unroll
    for (int n = 0; n < 2; ++n)
#pragma unroll
        for (int g4 = 0; g4 < 4; ++g4) { const int dv = n * 32 + g4 * 8 + 4 * h; bf16_t* op = Ob + orow + dv;
            float e0 = o[n][g4 * 4] * inv, e1 = o[n][g4 * 4 + 1] * inv, e2 = o[n][g4 * 4 + 2] * inv, e3 = o[n][g4 * 4 + 3] * inv;
            if (MLA) { const u32x2 g = gv[n][g4]; e0 *= siluf_(bflo(g.x)); e1 *= siluf_(bfhi(g.x)); e2 *= siluf_(bflo(g.y)); e3 *= siluf_(bfhi(g.y)); }
            u32x2 w; w.x = pk2(e0, e1); w.y = pk2(e2, e3); *(u32x2*)op = w; }
    if (!MLA) { if (h == 0) lsep[(size_t)(qw + r) * lses] = (CS + __log2f(lrow)) * LN2; }
}

DI void gsync(unsigned* ctr, unsigned& target) {
    asm volatile("s_waitcnt vmcnt(0)" ::: "memory");
    __syncthreads();
    target += gridDim.x;
    if (threadIdx.x == 0) {
        __builtin_amdgcn_fence(__ATOMIC_RELEASE, "agent");
        asm volatile("s_waitcnt vmcnt(0)" ::: "memory");
        (void)__hip_atomic_fetch_add(ctr, 1u, __ATOMIC_RELAXED, __HIP_MEMORY_SCOPE_AGENT);
        while (__hip_atomic_load(ctr, __ATOMIC_RELAXED, __HIP_MEMORY_SCOPE_AGENT) < target) __builtin_amdgcn_s_sleep(16);
        __builtin_amdgcn_fence(__ATOMIC_ACQUIRE, "agent");
        asm volatile("s_waitcnt vmcnt(0)" ::: "memory");
    }
    __syncthreads();
}

DI void panel_signal(unsigned* cnt) {
    if (threadIdx.x == 0) { __builtin_amdgcn_fence(__ATOMIC_RELEASE, "agent"); asm volatile("s_waitcnt vmcnt(0)" ::: "memory");
        (void)__hip_atomic_fetch_add(cnt, 1u, __ATOMIC_RELAXED, __HIP_MEMORY_SCOPE_AGENT); }
}
DI void panel_wait(unsigned* cnt, unsigned target) {
    if (threadIdx.x == 0) { while (__hip_atomic_load(cnt, __ATOMIC_RELAXED, __HIP_MEMORY_SCOPE_AGENT) < target) __builtin_amdgcn_s_sleep(8);
        __builtin_amdgcn_fence(__ATOMIC_ACQUIRE, "agent"); asm volatile("s_waitcnt vmcnt(0)" ::: "memory"); }
    __syncthreads();
}

__global__ void __launch_bounds__(512, 2) hybrid_fwd(Args a) {
    extern __shared__ __attribute__((aligned(16))) unsigned char lds_raw[];
    cg::grid_group grid = cg::this_grid();
    unsigned char* lds = lds_raw; PG8_LAS unsigned char* ldsl = (PG8_LAS unsigned char*)lds_raw;
    const int G = gridDim.x;
#define bx obid()
    unsigned char* ws = a.ws;
    bf16_t* z = (bf16_t*)(ws + WS_Z); unsigned char* sc = ws + WS_S;
    bf16_t* xn = (bf16_t*)(sc + S_XN); bf16_t* qf = (bf16_t*)(sc + S_QF); bf16_t* kvr = qf + 768; bf16_t* kf = (bf16_t*)(sc + S_KF);
    float* agg = (float*)(sc + S_AGG); float* lse = (float*)(sc + S_LSE); float* mrg = (float*)(sc + S_MRG); bf16_t* mb = (bf16_t*)(sc + S_MB);
    const int* positions = (const int*)a.in[1];

    unsigned* gctr = (unsigned*)(ws + WS_CTL); unsigned gtarget = 0;
    if (blockIdx.x == 0 && threadIdx.x < 129) __hip_atomic_store(gctr + 64 * threadIdx.x, 0u, __ATOMIC_RELAXED, __HIP_MEMORY_SCOPE_AGENT);
    unsigned* cntA = gctr + 64; unsigned* cntB = gctr + 64 * 65; const bool fullgrid = (G == 256);
    unsigned long long tacc = 0, tprev = 0; if (PROBE_K >= 0) tprev = __builtin_amdgcn_s_memrealtime();
    prologue_weights(a, lds);
    if (PROBE_K == 0) { grid.sync(); PSTAMP(0); }
#pragma unroll 1
    for (int l = 0; l < DEPTH; ++l) {
#pragma unroll 1
        for (int c = 0; c < NCHUNK; ++c) {
            int lo = l; asm volatile("" : "+s"(lo));
            const unsigned char* wl = ws + WS_W + (size_t)lo * WL_SIZE;
            const size_t roff = (size_t)c * TC;
            const float* xin = (l == 0 ? a.in[0] : a.out) + roff * DM; float* xout = a.out + roff * DM; const int* pos = positions + roff;
            p0_rmsnorm(xin, a.in[2] + lo * DM, xn);
            if (l == 0 && c == 0) grid.sync(); else gsync(gctr, gtarget);
            PSTAMP(1);
            { pg8::Gemm g; g.A = xn; g.Bt = (const bf16_t*)(wl + WL_IN); g.M = TC; g.N = NZP; g.K = DM; g.lda = DM;
              pg8::StaticOrder S; S.init(TC, NZP, G, bx); EpiZ E; E.O = z; E.ldc = LDZ; E.ncols = INW;
              pg8::gemm_phase<EpiZ, pg8::StaticOrder, true, true>(ldsl, g, S, E); }
            gsync(gctr, gtarget); PSTAMP(2);
            { pg8::Gemm g; g.A = z + C_CQ; g.Bt = (const bf16_t*)(wl + WL_UP); g.M = TC; g.N = NUP; g.K = KUP; g.lda = LDZ;
              pg8::StaticOrder S; S.init(TC, NUP, G, bx); EpiZ E; E.O = qf; E.ldc = LDQ; E.ncols = NUP;
              pg8::gemm_phase<EpiZ, pg8::StaticOrder, true, true>(ldsl, g, S, E);
              if (fullgrid) { pg8::Unit uu; for (int i = 0; S.next(i, uu); ++i) if (uu.pn >= 0) panel_signal(cntB + 64 * uu.pm); } }
            __syncthreads();
            LruP lp; lp.conv_w = a.in[4] + (size_t)lo * 4 * 1024; lp.conv_b = a.in[5] + lo * 1024; lp.b_gx = a.in[7] + lo * 1024; lp.b_ga = a.in[9] + lo * 1024; lp.lam = a.in[10] + lo * 1024;
            lp.wgx = (const bf16_t*)(wl + WL_GX); lp.wga = (const bf16_t*)(wl + WL_GA);
#pragma unroll 1
            for (int k3 = 0; k3 < 3; ++k3) {
                int stg = (k3 + bx % 3) % 3; asm volatile("" : "+s"(stg));
                if (stg == 0) dil_prep(z, pos, a.in[19] + lo * 64, a.in[20] + lo * 64);
                else if (stg == 1) { for (int u = bx; u < NB * 64; u += G) lru_unit<false>(lds, z, agg, lp, u >> 6, (u >> 3) & 7, u & 7); }
                else {
                    if (fullgrid) panel_wait(cntB + 64 * (bx >> 2), 7u * (unsigned)(l * NCHUNK + c + 1)); else gsync(gctr, gtarget);
                    mla_finalize(lds, z, qf, kvr, kf, pos, a.in[16] + lo * 96, a.in[17] + lo * 96); }
                __syncthreads();
            }
            PSTAMP(3);
            gsync(gctr, gtarget); PSTAMP(4);
            float cs_mla, cs_dil;
            { float mq = 0.f, mk = 0.f, dq_ = 0.f, dk_ = 0.f; const float* g1 = a.in[16] + lo * 96; const float* g2 = a.in[17] + lo * 96; const float* g3 = a.in[19] + lo * 64; const float* g4 = a.in[20] + lo * 64;
              for (int i = 0; i < 96; ++i) { mq = fmaxf(mq, fabsf(g1[i])); mk = fmaxf(mk, fabsf(g2[i])); }
              for (int i = 0; i < 64; ++i) { dq_ = fmaxf(dq_, fabsf(g3[i])); dk_ = fmaxf(dk_, fabsf(g4[i])); }
              cs_mla = 96.f * 0.10206207261596575f * LOG2E * mq * mk; cs_dil = 64.f * 0.125f * LOG2E * dq_ * dk_; }
            const int nrnd = (512 + NB * 384 + G - 1) / G, rot = (bx & 1) ? 2 : 0;
#pragma unroll 1
            for (int k8 = 0; k8 < nrnd; ++k8) {
                const int u = bx + G * ((k8 + rot) % nrnd); if (u >= 512 + NB * 384) continue;
                if (u < 512) {
                    int qb, bh; if (u < 256) { qb = 15 - (u >> 5); bh = u & 31; } else { qb = (u - 256) >> 5; bh = (u - 256) & 31; }
                    const int bl = bh >> 3, hd = bh & 7; const size_t t0 = (size_t)bl * SEQ;
                    attn_unit<96, false, true>(lds, qf + t0 * LDQ + hd * 96, LDQ, kf + t0 * 768 + hd * 96, 768, kvr + t0 * LDQ + hd * 128 + 64, LDQ, qb * 256,
                                               z + t0 * LDZ + C_MLAG + hd * 64, LDZ, nullptr, 0, cs_mla);
                } else {
                    const int v = u - 512, bl = v / 384, w = v % 384, gi = w >> 7, w2 = w & 127, hd = w2 >> 4, rem = w2 & 15;
                    const int d = 1 << (2 * gi), npairs = 16 >> (2 * gi), r = rem / npairs, pair = rem % npairs, head = gi * 8 + hd;
                    const size_t brow = (size_t)bl * SEQ + r; bf16_t* zb = z + brow * LDZ + head * 64; const size_t st = (size_t)d * LDZ;
                    attn_unit<64, true, false>(lds, zb + C_DQ, st, zb + C_DK, st, zb + C_DV, st, pair * 256, zb + C_DQ, st, lse + (size_t)gi * TC * 8 + brow * 8 + hd, (size_t)d * 8, cs_dil);
                }
            }
            gsync(gctr, gtarget); PSTAMP(5);
            dil_combine(z, lse);
            for (int u = bx; u < NB * 64; u += G) lru_unit<true>(lds, z, agg, lp, u >> 6, (u >> 3) & 7, u & 7);
            gsync(gctr, gtarget); PSTAMP(6);
            { pg8::Gemm g; g.A = z + C_LRUG; g.Bt = (const bf16_t*)(wl + WL_PCAT); g.M = TC; g.N = DM; g.K = 2048; g.lda = LDZ;
              pg8::StaticOrder S; S.init(TC, DM, G, bx); EpiChain E; E.Z = z; E.bm = a.in[22] + (size_t)lo * 3072; E.MB = mb;
              pg8::gemm_phase<EpiChain, pg8::StaticOrder, true, true>(ldsl, g, S, E);
              if (fullgrid) { pg8::Unit uu; S.next(0, uu); panel_signal(cntA + 64 * uu.pm); panel_wait(cntA + 64 * uu.pm, 4u * (unsigned)(l * NCHUNK + c + 1)); } }
            if (!fullgrid) gsync(gctr, gtarget);
            PSTAMP(7);
            { pg8::Gemm g; g.A = mb; g.Bt = (const bf16_t*)(wl + WL_OUT); g.M = TC; g.N = DM; g.K = DM; g.lda = DM;
              pg8::StaticOrder S; S.init(TC, DM, G, bx); EpiOut E; E.X = xin; E.O = xout;
              pg8::gemm_phase<EpiOut, pg8::StaticOrder, true, true>(ldsl, g, S, E); }
            __syncthreads();
            if (PROBE_K == 8) { grid.sync(); PSTAMP(8); }
        }
    }
    if (PROBE_K >= 0 && blockIdx.x == 0 && threadIdx.x == 0) { const unsigned long long t0 = __builtin_amdgcn_s_memrealtime(); while (__builtin_amdgcn_s_memrealtime() - t0 < tacc) __builtin_amdgcn_s_sleep(8); }
}

extern "C" void kernel_launch(void* const* d_in, const int* in_sizes, int n_in, void* d_out, int out_size, void* d_ws, size_t ws_size, hipStream_t stream) {
    static int grid_blocks = 0;
    if (!grid_blocks) {
        int dev = 0, cus = 0, per_cu = 0;
        (void)hipGetDevice(&dev);
        (void)hipDeviceGetAttribute(&cus, hipDeviceAttributeMultiprocessorCount, dev);
        if (hipFuncSetAttribute((const void*)hybrid_fwd, hipFuncAttributeMaxDynamicSharedMemorySize, LDS_BYTES) != hipSuccess) fprintf(stderr, "hipFuncSetAttribute failed\n");
        if (hipOccupancyMaxActiveBlocksPerMultiprocessor(&per_cu, (const void*)hybrid_fwd, 512, LDS_BYTES) != hipSuccess || per_cu < 1) per_cu = 1;
        grid_blocks = cus * 1;
        if (ws_size < WS_NEED) fprintf(stderr, "workspace too small: %zu < %zu\n", ws_size, (size_t)WS_NEED);
    }
    if (ws_size < WS_NEED || n_in < 24) return;
    Args a{};
    for (int i = 0; i < 24; ++i) a.in[i] = (const float*)d_in[i];
    a.out = (float*)d_out; a.ws = (unsigned char*)d_ws;
    void* args[] = {&a};
    hipError_t e = hipLaunchCooperativeKernel((const void*)hybrid_fwd, dim3(grid_blocks), dim3(512), args, LDS_BYTES, stream);
    if (e != hipSuccess) fprintf(stderr, "cooperative launch failed: %s (grid %d)\n", hipGetErrorString(e), grid_blocks);
}
```

```cpp
#include <hip/hip_runtime.h>
#include <hip/hip_cooperative_groups.h>
#include <cstdio>
#include <cstdint>
namespace cg = cooperative_groups;
__device__ __forceinline__ int otid() { int t = threadIdx.x; asm volatile("" : "+v"(t)); return t; }
__device__ __forceinline__ int obid() { int b = blockIdx.x; asm volatile("" : "+s"(b)); return b; }
namespace pg8 {
#define PG8_LAS __attribute__((address_space(3)))
typedef unsigned short bf16_t;
typedef short bf16x8 __attribute__((ext_vector_type(8)));
typedef float f32x4 __attribute__((ext_vector_type(4)));
typedef unsigned u32x4 __attribute__((ext_vector_type(4)));
constexpr int BM = 256, BK = 64, HALF = 128, HTB = HALF * BK * 2  , STAGE_BYTES = 8 * HTB, NXCD = 8, WGM = 8;

__host__ __device__ __forceinline__ int lds_byte(int r, int c) { const int st = (r >> 4) * 2 + (c >> 5), rr = r & 15, cc = c & 31, ob = rr * 64 + cc * 2; return st * 1024 + (ob ^ (((ob >> 9) & 1) << 5)); }
__host__ __device__ __forceinline__ void stage_rc(int b, int& R, int& C) { const int st = b / 1024, sb = b % 1024, swz = sb ^ (((sb >> 9) & 1) << 5); R = (st >> 1) * 16 + swz / 64; C = (st & 1) * 32 + (swz % 64) / 2; }
__host__ __device__ __forceinline__ int perm32(int rho) { const int n = rho >> 4, i = rho & 15; return 8 * (i >> 2) + 4 * n + (i & 3); }

struct Unit { int pm, pn; };
struct Gemm { const bf16_t* A; const bf16_t* Bt; int M, N, K, lda; };

struct StaticOrder {
    int nM, nN, nwg, G, c;
    __host__ __device__ void init(int M, int N, int G_, int c_) { nM = M / BM; nN = N / BM; nwg = nM * nN; G = G_; c = c_; }
    __host__ __device__ bool next(int i, Unit& u) const {
        const long L = (long)i * G + c; if (L >= nwg) return false;
        int wgid = (int)L; { const int q = nwg / NXCD, r = nwg % NXCD, xcd = wgid % NXCD, off = wgid / NXCD; wgid = (xcd < r ? xcd * (q + 1) : r * (q + 1) + (xcd - r) * q) + off; }
        const int nig = WGM * nN, gid = wgid / nig, fm = gid * WGM, gsz = (nM - fm) < WGM ? (nM - fm) : WGM;
        u.pm = fm + ((wgid % nig) % gsz); u.pn = (wgid % nig) / gsz; return true;
    }
    __device__ __forceinline__ void a_ready(const Unit&) const {}
    __device__ __forceinline__ void done(const Unit&) const {}
};
__device__ __forceinline__ unsigned cvt_pk_bf16(float lo, float hi) { unsigned r; asm volatile("v_cvt_pk_bf16_f32 %0, %1, %2" : "=v"(r) : "v"(lo), "v"(hi)); return r; }
template <class Epi, class Sched, bool ALIGN_EPI = false, bool SP2 = false>
__device__ __forceinline__ void gemm_body(PG8_LAS unsigned char* lds, const Gemm g, const Sched& S, const Epi& E, f32x4 (&acc)[2][2][4][2], const bool zero_init) {
    const int tid = otid(), wid = __builtin_amdgcn_readfirstlane(tid >> 6), lane = tid & 63, wr = wid >> 2, wc = wid & 3, fr = lane & 15, fq = lane >> 4;
    const int K = g.K, nt = K / BK;
    unsigned voffA[2], voffB[2];
#pragma unroll
    for (int i = 0; i < 2; ++i) { int R, C; stage_rc(tid * 16 + i * 8192, R, C); const int Rb = Epi::PERM ? ((R & ~31) + perm32(R & 31)) : R;
        voffA[i] = (unsigned)(R * g.lda + C) * 2u; voffB[i] = (unsigned)(Rb * K + C) * 2u; }
    const size_t kstep = (size_t)(BK * 2);
    const size_t hstepA = (size_t)HALF * g.lda * 2, hstepB = (size_t)HALF * K * 2;
    const size_t tstepA = 2 * hstepA, tstepB = 2 * hstepB;
    const unsigned ldsw = (unsigned)wid * 1024u;
    const int aoff = lds_byte(wr * 64 + fr, fq * 8), boff = lds_byte(wc * 32 + fr, fq * 8);
#define PG8_SA(b, h) (((b) * 2 + (h)) * HTB)
#define PG8_SB(b, h) ((4 + (b) * 2 + (h)) * HTB)
#define PG8_STAGE(bufoff, gbase, voff) do { _Pragma("unroll") for (int _i = 0; _i < 2; ++_i) \
        __builtin_amdgcn_global_load_lds((const unsigned*)((const char*)(gbase) + (voff)[_i]), (PG8_LAS unsigned*)(lds + (bufoff) + ldsw + _i * 8192), 16, 0, 0); } while (0)
#define PG8_LDA(dst, b, h) do { _Pragma("unroll") for (int m = 0; m < 4; ++m) _Pragma("unroll") for (int k = 0; k < 2; ++k) dst[m][k] = *(const PG8_LAS bf16x8*)(lds + PG8_SA(b, h) + aoff + m * 2048 + k * 1024); } while (0)
#define PG8_LDB(dst, b, h) do { _Pragma("unroll") for (int n = 0; n < 2; ++n) _Pragma("unroll") for (int k = 0; k < 2; ++k) dst[n][k] = *(const PG8_LAS bf16x8*)(lds + PG8_SB(b, h) + boff + n * 2048 + k * 1024); } while (0)
#define PG8_MMA(ai, bj, At, Bt) do { __builtin_amdgcn_s_setprio(1); _Pragma("unroll") for (int m = 0; m < 4; ++m) _Pragma("unroll") for (int n = 0; n < 2; ++n) _Pragma("unroll") for (int k = 0; k < 2; ++k) \
        acc[ai][bj][m][n] = __builtin_amdgcn_mfma_f32_16x16x32_bf16(Bt[n][k], At[m][k], acc[ai][bj][m][n], 0, 0, 0); __builtin_amdgcn_s_setprio(0); } while (0)
#define PG8_WAIT_V(n) asm volatile("s_waitcnt vmcnt(" #n ")" ::: "memory")
#define PG8_WAIT_L(n) asm volatile("s_waitcnt lgkmcnt(" #n ")" ::: "memory")
#define PG8_BAR __builtin_amdgcn_s_barrier()
#define PG8_SCHED __builtin_amdgcn_sched_barrier(0)
    Unit cur, nxt; int ui = 0;
    if (!S.next(0, cur)) return;
    if (zero_init) {
#pragma unroll
    for (int a = 0; a < 2; ++a)
#pragma unroll
        for (int b = 0; b < 2; ++b)
#pragma unroll
            for (int m = 0; m < 4; ++m)
#pragma unroll
                for (int n = 0; n < 2; ++n) acc[a][b][m][n] = (f32x4){0.f, 0.f, 0.f, 0.f};
    }
    bf16x8 At[4][2], B0[2][2], B1[2][2];
    const char* cA = (const char*)g.A + (size_t)cur.pm * tstepA; const char* cB = (const char*)g.Bt + (size_t)cur.pn * tstepB;
    S.a_ready(cur);
    if constexpr (SP2) {
        PG8_STAGE(PG8_SB(0, 0), cB, voffB); PG8_STAGE(PG8_SB(0, 1), cB + hstepB, voffB); PG8_STAGE(PG8_SA(0, 0), cA, voffA); PG8_STAGE(PG8_SA(0, 1), cA + hstepA, voffA);
        if (wr == 1) PG8_BAR;
        PG8_WAIT_V(2); PG8_BAR;
        PG8_STAGE(PG8_SB(1, 0), cB + kstep, voffB); PG8_STAGE(PG8_SA(1, 0), cA + kstep, voffA); PG8_STAGE(PG8_SB(1, 1), cB + hstepB + kstep, voffB);
        PG8_WAIT_V(6); PG8_BAR;
    } else {
        PG8_STAGE(PG8_SB(0, 0), cB, voffB); PG8_STAGE(PG8_SA(0, 0), cA, voffA); PG8_STAGE(PG8_SB(0, 1), cB + hstepB, voffB); PG8_STAGE(PG8_SA(0, 1), cA + hstepA, voffA);
        if (wr == 1) PG8_BAR;
        PG8_WAIT_V(4); PG8_BAR;
        PG8_STAGE(PG8_SB(1, 0), cB + kstep, voffB); PG8_STAGE(PG8_SA(1, 0), cA + kstep, voffA); PG8_STAGE(PG8_SB(1, 1), cB + hstepB + kstep, voffB);
        PG8_WAIT_V(6); PG8_BAR;
    }
    for (;;) {
        const bool has_next = S.next(ui + 1, nxt);
        const char* nA = has_next ? (const char*)g.A + (size_t)nxt.pm * tstepA : cA; const char* nB = has_next ? (const char*)g.Bt + (size_t)nxt.pn * tstepB : cB;
#pragma unroll 1
        for (int t = 0; t < nt; t += 2) {
            if constexpr (Epi::CHAIN) { if (t == Epi::T1 || t == Epi::T2) E.mid(acc, cur, t, wr, wc, fr, fq); }
            const bool last = (t == nt - 2);
            const char* a1 = cA + (size_t)(t + 1) * kstep;
            const char* a2 = last ? nA : cA + (size_t)(t + 2) * kstep; const char* b2 = last ? nB : cB + (size_t)(t + 2) * kstep;
            const char* a3 = a2 + kstep; const char* b3 = b2 + kstep;
            if (last && has_next) S.a_ready(nxt);
            if constexpr (SP2) {
            PG8_LDB(B0, 0, 0); PG8_LDB(B1, 0, 1); PG8_SCHED; PG8_LDA(At, 0, 0); PG8_STAGE(PG8_SA(1, 1), a1 + hstepA, voffA);
            PG8_WAIT_V(8); PG8_WAIT_L(0); PG8_BAR; PG8_MMA(0, 0, At, B0); PG8_MMA(0, 1, At, B1); PG8_BAR; PG8_SCHED;
            PG8_LDA(At, 0, 1); PG8_STAGE(PG8_SB(0, 0), b2, voffB); PG8_STAGE(PG8_SB(0, 1), b2 + hstepB, voffB); PG8_STAGE(PG8_SA(0, 0), a2, voffA);
            PG8_WAIT_V(8); PG8_WAIT_L(0); PG8_BAR; PG8_MMA(1, 0, At, B0); PG8_MMA(1, 1, At, B1); PG8_BAR; PG8_SCHED;
            PG8_LDB(B0, 1, 0); PG8_LDB(B1, 1, 1); PG8_SCHED; PG8_LDA(At, 1, 0); PG8_STAGE(PG8_SA(0, 1), a2 + hstepA, voffA);
            PG8_WAIT_V(8); PG8_WAIT_L(0); PG8_BAR; PG8_MMA(0, 0, At, B0); PG8_MMA(0, 1, At, B1); PG8_BAR; PG8_SCHED;
            PG8_LDA(At, 1, 1); PG8_STAGE(PG8_SB(1, 0), b3, voffB); PG8_STAGE(PG8_SB(1, 1), b3 + hstepB, voffB); PG8_STAGE(PG8_SA(1, 0), a3, voffA);
            PG8_WAIT_V(8); PG8_WAIT_L(0); PG8_BAR; PG8_MMA(1, 0, At, B0); PG8_MMA(1, 1, At, B1); PG8_BAR; PG8_SCHED;
            } else {
            PG8_LDB(B0, 0, 0); PG8_SCHED; PG8_LDA(At, 0, 0); PG8_STAGE(PG8_SA(1, 1), a1 + hstepA, voffA);
            PG8_WAIT_L(8); PG8_BAR; PG8_WAIT_L(0); PG8_MMA(0, 0, At, B0); PG8_BAR; PG8_SCHED;
            PG8_LDB(B1, 0, 1); PG8_STAGE(PG8_SB(0, 0), b2, voffB);
            PG8_BAR; PG8_WAIT_L(0); PG8_MMA(0, 1, At, B1); PG8_BAR;
            PG8_LDA(At, 0, 1); PG8_STAGE(PG8_SA(0, 0), a2, voffA);
            PG8_BAR; PG8_WAIT_L(0); PG8_MMA(1, 0, At, B0); PG8_BAR; PG8_SCHED;
            PG8_STAGE(PG8_SB(0, 1), b2 + hstepB, voffB);
            PG8_WAIT_V(6); PG8_BAR; PG8_MMA(1, 1, At, B1); PG8_BAR;
            PG8_LDB(B0, 1, 0); PG8_SCHED; PG8_LDA(At, 1, 0); PG8_STAGE(PG8_SA(0, 1), a2 + hstepA, voffA);
            PG8_WAIT_L(8); PG8_BAR; PG8_WAIT_L(0); PG8_MMA(0, 0, At, B0); PG8_BAR; PG8_SCHED;
            PG8_LDB(B1, 1, 1); PG8_STAGE(PG8_SB(1, 0), b3, voffB);
            PG8_BAR; PG8_WAIT_L(0); PG8_MMA(0, 1, At, B1); PG8_BAR;
            PG8_LDA(At, 1, 1); PG8_STAGE(PG8_SA(1, 0), a3, voffA);
            PG8_BAR; PG8_WAIT_L(0); PG8_MMA(1, 0, At, B0); PG8_BAR; PG8_SCHED;
            PG8_STAGE(PG8_SB(1, 1), b3 + hstepB, voffB);
            PG8_WAIT_V(6); PG8_BAR; PG8_MMA(1, 1, At, B1); PG8_BAR;
            }
        }
        if constexpr (ALIGN_EPI) { if (wr == 0) PG8_BAR; }
        if constexpr (!Epi::AFTER_DRAIN) { E(acc, cur, wr, wc, fr, fq); S.done(cur); }
        if (!has_next) break;
#pragma unroll
        for (int a = 0; a < 2; ++a)
#pragma unroll
            for (int b = 0; b < 2; ++b)
#pragma unroll
                for (int m = 0; m < 4; ++m)
#pragma unroll
                    for (int n = 0; n < 2; ++n) acc[a][b][m][n] = (f32x4){0.f, 0.f, 0.f, 0.f};
        cur = nxt; cA = nA; cB = nB; ++ui;
        if constexpr (ALIGN_EPI) { if (wr == 1) PG8_BAR; }
    }
    PG8_WAIT_V(0);
    if constexpr (!ALIGN_EPI) { if (wr == 0) PG8_BAR; }
    PG8_BAR;
    if constexpr (Epi::AFTER_DRAIN) { E.fused(acc, cur, wr, wc, fr, fq, lds, wid, lane); S.done(cur); }
#undef PG8_SA
#undef PG8_SB
#undef PG8_STAGE
#undef PG8_LDA
#undef PG8_LDB
#undef PG8_MMA
#undef PG8_WAIT_V
#undef PG8_WAIT_L
#undef PG8_BAR
#undef PG8_SCHED
}
template <class Epi, class Sched, bool ALIGN_EPI = false, bool SP2 = false>
__device__ __forceinline__ void gemm_phase(PG8_LAS unsigned char* lds, const Gemm g, const Sched& S, const Epi& E) {
    f32x4 acc[2][2][4][2];
    gemm_body<Epi, Sched, ALIGN_EPI, SP2>(lds, g, S, E, acc, true);
}
struct OneUnit { Unit u;
    __device__ __forceinline__ bool next(int i, Unit& o) const { if (i) return false; o = u; return true; }
    __device__ __forceinline__ void a_ready(const Unit&) const {}
    __device__ __forceinline__ void done(const Unit&) const {} };
}

typedef unsigned short bf16_t;
using pg8::bf16x8; using pg8::f32x4; using pg8::u32x4;
typedef float f32x16 __attribute__((ext_vector_type(16)));
typedef unsigned u32x2 __attribute__((ext_vector_type(2)));
#define DI __device__ __forceinline__
#define MFMA32(a, b, c) __builtin_amdgcn_mfma_f32_32x32x16_bf16((a), (b), (c), 0, 0, 0)

constexpr int SEQ = 4096, BATCH = 8, DM = 1024, DEPTH = 2;
constexpr int NB = 4, TC = NB * SEQ, NCHUNK = BATCH / NB;
constexpr int INW = 11168, LDZ = 11168, NZP = 11264;
constexpr int C_LRUX = 0, C_LRUG = 1024, C_MLAG = 2048, C_DILG = 2560, C_DQ = 3072, C_DK = 4608, C_DV = 6144, C_MERGE = 7680, C_CQ = 10752, C_CKV = 11008, C_KR = 11136;
constexpr float EPS = 1e-6f, LOG2E = 1.4426950408889634f, LN2 = 0.6931471805599453f, LOG2_THETA = 13.287712379549449f;
constexpr int NUP = 1792, KUP = 384;

constexpr size_t W_IN_B = (size_t)NZP * DM * 2, W_UP_B = (size_t)NUP * KUP * 2, W_SQ_B = (size_t)DM * DM * 2, W_HF_B = (size_t)DM * 512 * 2, W_G_B = (size_t)8 * 128 * 128 * 2;
constexpr size_t WL_IN = 0, WL_UP = WL_IN + W_IN_B, WL_PCAT = WL_UP + W_UP_B  , WL_OUT = WL_PCAT + W_SQ_B + 2 * W_HF_B,
                 WL_GX = WL_OUT + W_SQ_B, WL_GA = WL_GX + W_G_B, WL_SIZE = WL_GA + W_G_B;
constexpr size_t WS_W = 0, WS_Z = WS_W + 2 * WL_SIZE, WS_S = WS_Z + (size_t)TC * LDZ * 2;
constexpr size_t S_XN = 0;
constexpr int LDQ = 1792;
constexpr size_t S_QF = 0, S_KF = S_QF + (size_t)TC * LDQ * 2, S_AGG = S_KF + (size_t)TC * 768 * 2,
                 S_LSE = S_AGG + (size_t)(TC / 64) * 1024 * 8, S_P23_END = S_LSE + (size_t)3 * TC * 8 * 4;
constexpr size_t S_MRG = 0, S_MB = S_MRG + (size_t)TC * DM * 4, S_END = S_MB + (size_t)TC * DM * 2;
static_assert(S_P23_END <= S_END, "scratch");
constexpr size_t WS_CTL = WS_S + S_END;
constexpr size_t WS_NEED = WS_CTL + 256 * 129;
static_assert(WS_NEED <= 536870912ull, "workspace");
static_assert(WS_Z % 256 == 0 && WS_S % 256 == 0 && WL_SIZE % 256 == 0, "align");
constexpr int LDS_BYTES = 139264;

DI float bflo(unsigned w) { return __uint_as_float(w << 16); }
DI float bfhi(unsigned w) { return __uint_as_float(w & 0xffff0000u); }
DI unsigned pk2(float lo, float hi) { typedef float f2_t __attribute__((ext_vector_type(2))); typedef __bf16 b2_t __attribute__((ext_vector_type(2)));
    f2_t v = {lo, hi}; b2_t b = __builtin_convertvector(v, b2_t); return __builtin_bit_cast(unsigned, b); }
DI float sigmoidf_(float x) { return __builtin_amdgcn_rcpf(1.f + __builtin_amdgcn_exp2f(-LOG2E * x)); }
DI float siluf_(float x) { return x * sigmoidf_(x); }
DI float fexp_(float x) { return __builtin_amdgcn_exp2f(LOG2E * x); }
DI float wave_sum(float v) {
#pragma unroll
    for (int m = 1; m < 64; m <<= 1) v += __shfl_xor(v, m);
    return v; }
DI void lds_barrier() { asm volatile("s_waitcnt lgkmcnt(0)\n\ts_barrier" ::: "memory"); }
DI int crow(int i, int h) { return (i & 3) + 8 * (i >> 2) + 4 * h; }
DI void sincos_rev(float ang, float& s, float& c) { float rev = ang * 0.15915494309189535f; rev = rev - floorf(rev); s = __builtin_amdgcn_sinf(rev); c = __builtin_amdgcn_cosf(rev); }

struct Args { const float* in[24]; float* out; unsigned char* ws; };
#ifndef PROBE_K
#define PROBE_K (-1)
#endif
#define PSTAMP(k) do { if (PROBE_K >= 0) { const unsigned long long now_ = __builtin_amdgcn_s_memrealtime(); if ((k) == PROBE_K) tacc += now_ - tprev; tprev = now_; } } while (0)

DI void wconv_job(float* tl, const float* __restrict__ src, int lds_, int n0s, int nrows, int ncols, bf16_t* dst, int ldd, int n0d, int k0d, const float* __restrict__ scale, int& base) {
    const int tid = otid(), ntn = (ncols + 127) / 128, ntk = nrows / 64, nt = ntn * ntk;
    f32x4 pv[4];
#define WC_LOAD(T) { const int tn_ = (T) % ntn, k0_ = ((T) / ntn) * 64, n4_ = tn_ * 128 + (tid & 31) * 4; _Pragma("unroll") for (int i = 0; i < 4; ++i) { const int kk = i * 16 + (tid >> 5); \
        f32x4 v = (f32x4){0.f, 0.f, 0.f, 0.f}; if (n4_ < ncols) v = *(const f32x4*)(src + (size_t)(k0_ + kk) * lds_ + n0s + n4_); if (scale) v *= scale[k0_ + kk]; pv[i] = v; } }
    const int G_ = gridDim.x; int t = (obid() + G_ - base % G_) % G_; base += nt;
    if (t < nt) WC_LOAD(t)
    for (; t < nt; t += gridDim.x) {
        const int tn = t % ntn, k0 = (t / ntn) * 64;
#pragma unroll
        for (int i = 0; i < 4; ++i) *(f32x4*)(tl + (i * 16 + (tid >> 5)) * 132 + (tid & 31) * 4) = pv[i];
        __syncthreads();
        if (t + (int)gridDim.x < nt) WC_LOAD(t + gridDim.x)
        { const int n = tid >> 2, kq = tid & 3; const float* tp = tl + (kq * 16) * 132 + n;
          if (tn * 128 + n < ncols) { u32x4 w0, w1;
            w0.x = pk2(tp[0 * 132], tp[1 * 132]); w0.y = pk2(tp[2 * 132], tp[3 * 132]); w0.z = pk2(tp[4 * 132], tp[5 * 132]); w0.w = pk2(tp[6 * 132], tp[7 * 132]);
            w1.x = pk2(tp[8 * 132], tp[9 * 132]); w1.y = pk2(tp[10 * 132], tp[11 * 132]); w1.z = pk2(tp[12 * 132], tp[13 * 132]); w1.w = pk2(tp[14 * 132], tp[15 * 132]);
            bf16_t* dp = dst + (size_t)(n0d + tn * 128 + n) * ldd + k0d + k0 + kq * 16; *(u32x4*)dp = w0; *(u32x4*)(dp + 8) = w1; } }
        lds_barrier();
    }
#undef WC_LOAD
}
DI void zero_rect(bf16_t* dst, int ldd, int n0, int nn, int k0, int nk) {
    const int per = nk / 8, tot = nn * per;
    for (int i = obid() * 512 + otid(); i < tot; i += gridDim.x * 512) { const int n = i / per, c = i % per;
        *(u32x4*)(dst + (size_t)(n0 + n) * ldd + k0 + c * 8) = (u32x4){0u, 0u, 0u, 0u}; }
}
DI void prologue_weights(const Args& a, unsigned char* lds) {
    float* tl = (float*)lds; int base = 0;
    for (int l = 0; l < DEPTH; ++l) {
        unsigned char* wl = a.ws + WS_W + (size_t)l * WL_SIZE;
        bf16_t* win = (bf16_t*)(wl + WL_IN); const float* w_in = a.in[3] + (size_t)l * DM * INW;
        wconv_job(tl, w_in, INW, 0,    1024, 2048, win, DM, C_LRUX, 0, nullptr, base);
        wconv_job(tl, w_in, INW, 2464, 1024, 512,  win, DM, C_MLAG, 0, nullptr, base);
        wconv_job(tl, w_in, INW, 7584, 1024, 512,  win, DM, C_DILG, 0, nullptr, base);
        wconv_job(tl, w_in, INW, 2976, 1024, 4608, win, DM, C_DQ, 0, nullptr, base);
        wconv_job(tl, w_in, INW, 8096, 1024, 3072, win, DM, C_MERGE, 0, nullptr, base);
        wconv_job(tl, w_in, INW, 2048, 1024, 416,  win, DM, C_CQ, 0, nullptr, base);
        zero_rect(win, DM, INW, NZP - INW, 0, DM);
        bf16_t* wup = (bf16_t*)(wl + WL_UP);
        wconv_job(tl, a.in[14] + (size_t)l * 256 * 768, 768, 0, 256, 768, wup, KUP, 0, 0, a.in[12] + l * 256, base);
        wconv_job(tl, a.in[15] + (size_t)l * 128 * 1024, 1024, 0, 128, 1024, wup, KUP, 768, 256, a.in[13] + l * 128, base);
        zero_rect(wup, KUP, 0, 768, 256, 128); zero_rect(wup, KUP, 768, 1024, 0, 256);
        wconv_job(tl, a.in[11] + (size_t)l * DM * DM, DM, 0, 1024, 1024, (bf16_t*)(wl + WL_PCAT), 2048, 0, 0, nullptr, base);
        wconv_job(tl, a.in[18] + (size_t)l * 512 * DM, DM, 0, 512, 1024, (bf16_t*)(wl + WL_PCAT), 2048, 0, 1024, nullptr, base);
        wconv_job(tl, a.in[21] + (size_t)l * 512 * DM, DM, 0, 512, 1024, (bf16_t*)(wl + WL_PCAT), 2048, 0, 1536, nullptr, base);
        wconv_job(tl, a.in[23] + (size_t)l * DM * DM, DM, 0, 1024, 1024, (bf16_t*)(wl + WL_OUT), 1024, 0, 0, nullptr, base);
        for (int nb = 0; nb < 8; ++nb) {
            wconv_job(tl, a.in[6] + ((size_t)l * 8 + nb) * 128 * 128, 128, 0, 128, 128, (bf16_t*)(wl + WL_GX) + nb * 128 * 128, 128, 0, 0, nullptr, base);
            wconv_job(tl, a.in[8] + ((size_t)l * 8 + nb) * 128 * 128, 128, 0, 128, 128, (bf16_t*)(wl + WL_GA) + nb * 128 * 128, 128, 0, 0, nullptr, base);
        }
    }
}

DI void p0_rmsnorm(const float* __restrict__ x, const float* __restrict__ g, bf16_t* xn) {
    const int tid = otid(), lane = tid & 63, gw = obid() * 8 + (tid >> 6), nw = gridDim.x * 8;
    f32x4 gv[4];
#pragma unroll
    for (int i = 0; i < 4; ++i) gv[i] = *(const f32x4*)(g + i * 256 + lane * 4);
    for (int row = gw; row < TC; row += nw) {
        const float* xr = x + (size_t)row * DM; f32x4 v[4]; float ss = 0.f;
#pragma unroll
        for (int i = 0; i < 4; ++i) { v[i] = *(const f32x4*)(xr + i * 256 + lane * 4); ss += v[i][0] * v[i][0] + v[i][1] * v[i][1] + v[i][2] * v[i][2] + v[i][3] * v[i][3]; }
        ss = wave_sum(ss); const float rs = rsqrtf(ss * (1.f / DM) + EPS);
#pragma unroll
        for (int i = 0; i < 4; ++i) { u32x2 w; w.x = pk2(v[i][0] * rs * gv[i][0], v[i][1] * rs * gv[i][1]); w.y = pk2(v[i][2] * rs * gv[i][2], v[i][3] * rs * gv[i][3]);
            *(u32x2*)(xn + (size_t)row * DM + i * 256 + lane * 4) = w; }
    }
}

struct EpiZ {
    static constexpr bool PERM = true, AFTER_DRAIN = false, CHAIN = false;
    bf16_t* O; int ldc; int ncols;
    DI void operator()(const f32x4 (&acc)[2][2][4][2], const pg8::Unit& u, int wr, int wc, int fr, int fq) const {
        const int row0 = u.pm * 256 + wr * 64 + fr, col0 = u.pn * 256 + wc * 32 + 8 * fq;
#pragma unroll
        for (int ai = 0; ai < 2; ++ai)
#pragma unroll
            for (int m = 0; m < 4; ++m) { bf16_t* rowp = O + (size_t)(row0 + ai * 128 + m * 16) * ldc;
#pragma unroll
                for (int bj = 0; bj < 2; ++bj) { const int c = col0 + bj * 128; if (c < ncols) { const f32x4 v0 = acc[ai][bj][m][0], v1 = acc[ai][bj][m][1];
                    u32x4 w; w.x = pk2(v0[0], v0[1]); w.y = pk2(v0[2], v0[3]); w.z = pk2(v1[0], v1[1]); w.w = pk2(v1[2], v1[3]); *(u32x4*)(rowp + c) = w; } } }
    }
};
struct EpiChain {
    static constexpr bool PERM = true, AFTER_DRAIN = false, CHAIN = true; static constexpr int T1 = 16, T2 = 24;
    const bf16_t* Z; const float* bm; bf16_t* MB;
    template <bool FIN> DI void run(f32x4 (&acc)[2][2][4][2], const pg8::Unit& u, int br, int wr, int wc, int fr_, int fq_) const {
        int fr = fr_, fq = fq_; asm volatile("" : "+v"(fr), "+v"(fq));
        const int row0 = u.pm * 256 + wr * 64 + fr, col0 = u.pn * 256 + wc * 32 + 8 * fq;
        const float* bmb = bm + br * 1024; const bf16_t* zb = Z + C_MERGE + br * 1024;
#pragma unroll
        for (int bj = 0; bj < 2; ++bj)
#pragma unroll
            for (int n = 0; n < 2; ++n) { const int c = col0 + bj * 128 + 4 * n;
                f32x4 b = *(const f32x4*)(bmb + c) * (-LOG2E), d = b; if (!FIN) d = *(const f32x4*)(bmb + 1024 + c) * (-LOG2E);
                u32x2 gz[8], hz[8];
#pragma unroll
                for (int q = 0; q < 8; ++q) { const bf16_t* zp = zb + (size_t)(row0 + (q >> 2) * 128 + (q & 3) * 16) * LDZ + c; gz[q] = *(const u32x2*)zp; if (!FIN) hz[q] = *(const u32x2*)(zp + 1024); }
#pragma unroll
                for (int q = 0; q < 8; ++q) { const int ai = q >> 2, m = q & 3; const size_t row = (size_t)(row0 + ai * 128 + m * 16);
                    f32x4 sc;
                    sc[0] = __builtin_amdgcn_rcpf(1.f + __builtin_amdgcn_exp2f(bflo(gz[q].x) * (-LOG2E) + b[0])); sc[1] = __builtin_amdgcn_rcpf(1.f + __builtin_amdgcn_exp2f(bfhi(gz[q].x) * (-LOG2E) + b[1]));
                    sc[2] = __builtin_amdgcn_rcpf(1.f + __builtin_amdgcn_exp2f(bflo(gz[q].y) * (-LOG2E) + b[2])); sc[3] = __builtin_amdgcn_rcpf(1.f + __builtin_amdgcn_exp2f(bfhi(gz[q].y) * (-LOG2E) + b[3]));
                    if (!FIN) {
                        sc[0] *= 1.f + __builtin_amdgcn_exp2f(bflo(hz[q].x) * (-LOG2E) + d[0]); sc[1] *= 1.f + __builtin_amdgcn_exp2f(bfhi(hz[q].x) * (-LOG2E) + d[1]);
                        sc[2] *= 1.f + __builtin_amdgcn_exp2f(bflo(hz[q].y) * (-LOG2E) + d[2]); sc[3] *= 1.f + __builtin_amdgcn_exp2f(bfhi(hz[q].y) * (-LOG2E) + d[3]);
                        acc[ai][bj][m][n] *= sc; asm volatile("" : "+v"(acc[ai][bj][m][n]));
                    } else {
                        const f32x4 v = acc[ai][bj][m][n] * sc; u32x2 w; w.x = pk2(v[0], v[1]); w.y = pk2(v[2], v[3]); *(u32x2*)(MB + row * DM + c) = w; } }
                asm volatile("" ::: "memory"); }
    }
    DI void mid(f32x4 (&acc)[2][2][4][2], const pg8::Unit& u, int t, int wr, int wc, int fr, int fq) const { run<false>(acc, u, t == T1 ? 0 : 1, wr, wc, fr, fq); }
    DI void operator()(f32x4 (&acc)[2][2][4][2], const pg8::Unit& u, int wr, int wc, int fr, int fq) const { run<true>(acc, u, 2, wr, wc, fr, fq); }
};
struct EpiOut {
    static constexpr bool PERM = false, AFTER_DRAIN = false, CHAIN = false;
    const float* X; float* O;
    DI void operator()(const f32x4 (&acc)[2][2][4][2], const pg8::Unit& u, int wr, int wc, int fr, int fq) const {
        const int row0 = u.pm * 256 + wr * 64 + fr, col0 = u.pn * 256 + wc * 32 + 4 * fq;
#pragma unroll
        for (int ai = 0; ai < 2; ++ai)
#pragma unroll
            for (int mp = 0; mp < 2; ++mp) {
                f32x4 xv[2][2][2];
#pragma unroll
                for (int mm = 0; mm < 2; ++mm) { const size_t ro = (size_t)(row0 + ai * 128 + (mp * 2 + mm) * 16) * DM + col0;
#pragma unroll
                    for (int bj = 0; bj < 2; ++bj)
#pragma unroll
                        for (int n = 0; n < 2; ++n) xv[mm][bj][n] = *(const f32x4*)(X + ro + bj * 128 + n * 16); }
#pragma unroll
                for (int mm = 0; mm < 2; ++mm) { const size_t ro = (size_t)(row0 + ai * 128 + (mp * 2 + mm) * 16) * DM + col0;
#pragma unroll
                    for (int bj = 0; bj < 2; ++bj)
#pragma unroll
                        for (int n = 0; n < 2; ++n) *(f32x4*)(O + ro + bj * 128 + n * 16) = xv[mm][bj][n] + acc[ai][bj][mp * 2 + mm][n]; }
                asm volatile("" ::: "memory"); }
    }
};

#define UNPK8(W_, d, o, sc_) { const u32x4 w_ = (W_); d[o + 0] = bflo(w_.x) * (sc_); d[o + 1] = bfhi(w_.x) * (sc_); d[o + 2] = bflo(w_.y) * (sc_); d[o + 3] = bfhi(w_.y) * (sc_); d[o + 4] = bflo(w_.z) * (sc_); d[o + 5] = bfhi(w_.z) * (sc_); d[o + 6] = bflo(w_.w) * (sc_); d[o + 7] = bfhi(w_.w) * (sc_); }
DI void dil_prep(bf16_t* z, const int* __restrict__ pos, const float* __restrict__ gq, const float* __restrict__ gk) {
    const int tid = otid(), lane = tid & 63, gw = obid() * 8 + (tid >> 6), nw = gridDim.x * 8, j = lane & 7, hsub = lane >> 3;
    float inv[8], gqo[8], gqp[8], gko[8], gkp[8];
#pragma unroll
    for (int e = 0; e < 8; ++e) { inv[e] = __builtin_amdgcn_exp2f(-(float)(8 * (j & 3) + e) * (LOG2_THETA / 32.f));
        gqo[e] = gq[j * 8 + e]; gqp[e] = gq[(j ^ 4) * 8 + e]; gko[e] = gk[j * 8 + e]; gkp[e] = gk[(j ^ 4) * 8 + e]; }
    const float sgn = (j < 4) ? -1.f : 1.f;
    for (int wi0 = gw; wi0 < TC * 6; wi0 += 8 * nw) {
        u32x4 wv[8];
#pragma unroll
        for (int b = 0; b < 8; ++b) { const int wi = wi0 + b * nw; wv[b] = (u32x4){0u, 0u, 0u, 0u};
            if (wi < TC * 6) { const int tok = wi / 6, grp = wi - tok * 6; wv[b] = *(const u32x4*)(z + (size_t)tok * LDZ + (grp < 3 ? C_DQ + grp * 512 : C_DK + (grp - 3) * 512) + hsub * 64 + j * 8); } }
#pragma unroll
        for (int b = 0; b < 8; ++b) { const int wi = wi0 + b * nw; if (wi < TC * 6) {
            const int tok = wi / 6, grp = wi - tok * 6; const bool isq = grp < 3;
            bf16_t* p = z + (size_t)tok * LDZ + (isq ? C_DQ + grp * 512 : C_DK + (grp - 3) * 512) + hsub * 64 + j * 8;
            const u32x4 w = wv[b]; u32x4 q;
            q.x = __shfl_xor(w.x, 4); q.y = __shfl_xor(w.y, 4); q.z = __shfl_xor(w.z, 4); q.w = __shfl_xor(w.w, 4);
            float v[8], u[8]; UNPK8(w, v, 0, 1.f) UNPK8(q, u, 0, 1.f)
            float ss = 0.f;
#pragma unroll
            for (int e = 0; e < 8; ++e) ss += v[e] * v[e];
            ss += __shfl_xor(ss, 1); ss += __shfl_xor(ss, 2); ss += __shfl_xor(ss, 4);
            const float rs = rsqrtf(ss * (1.f / 64.f) + EPS) * (isq ? 0.125f * LOG2E : 1.f);
            const float fp = (float)pos[tok];
            float o[8];
#pragma unroll
            for (int e = 0; e < 8; ++e) { float sn, cs; sincos_rev(fp * inv[e], sn, cs);
                const float a = v[e] * rs * (isq ? gqo[e] : gko[e]), bb = u[e] * rs * (isq ? gqp[e] : gkp[e]); o[e] = a * cs + sgn * bb * sn; }
            u32x4 r; r.x = pk2(o[0], o[1]); r.y = pk2(o[2], o[3]); r.z = pk2(o[4], o[5]); r.w = pk2(o[6], o[7]);
            *(u32x4*)p = r; } }
    }
}

DI float ssq8(u32x4 w) { return bflo(w.x) * bflo(w.x) + bfhi(w.x) * bfhi(w.x) + bflo(w.y) * bflo(w.y) + bfhi(w.y) * bfhi(w.y) + bflo(w.z) * bflo(w.z) + bfhi(w.z) * bfhi(w.z) + bflo(w.w) * bflo(w.w) + bfhi(w.w) * bfhi(w.w); }
DI u32x4 scale8(u32x4 w, float s, const float* __restrict__ g) { u32x4 o; o.x = pk2(bflo(w.x) * s * g[0], bfhi(w.x) * s * g[1]); o.y = pk2(bflo(w.y) * s * g[2], bfhi(w.y) * s * g[3]);
    o.z = pk2(bflo(w.z) * s * g[4], bfhi(w.z) * s * g[5]); o.w = pk2(bflo(w.w) * s * g[6], bfhi(w.w) * s * g[7]); return o; }
DI void rope16(float (&v)[32], const float* __restrict__ g, float fp) {
#pragma unroll
    for (int i = 0; i < 16; ++i) { const float inv = exp2f(-(float)i * (LOG2_THETA / 16.f)); float sn, cs; sincos_rev(fp * inv, sn, cs);
        const float x1 = v[i] * g[i], x2 = v[16 + i] * g[16 + i]; v[i] = x1 * cs - x2 * sn; v[16 + i] = x2 * cs + x1 * sn; }
}
DI void mla_finalize(unsigned char* lds, const bf16_t* z, bf16_t* qf, bf16_t* kvr, bf16_t* kf, const int* __restrict__ pos, const float* __restrict__ gqn_g, const float* __restrict__ gkn_g) {
    float* rst = (float*)lds;
    float* gl = rst + 128; const float* gqn = gl; const float* gkn = gl + 96;
    for (int grp = obid(); grp < TC / 64; grp += gridDim.x) {
        const int tid = otid(), lane = tid & 63, wid = tid >> 6;
        const int t0 = grp * 64;
        const int tl_ = tid >> 3, hd = tid & 7, tok = t0 + tl_;
        bf16_t* pq = qf + (size_t)tok * LDQ + hd * 96; bf16_t* pkv = kvr + (size_t)tok * LDQ + hd * 128; const bf16_t* pkr = z + (size_t)tok * LDZ + C_KR; bf16_t* pk = kf + (size_t)tok * 768 + hd * 96;
        u32x4 rq[12];
#pragma unroll
        for (int c = 0; c < 12; ++c) rq[c] = *(const u32x4*)(pq + c * 8);
        const float fp = (float)pos[tok];
        if (tid < 192) gl[tid] = (tid < 96) ? gqn_g[tid] : gkn_g[tid - 96];
        u32x2 la[8]; unsigned lb[8];
#pragma unroll
        for (int i = 0; i < 8; ++i) { const bf16_t* zr = z + (size_t)(t0 + wid * 8 + i) * LDZ; la[i] = *(const u32x2*)(zr + C_CQ + lane * 4); lb[i] = *(const unsigned*)(zr + C_CKV + lane * 2); }
        __syncthreads();
#pragma unroll
        for (int i = 0; i < 8; ++i) {
            float s1 = bflo(la[i].x) * bflo(la[i].x) + bfhi(la[i].x) * bfhi(la[i].x) + bflo(la[i].y) * bflo(la[i].y) + bfhi(la[i].y) * bfhi(la[i].y), s2 = bflo(lb[i]) * bflo(lb[i]) + bfhi(lb[i]) * bfhi(lb[i]);
            s1 = wave_sum(s1); s2 = wave_sum(s2);
            if (lane == 0) { rst[(wid * 8 + i) * 2] = rsqrtf(s1 * (1.f / 256.f) + EPS); rst[(wid * 8 + i) * 2 + 1] = rsqrtf(s2 * (1.f / 128.f) + EPS); } }
        __syncthreads();
        const float rcq = rst[tl_ * 2], rckv = rst[tl_ * 2 + 1];
        {
            float ss = 0.f;
#pragma unroll
            for (int c = 0; c < 12; ++c) ss += ssq8(rq[c]);
            ss *= rcq * rcq;
            const float rs = rsqrtf(ss * (1.f / 96.f) + EPS) * rcq * (0.10206207261596575f * LOG2E);
#pragma unroll
            for (int c = 0; c < 8; ++c) *(u32x4*)(pq + c * 8) = scale8(rq[c], rs, gqn + c * 8);
            float v[32];
#pragma unroll
            for (int c = 0; c < 4; ++c) { UNPK8(rq[8 + c], v, c * 8, rs) }
            rope16(v, gqn + 64, fp);
#pragma unroll
            for (int c = 0; c < 4; ++c) { u32x4 w; w.x = pk2(v[c * 8 + 0], v[c * 8 + 1]); w.y = pk2(v[c * 8 + 2], v[c * 8 + 3]); w.z = pk2(v[c * 8 + 4], v[c * 8 + 5]); w.w = pk2(v[c * 8 + 6], v[c * 8 + 7]);
                *(u32x4*)(pq + 64 + c * 8) = w; }
        }
        asm volatile("" ::: "memory");
        {
            u32x4 rk[8], rv[8], rr[4];
#pragma unroll
            for (int c = 0; c < 8; ++c) { rk[c] = *(const u32x4*)(pkv + c * 8); rv[c] = *(const u32x4*)(pkv + 64 + c * 8); }
#pragma unroll
            for (int c = 0; c < 4; ++c) rr[c] = *(const u32x4*)(pkr + c * 8);
            float ss = 0.f, sr = 0.f;
#pragma unroll
            for (int c = 0; c < 8; ++c) ss += ssq8(rk[c]);
#pragma unroll
            for (int c = 0; c < 4; ++c) sr += ssq8(rr[c]);
            ss = ss * rckv * rckv + sr;
            const float rs = rsqrtf(ss * (1.f / 96.f) + EPS);
#pragma unroll
            for (int c = 0; c < 8; ++c) *(u32x4*)(pk + c * 8) = scale8(rk[c], rs * rckv, gkn + c * 8);
            float v[32];
#pragma unroll
            for (int c = 0; c < 4; ++c) { UNPK8(rr[c], v, c * 8, rs) }
            rope16(v, gkn + 64, fp);
#pragma unroll
            for (int c = 0; c < 4; ++c) { u32x4 w; w.x = pk2(v[c * 8 + 0], v[c * 8 + 1]); w.y = pk2(v[c * 8 + 2], v[c * 8 + 3]); w.z = pk2(v[c * 8 + 4], v[c * 8 + 5]); w.w = pk2(v[c * 8 + 6], v[c * 8 + 7]);
                *(u32x4*)(pk + 64 + c * 8) = w; }
#pragma unroll
            for (int c = 0; c < 8; ++c) { u32x4 w = rv[c];
                w.x = pk2(bflo(w.x) * rckv, bfhi(w.x) * rckv); w.y = pk2(bflo(w.y) * rckv, bfhi(w.y) * rckv); w.z = pk2(bflo(w.z) * rckv, bfhi(w.z) * rckv); w.w = pk2(bflo(w.w) * rckv, bfhi(w.w) * rckv);
                *(u32x4*)(pkv + 64 + c * 8) = w; }
        }
    }
}

DI void dil_combine(bf16_t* z, const float* __restrict__ lse) {
    const int tot = TC * 64, stride = gridDim.x * 512;
    for (int it0 = obid() * 512 + otid(); it0 < tot; it0 += 2 * stride) {
        u32x4 A[2], B[2], C[2], Gt[2]; float L0[2], L1[2], L2[2];
#pragma unroll
        for (int b = 0; b < 2; ++b) { const int it = it0 + b * stride; if (it < tot) { const int tok = it >> 6, hd = (it >> 3) & 7, dc = it & 7; const bf16_t* zr = z + (size_t)tok * LDZ;
            L0[b] = lse[(size_t)tok * 8 + hd]; L1[b] = lse[(size_t)TC * 8 + (size_t)tok * 8 + hd]; L2[b] = lse[(size_t)2 * TC * 8 + (size_t)tok * 8 + hd];
            A[b] = *(const u32x4*)(zr + C_DQ + (0 * 8 + hd) * 64 + dc * 8); B[b] = *(const u32x4*)(zr + C_DQ + (1 * 8 + hd) * 64 + dc * 8); C[b] = *(const u32x4*)(zr + C_DQ + (2 * 8 + hd) * 64 + dc * 8);
            Gt[b] = *(const u32x4*)(zr + C_DILG + hd * 64 + dc * 8); } }
#pragma unroll
        for (int b = 0; b < 2; ++b) { const int it = it0 + b * stride; if (it < tot) { const int tok = it >> 6, hd = (it >> 3) & 7, dc = it & 7;
            const float l0 = L0[b], l1 = L1[b], l2 = L2[b];
            const float mx = fmaxf(l0, fmaxf(l1, l2)); float w0 = fexp_(l0 - mx), w1 = fexp_(l1 - mx), w2 = fexp_(l2 - mx); const float iw = __builtin_amdgcn_rcpf(w0 + w1 + w2); w0 *= iw; w1 *= iw; w2 *= iw;
            const u32x4 a = A[b], bq = B[b], c = C[b], g = Gt[b]; u32x4 o;
#define CMB(F) { const float e0 = (w0 * bflo(a.F) + w1 * bflo(bq.F) + w2 * bflo(c.F)) * siluf_(bflo(g.F)), e1 = (w0 * bfhi(a.F) + w1 * bfhi(bq.F) + w2 * bfhi(c.F)) * siluf_(bfhi(g.F)); o.F = pk2(e0, e1); }
            CMB(x) CMB(y) CMB(z) CMB(w)
#undef CMB
            *(u32x4*)(z + (size_t)tok * LDZ + C_DILG + hd * 64 + dc * 8) = o; } }
    }
}

struct LruP { const float* conv_w; const float* conv_b; const float* b_gx; const float* b_ga; const float* lam; const bf16_t* wgx; const bf16_t* wga; };
constexpr int L_XS = 0, L_XCB = 18432, L_XC = L_XCB + 17408, L_HB = L_XC + 32768, L_CW = L_HB + 32768, L_EX = L_CW + 5 * 128 * 4, L_END = L_EX + 2 * 128 * 8;
static_assert(L_END <= LDS_BYTES, "lru lds");
template <bool FINAL> DI void lru_unit(unsigned char* lds, bf16_t* z, float* agg, const LruP& P, int bl, int n, int grp) {
    const int tid0 = otid();
    bf16_t* xs = (bf16_t*)(lds + L_XS); bf16_t* xcb = (bf16_t*)(lds + L_XCB); float* xc = (float*)(lds + L_XC); float* hb = (float*)(lds + L_HB);
    float* cw = (float*)(lds + L_CW); float2* ex = (float2*)(lds + L_EX);
    __syncthreads();
    const int tid = tid0, lane = tid & 63, wid = tid >> 6, r = lane & 31, h = lane >> 5, ct = wid & 3, rt = wid >> 2;
    for (int i = tid; i < 640; i += 512) cw[i] = (i < 512) ? P.conv_w[(i >> 7) * 1024 + n * 128 + (i & 127)] : P.conv_b[n * 128 + (i & 127)];
    bf16x8 bx[8], ba[8];
    { const bf16_t* wx = P.wgx + (size_t)n * 16384 + (size_t)(ct * 32 + r) * 128 + 8 * h; const bf16_t* wa = P.wga + (size_t)n * 16384 + (size_t)(ct * 32 + r) * 128 + 8 * h;
#pragma unroll
      for (int s = 0; s < 8; ++s) { bx[s] = *(const bf16x8*)(wx + 16 * s); ba[s] = *(const bf16x8*)(wa + 16 * s); } }
    const int ch = ct * 32 + r, chg = n * 128 + ch; const float bgx = P.b_gx[chg], bga = P.b_ga[chg]; const float sp = __logf(1.f + __expf(-P.lam[chg]));
    float hrun = 0.f, Arun = 1.f;
    if (FINAL) {
#pragma unroll
        for (int g2 = 0; g2 < 7; ++g2) if (g2 < grp) { const float2 ab = *(const float2*)(agg + ((size_t)(bl * 8 + g2) * 1024 + chg) * 2); hrun = ab.x * hrun + ab.y; } }
    const size_t rowb = (size_t)bl * SEQ;
    u32x4 xr[3], gr[2];
#define LRU_XLOAD(J) { _Pragma("unroll") for (int q = 0; q < 3; ++q) { const int c = tid + q * 512; const int i = c >> 4, cc = c & 15; const int p = (J) * 64 - 3 + i; \
        xr[q] = (u32x4){0u, 0u, 0u, 0u}; if (c < 67 * 16 && p >= 0) xr[q] = *(const u32x4*)(z + (rowb + p) * LDZ + C_LRUX + n * 128 + cc * 8); } }
#pragma unroll
    for (int s = 0; s < 8; ++s) asm volatile("" :: "v"(bx[s]), "v"(ba[s]));
    asm volatile("" :: "v"(bgx), "v"(bga), "v"(sp), "v"(hrun));
    LRU_XLOAD(grp * 8)
    __syncthreads();
#pragma unroll 1
    for (int jt = 0; jt < 8; ++jt) {
        int tq = tid0; asm volatile("" : "+v"(tq));
        const int tid = tq, lane = tid & 63, wid = tid >> 6, r = lane & 31, h = lane >> 5, ct = wid & 3, rt = wid >> 2, ch = ct * 32 + r;
        const int j = grp * 8 + jt; const size_t row0 = rowb + (size_t)j * 64;
#pragma unroll
        for (int q = 0; q < 3; ++q) { const int c = tid + q * 512; if (c < 67 * 16) *(u32x4*)(xs + (c >> 4) * 136 + (c & 15) * 8) = xr[q]; }
        lds_barrier();
        if (jt + 1 < 8) LRU_XLOAD(j + 1)
        if (FINAL) {
#pragma unroll
            for (int q = 0; q < 2; ++q) { const int c = tid + q * 512; gr[q] = *(const u32x4*)(z + (row0 + (c >> 4)) * LDZ + C_LRUG + n * 128 + (c & 15) * 8); } }
        {
            const int i = tid >> 3, c0 = (tid & 7) * 16; float acc[16];
#pragma unroll
            for (int q = 0; q < 4; ++q) { const f32x4 b = *(const f32x4*)(cw + 512 + c0 + q * 4); acc[q * 4] = b[0]; acc[q * 4 + 1] = b[1]; acc[q * 4 + 2] = b[2]; acc[q * 4 + 3] = b[3]; }
#pragma unroll
            for (int k = 0; k < 4; ++k) {
                const u32x4 xa = *(const u32x4*)(xs + (i + k) * 136 + c0), xb = *(const u32x4*)(xs + (i + k) * 136 + c0 + 8);
                const float xv[16] = {bflo(xa.x), bfhi(xa.x), bflo(xa.y), bfhi(xa.y), bflo(xa.z), bfhi(xa.z), bflo(xa.w), bfhi(xa.w), bflo(xb.x), bfhi(xb.x), bflo(xb.y), bfhi(xb.y), bflo(xb.z), bfhi(xb.z), bflo(xb.w), bfhi(xb.w)};
#pragma unroll
                for (int q = 0; q < 4; ++q) { const f32x4 w = *(const f32x4*)(cw + k * 128 + c0 + q * 4);
                    acc[q * 4] += w[0] * xv[q * 4]; acc[q * 4 + 1] += w[1] * xv[q * 4 + 1]; acc[q * 4 + 2] += w[2] * xv[q * 4 + 2]; acc[q * 4 + 3] += w[3] * xv[q * 4 + 3]; } }
#pragma unroll
            for (int q = 0; q < 4; ++q) *(f32x4*)(xc + i * 128 + c0 + q * 4) = (f32x4){acc[q * 4], acc[q * 4 + 1], acc[q * 4 + 2], acc[q * 4 + 3]};
            u32x4 w0, w1; w0.x = pk2(acc[0], acc[1]); w0.y = pk2(acc[2], acc[3]); w0.z = pk2(acc[4], acc[5]); w0.w = pk2(acc[6], acc[7]);
            w1.x = pk2(acc[8], acc[9]); w1.y = pk2(acc[10], acc[11]); w1.z = pk2(acc[12], acc[13]); w1.w = pk2(acc[14], acc[15]);
            *(u32x4*)(xcb + i * 136 + c0) = w0; *(u32x4*)(xcb + i * 136 + c0 + 8) = w1;
        }
        lds_barrier();
        float av[16], bv[16], Ao[4], Ho[4], Ap[4], Hp[4];
        {
            f32x16 gx, ga;
#pragma unroll
            for (int i = 0; i < 16; ++i) { gx[i] = 0.f; ga[i] = 0.f; }
#pragma unroll
            for (int s = 0; s < 8; ++s) { const bf16x8 a = *(const bf16x8*)(xcb + (rt * 32 + r) * 136 + 16 * s + 8 * h); gx = MFMA32(a, bx[s], gx); ga = MFMA32(a, ba[s], ga); }
#pragma unroll
            for (int i = 0; i < 16; ++i) { const int tk = rt * 32 + crow(i, h);
                const float vgx = sigmoidf_(gx[i] + bgx), vga = sigmoidf_(ga[i] + bga); const float la = -8.f * vga * sp; av[i] = fexp_(la);
                const float mult = __builtin_amdgcn_sqrtf(fmaxf(1.f - av[i] * av[i], 0.f));
                bv[i] = mult * vgx * xc[tk * 128 + ch]; }
        }
#pragma unroll
        for (int g = 0; g < 4; ++g) { float H = 0.f, A = 1.f;
#pragma unroll
            for (int k = 0; k < 4; ++k) { H = av[4 * g + k] * H + bv[4 * g + k]; A *= av[4 * g + k]; }
            Ao[g] = A; Ho[g] = H; Ap[g] = __shfl_xor(A, 32); Hp[g] = __shfl_xor(H, 32); }
        {   float c = 0.f, At = 1.f;
#pragma unroll
            for (int g = 0; g < 4; ++g) { const float A1 = h ? Ap[g] : Ao[g], H1 = h ? Hp[g] : Ho[g], A2 = h ? Ao[g] : Ap[g], H2 = h ? Ho[g] : Hp[g]; c = A1 * c + H1; c = A2 * c + H2; At *= A1 * A2; }
            if (h == 0) ex[rt * 128 + ch] = make_float2(At, c); }
        lds_barrier();
        {   const float2 e0 = ex[ch], e1 = ex[128 + ch]; const float hmid = e0.x * hrun + e0.y;
            float c = rt ? hmid : hrun;
            hrun = e1.x * hmid + e1.y; Arun *= e0.x * e1.x;
            if (FINAL) {
#pragma unroll
                for (int g = 0; g < 4; ++g) { const float A1 = h ? Ap[g] : Ao[g], H1 = h ? Hp[g] : Ho[g], A2 = h ? Ao[g] : Ap[g], H2 = h ? Ho[g] : Hp[g];
                    const float c1 = A1 * c + H1; float hh = h ? c1 : c; c = A2 * c1 + H2;
#pragma unroll
                    for (int k = 0; k < 4; ++k) { hh = av[4 * g + k] * hh + bv[4 * g + k]; hb[(rt * 32 + 8 * g + 4 * h + k) * 128 + ch] = hh; } } } }
        if (FINAL) {
            lds_barrier();
#pragma unroll
            for (int q = 0; q < 2; ++q) { const int c = tid + q * 512; const int i = c >> 4, cc = c & 15; bf16_t* gp = z + (row0 + i) * LDZ + C_LRUG + n * 128 + cc * 8; const u32x4 g = gr[q];
                const f32x4 h0 = *(const f32x4*)(hb + i * 128 + cc * 8), h1 = *(const f32x4*)(hb + i * 128 + cc * 8 + 4); u32x4 o;
                o.x = pk2(h0[0] * siluf_(bflo(g.x)), h0[1] * siluf_(bfhi(g.x))); o.y = pk2(h0[2] * siluf_(bflo(g.y)), h0[3] * siluf_(bfhi(g.y)));
                o.z = pk2(h1[0] * siluf_(bflo(g.z)), h1[1] * siluf_(bfhi(g.z))); o.w = pk2(h1[2] * siluf_(bflo(g.w)), h1[3] * siluf_(bfhi(g.w))); *(u32x4*)gp = o; }
        }
    }
#undef LRU_XLOAD
    if (!FINAL && h == 0 && rt == 0) *(float2*)(agg + ((size_t)(bl * 8 + grp) * 1024 + chg) * 2) = make_float2(Arun, hrun);
}

typedef short s16x4 __attribute__((ext_vector_type(4)));
DI s16x4 vtr(const bf16_t* p) { return __builtin_amdgcn_ds_read_tr16_b64_v4i16((__attribute__((address_space(3))) s16x4*)p); }
template <int DK, bool WIN, bool MLA>
DI void attn_unit(unsigned char* lds, const bf16_t* Qb, size_t qs, const bf16_t* Kb, size_t ks, const bf16_t* Vb, size_t vs, int q0, bf16_t* Ob, size_t os, float* lsep, size_t lses, const float CS) {
    constexpr int KLD = DK + 8, VLD = 96, KC = DK / 8, NKR = (128 * KC) / 512, KBYTES = 128 * KLD * 2, BUFB = KBYTES + 128 * VLD * 2;
    static_assert((128 * KC) % 512 == 0 && 2 * BUFB <= LDS_BYTES, "attention staging");
    const int tid = otid(), lane = tid & 63, wid = tid >> 6, r = lane & 31, h = lane >> 5;
    const int qw = q0 + 32 * wid;
    bf16x8 qf[DK / 16];
    { const bf16_t* qrow = Qb + (size_t)(qw + r) * qs + 8 * h;
#pragma unroll
      for (int s = 0; s < DK / 16; ++s) qf[s] = *(const bf16x8*)(qrow + 16 * s); }
    f32x16 o[2];
#pragma unroll
    for (int i = 0; i < 16; ++i) { o[0][i] = 0.f; o[1][i] = 0.f; }
    float lrow = 0.f;
    const int kt_lo = WIN ? (q0 >= 128 ? (q0 - 128) / 128 : 0) : 0, kt_hi = (q0 + 255) / 128, ntile = kt_hi - kt_lo + 1;
    const int kfrag = r * KLD + 8 * h, vfrag = (4 * h + ((lane & 15) >> 2)) * VLD + 16 * ((lane >> 4) & 1) + 4 * (lane & 3);
    u32x4 kreg[NKR], vreg[2];
#define ATT_GLOAD(KT) { const size_t kb = (size_t)(KT) * 128; \
        _Pragma("unroll") for (int q_ = 0; q_ < NKR; ++q_) { const int c_ = tid + q_ * 512; kreg[q_] = *(const u32x4*)(Kb + (kb + c_ / KC) * ks + (c_ % KC) * 8); } \
        _Pragma("unroll") for (int q_ = 0; q_ < 2; ++q_) { const int c_ = tid + q_ * 512; vreg[q_] = *(const u32x4*)(Vb + (kb + (c_ >> 3)) * vs + (c_ & 7) * 8); } }
#define ATT_LWRITE(SLOT) { bf16_t* kp_ = (bf16_t*)(lds + (SLOT) * BUFB); bf16_t* vp_ = (bf16_t*)(lds + (SLOT) * BUFB + KBYTES); \
        _Pragma("unroll") for (int q_ = 0; q_ < NKR; ++q_) { const int c_ = tid + q_ * 512; *(u32x4*)(kp_ + (c_ / KC) * KLD + (c_ % KC) * 8) = kreg[q_]; } \
        _Pragma("unroll") for (int q_ = 0; q_ < 2; ++q_) { const int c_ = tid + q_ * 512; *(u32x4*)(vp_ + (c_ >> 3) * VLD + (c_ & 7) * 8) = vreg[q_]; } }
    ATT_GLOAD(kt_lo)
#pragma unroll
    for (int s = 0; s < DK / 16; ++s) asm volatile("" :: "v"(qf[s]));
    __syncthreads();
    ATT_LWRITE(0)
    if (ntile > 1) ATT_GLOAD(kt_lo + 1)
#pragma unroll 1
    for (int it = 0; it < ntile; ++it) {
        const int kbase = (kt_lo + it) * 128;
        lds_barrier();
        if (it + 1 < ntile) { ATT_LWRITE((it + 1) & 1) if (it + 2 < ntile) ATT_GLOAD(kt_lo + it + 2) }
        const bf16_t* Ks = (const bf16_t*)(lds + (it & 1) * BUFB) + kfrag; const bf16_t* Vs = (const bf16_t*)(lds + (it & 1) * BUFB + KBYTES) + vfrag;
        const int qi = qw + r;
#pragma unroll
        for (int hp = 0; hp < 2; ++hp) {
            const int kb = kbase + 64 * hp;
            const bool active = (kb <= qw + 31) && (!WIN || kb + 63 >= qw - 128);
            if (active) {
                f32x16 x[2];
#pragma unroll
                for (int i = 0; i < 16; ++i) { x[0][i] = -CS; x[1][i] = -CS; }
#pragma unroll
                for (int s = 0; s < DK / 16; ++s) { const bf16x8 a0 = *(const bf16x8*)(Ks + (hp * 64) * KLD + 16 * s), a1 = *(const bf16x8*)(Ks + (hp * 64 + 32) * KLD + 16 * s);
                    x[0] = MFMA32(a0, qf[s], x[0]); x[1] = MFMA32(a1, qf[s], x[1]); }
                const bool need_mask = (kb + 63 > qw) || (WIN && kb < qw + 31 - 128);
                if (need_mask) {
#pragma unroll
                    for (int kt2 = 0; kt2 < 2; ++kt2)
#pragma unroll
                        for (int i = 0; i < 16; ++i) { const int key = kb + kt2 * 32 + crow(i, h); const bool ok = (key <= qi) && (!WIN || key >= qi - 128); x[kt2][i] = ok ? x[kt2][i] : -INFINITY; } }
#pragma unroll
                for (int kt2 = 0; kt2 < 2; ++kt2)
#pragma unroll
                    for (int i = 0; i < 16; ++i) { const float p = __builtin_amdgcn_exp2f(x[kt2][i]); x[kt2][i] = p; lrow += p; }
#pragma unroll
                for (int kt2 = 0; kt2 < 2; ++kt2)
#pragma unroll
                    for (int s = 0; s < 2; ++s) {
                        u32x4 pw; pw.x = pk2(x[kt2][8 * s + 0], x[kt2][8 * s + 1]); pw.y = pk2(x[kt2][8 * s + 2], x[kt2][8 * s + 3]); pw.z = pk2(x[kt2][8 * s + 4], x[kt2][8 * s + 5]); pw.w = pk2(x[kt2][8 * s + 6], x[kt2][8 * s + 7]);
                        const bf16x8 pb = __builtin_bit_cast(bf16x8, pw);
#pragma unroll
                        for (int n = 0; n < 2; ++n) { const bf16_t* vp = Vs + (hp * 64 + kt2 * 32 + 16 * s) * VLD + 32 * n;
                            const s16x4 lo = vtr(vp), hi = vtr(vp + 8 * VLD);
                            const bf16x8 av = __builtin_shufflevector(lo, hi, 0, 1, 2, 3, 4, 5, 6, 7);
                            o[n] = MFMA32(av, pb, o[n]); } }
            }
        }
    }
#undef ATT_GLOAD
#undef ATT_LWRITE
    lrow += __shfl_xor(lrow, 32);
    const float inv = __builtin_amdgcn_rcpf(lrow); const size_t orow = (size_t)(qw + r) * os;
    u32x2 gv[2][4];
    if (MLA) {
#pragma unroll
        for (int n = 0; n < 2; ++n)
#pragma unroll
            for (int g4 = 0; g4 < 4; ++g4) gv[n][g4] = *(const u32x2*)(Ob + orow + n * 32 + g4 * 8 + 4 * h); }
#pragma unroll
    for (int n = 0; n < 2; ++n)
#pragma unroll
        for (int g4 = 0; g4 < 4; ++g4) { const int dv = n * 32 + g4 * 8 + 4 * h; bf16_t* op = Ob + orow + dv;
            float e0 = o[n][g4 * 4] * inv, e1 = o[n][g4 * 4 + 1] * inv, e2 = o[n][g4 * 4 + 2] * inv, e3 = o[n][g4 * 4 + 3] * inv;
            if (MLA) { const u32x2 g = gv[n][g4]; e0 *= siluf_(bflo(g.x)); e1 *= siluf_(bfhi(g.x)); e2 *= siluf_(bflo(g.y)); e3 *= siluf_(bfhi(g.y)); }
            u32x2 w; w.x = pk2(e0, e1); w.y = pk2(e2, e3); *(u32x2*)op = w; }
    if (!MLA) { if (h == 0) lsep[(size_t)(qw + r) * lses] = (CS + __log2f(lrow)) * LN2; }
}

DI void gsync(unsigned* ctr, unsigned& target) {
    asm volatile("s_waitcnt vmcnt(0)" ::: "memory");
    __syncthreads();
    target += gridDim.x;
    if (threadIdx.x == 0) {
        __builtin_amdgcn_fence(__ATOMIC_RELEASE, "agent");
        asm volatile("s_waitcnt vmcnt(0)" ::: "memory");
        (void)__hip_atomic_fetch_add(ctr, 1u, __ATOMIC_RELAXED, __HIP_MEMORY_SCOPE_AGENT);
        while (__hip_atomic_load(ctr, __ATOMIC_RELAXED, __HIP_MEMORY_SCOPE_AGENT) < target) __builtin_amdgcn_s_sleep(48);
        __builtin_amdgcn_fence(__ATOMIC_ACQUIRE, "agent");
        asm volatile("s_waitcnt vmcnt(0)" ::: "memory");
    }
    __syncthreads();
}

DI void panel_signal(unsigned* cnt) {
    if (threadIdx.x == 0) { __builtin_amdgcn_fence(__ATOMIC_RELEASE, "agent"); asm volatile("s_waitcnt vmcnt(0)" ::: "memory");
        (void)__hip_atomic_fetch_add(cnt, 1u, __ATOMIC_RELAXED, __HIP_MEMORY_SCOPE_AGENT); }
}
DI void panel_wait(unsigned* cnt, unsigned target) {
    if (threadIdx.x == 0) { while (__hip_atomic_load(cnt, __ATOMIC_RELAXED, __HIP_MEMORY_SCOPE_AGENT) < target) __builtin_amdgcn_s_sleep(24);
        __builtin_amdgcn_fence(__ATOMIC_ACQUIRE, "agent"); asm volatile("s_waitcnt vmcnt(0)" ::: "memory"); }
    __syncthreads();
}

__global__ void __launch_bounds__(512, 2) hybrid_fwd(Args a) {
    extern __shared__ __attribute__((aligned(16))) unsigned char lds_raw[];
    cg::grid_group grid = cg::this_grid();
    unsigned char* lds = lds_raw; PG8_LAS unsigned char* ldsl = (PG8_LAS unsigned char*)lds_raw;
    const int G = gridDim.x;
#define bx obid()
    unsigned char* ws = a.ws;
    bf16_t* z = (bf16_t*)(ws + WS_Z); unsigned char* sc = ws + WS_S;
    bf16_t* xn = (bf16_t*)(sc + S_XN); bf16_t* qf = (bf16_t*)(sc + S_QF); bf16_t* kvr = qf + 768; bf16_t* kf = (bf16_t*)(sc + S_KF);
    float* agg = (float*)(sc + S_AGG); float* lse = (float*)(sc + S_LSE); float* mrg = (float*)(sc + S_MRG); bf16_t* mb = (bf16_t*)(sc + S_MB);
    const int* positions = (const int*)a.in[1];

    unsigned* gctr = (unsigned*)(ws + WS_CTL); unsigned gtarget = 0;
    if (blockIdx.x == 0 && threadIdx.x < 129) __hip_atomic_store(gctr + 64 * threadIdx.x, 0u, __ATOMIC_RELAXED, __HIP_MEMORY_SCOPE_AGENT);
    unsigned* cntA = gctr + 64; unsigned* cntB = gctr + 64 * 65; const bool fullgrid = (G == 256);
    unsigned long long tacc = 0, tprev = 0; if (PROBE_K >= 0) tprev = __builtin_amdgcn_s_memrealtime();
    prologue_weights(a, lds);
    if (PROBE_K == 0) { grid.sync(); PSTAMP(0); }
#pragma unroll 1
    for (int l = 0; l < DEPTH; ++l) {
#pragma unroll 1
        for (int c = 0; c < NCHUNK; ++c) {
            int lo = l; asm volatile("" : "+s"(lo));
            const unsigned char* wl = ws + WS_W + (size_t)lo * WL_SIZE;
            const size_t roff = (size_t)c * TC;
            const float* xin = (l == 0 ? a.in[0] : a.out) + roff * DM; float* xout = a.out + roff * DM; const int* pos = positions + roff;
            p0_rmsnorm(xin, a.in[2] + lo * DM, xn);
            if (l == 0 && c == 0) grid.sync(); else gsync(gctr, gtarget);
            PSTAMP(1);
            { pg8::Gemm g; g.A = xn; g.Bt = (const bf16_t*)(wl + WL_IN); g.M = TC; g.N = NZP; g.K = DM; g.lda = DM;
              pg8::StaticOrder S; S.init(TC, NZP, G, bx); EpiZ E; E.O = z; E.ldc = LDZ; E.ncols = INW;
              pg8::gemm_phase<EpiZ, pg8::StaticOrder, true, true>(ldsl, g, S, E); }
            gsync(gctr, gtarget); PSTAMP(2);
            { pg8::Gemm g; g.A = z + C_CQ; g.Bt = (const bf16_t*)(wl + WL_UP); g.M = TC; g.N = NUP; g.K = KUP; g.lda = LDZ;
              pg8::StaticOrder S; S.init(TC, NUP, G, bx); EpiZ E; E.O = qf; E.ldc = LDQ; E.ncols = NUP;
              pg8::gemm_phase<EpiZ, pg8::StaticOrder, true, true>(ldsl, g, S, E);
              if (fullgrid) { pg8::Unit uu; for (int i = 0; S.next(i, uu); ++i) if (uu.pn >= 0) panel_signal(cntB + 64 * uu.pm); } }
            __syncthreads();
            LruP lp; lp.conv_w = a.in[4] + (size_t)lo * 4 * 1024; lp.conv_b = a.in[5] + lo * 1024; lp.b_gx = a.in[7] + lo * 1024; lp.b_ga = a.in[9] + lo * 1024; lp.lam = a.in[10] + lo * 1024;
            lp.wgx = (const bf16_t*)(wl + WL_GX); lp.wga = (const bf16_t*)(wl + WL_GA);
#pragma unroll 1
            for (int k3 = 0; k3 < 3; ++k3) {
                int stg = (k3 + bx % 3) % 3; asm volatile("" : "+s"(stg));
                if (stg == 0) dil_prep(z, pos, a.in[19] + lo * 64, a.in[20] + lo * 64);
                else if (stg == 1) { for (int u = bx; u < NB * 64; u += G) lru_unit<false>(lds, z, agg, lp, u >> 6, (u >> 3) & 7, u & 7); }
                else {
                    if (fullgrid) panel_wait(cntB + 64 * (bx >> 2), 7u * (unsigned)(l * NCHUNK + c + 1)); else gsync(gctr, gtarget);
                    mla_finalize(lds, z, qf, kvr, kf, pos, a.in[16] + lo * 96, a.in[17] + lo * 96); }
                __syncthreads();
            }
            PSTAMP(3);
            gsync(gctr, gtarget); PSTAMP(4);
            float cs_mla, cs_dil;
            { float mq = 0.f, mk = 0.f, dq_ = 0.f, dk_ = 0.f; const float* g1 = a.in[16] + lo * 96; const float* g2 = a.in[17] + lo * 96; const float* g3 = a.in[19] + lo * 64; const float* g4 = a.in[20] + lo * 64;
              for (int i = 0; i < 96; ++i) { mq = fmaxf(mq, fabsf(g1[i])); mk = fmaxf(mk, fabsf(g2[i])); }
              for (int i = 0; i < 64; ++i) { dq_ = fmaxf(dq_, fabsf(g3[i])); dk_ = fmaxf(dk_, fabsf(g4[i])); }
              cs_mla = 96.f * 0.10206207261596575f * LOG2E * mq * mk; cs_dil = 64.f * 0.125f * LOG2E * dq_ * dk_; }
            const int nrnd = (512 + NB * 384 + G - 1) / G, rot = (bx & 1) ? 2 : 0;
#pragma unroll 1
            for (int k8 = 0; k8 < nrnd; ++k8) {
                const int u = bx + G * ((k8 + rot) % nrnd); if (u >= 512 + NB * 384) continue;
                if (u < 512) {
                    int qb, bh; if (u < 256) { qb = 15 - (u >> 5); bh = u & 31; } else { qb = (u - 256) >> 5; bh = (u - 256) & 31; }
                    const int bl = bh >> 3, hd = bh & 7; const size_t t0 = (size_t)bl * SEQ;
                    attn_unit<96, false, true>(lds, qf + t0 * LDQ + hd * 96, LDQ, kf + t0 * 768 + hd * 96, 768, kvr + t0 * LDQ + hd * 128 + 64, LDQ, qb * 256,
                                               z + t0 * LDZ + C_MLAG + hd * 64, LDZ, nullptr, 0, cs_mla);
                } else {
                    const int v = u - 512, bl = v / 384, w = v % 384, gi = w >> 7, w2 = w & 127, hd = w2 >> 4, rem = w2 & 15;
                    const int d = 1 << (2 * gi), npairs = 16 >> (2 * gi), r = rem / npairs, pair = rem % npairs, head = gi * 8 + hd;
                    const size_t brow = (size_t)bl * SEQ + r; bf16_t* zb = z + brow * LDZ + head * 64; const size_t st = (size_t)d * LDZ;
                    attn_unit<64, true, false>(lds, zb + C_DQ, st, zb + C_DK, st, zb + C_DV, st, pair * 256, zb + C_DQ, st, lse + (size_t)gi * TC * 8 + brow * 8 + hd, (size_t)d * 8, cs_dil);
                }
            }
            gsync(gctr, gtarget); PSTAMP(5);
            dil_combine(z, lse);
            for (int u = bx; u < NB * 64; u += G) lru_unit<true>(lds, z, agg, lp, u >> 6, (u >> 3) & 7, u & 7);
            gsync(gctr, gtarget); PSTAMP(6);
            { pg8::Gemm g; g.A = z + C_LRUG; g.Bt = (const bf16_t*)(wl + WL_PCAT); g.M = TC; g.N = DM; g.K = 2048; g.lda = LDZ;
              pg8::StaticOrder S; S.init(TC, DM, G, bx); EpiChain E; E.Z = z; E.bm = a.in[22] + (size_t)lo * 3072; E.MB = mb;
              pg8::gemm_phase<EpiChain, pg8::StaticOrder, true, true>(ldsl, g, S, E);
              if (fullgrid) { pg8::Unit uu; S.next(0, uu); panel_signal(cntA + 64 * uu.pm); panel_wait(cntA + 64 * uu.pm, 4u * (unsigned)(l * NCHUNK + c + 1)); } }
            if (!fullgrid) gsync(gctr, gtarget);
            PSTAMP(7);
            { pg8::Gemm g; g.A = mb; g.Bt = (const bf16_t*)(wl + WL_OUT); g.M = TC; g.N = DM; g.K = DM; g.lda = DM;
              pg8::StaticOrder S; S.init(TC, DM, G, bx); EpiOut E; E.X = xin; E.O = xout;
              pg8::gemm_phase<EpiOut, pg8::StaticOrder, true, true>(ldsl, g, S, E); }
            __syncthreads();
            if (PROBE_K == 8) { grid.sync(); PSTAMP(8); }
        }
    }
    if (PROBE_K >= 0 && blockIdx.x == 0 && threadIdx.x == 0) { const unsigned long long t0 = __builtin_amdgcn_s_memrealtime(); while (__builtin_amdgcn_s_memrealtime() - t0 < tacc) __builtin_amdgcn_s_sleep(8); }
}

extern "C" void kernel_launch(void* const* d_in, const int* in_sizes, int n_in, void* d_out, int out_size, void* d_ws, size_t ws_size, hipStream_t stream) {
    static int grid_blocks = 0;
    if (!grid_blocks) {
        int dev = 0, cus = 0, per_cu = 0;
        (void)hipGetDevice(&dev);
        (void)hipDeviceGetAttribute(&cus, hipDeviceAttributeMultiprocessorCount, dev);
        if (hipFuncSetAttribute((const void*)hybrid_fwd, hipFuncAttributeMaxDynamicSharedMemorySize, LDS_BYTES) != hipSuccess) fprintf(stderr, "hipFuncSetAttribute failed\n");
        if (hipOccupancyMaxActiveBlocksPerMultiprocessor(&per_cu, (const void*)hybrid_fwd, 512, LDS_BYTES) != hipSuccess || per_cu < 1) per_cu = 1;
        grid_blocks = cus * 1;
        if (ws_size < WS_NEED) fprintf(stderr, "workspace too small: %zu < %zu\n", ws_size, (size_t)WS_NEED);
    }
    if (ws_size < WS_NEED || n_in < 24) return;
    Args a{};
    for (int i = 0; i < 24; ++i) a.in[i] = (const float*)d_in[i];
    a.out = (float*)d_out; a.ws = (unsigned char*)d_ws;
    void* args[] = {&a};
    hipError_t e = hipLaunchCooperativeKernel((const void*)hybrid_fwd, dim3(grid_blocks), dim3(512), args, LDS_BYTES, stream);
    if (e != hipSuccess) fprintf(stderr, "cooperative launch failed: %s (grid %d)\n", hipGetErrorString(e), grid_blocks);
}
```

```cpp
#include <hip/hip_runtime.h>
#include <hip/hip_cooperative_groups.h>
#include <cstdio>
#include <cstdint>
namespace cg = cooperative_groups;
__device__ __forceinline__ int otid() { int t = threadIdx.x; asm volatile("" : "+v"(t)); return t; }
__device__ __forceinline__ int obid() { int b = blockIdx.x; asm volatile("" : "+s"(b)); return b; }
namespace pg8 {
#define PG8_LAS __attribute__((address_space(3)))
typedef unsigned short bf16_t;
typedef short bf16x8 __attribute__((ext_vector_type(8)));
typedef float f32x4 __attribute__((ext_vector_type(4)));
typedef unsigned u32x4 __attribute__((ext_vector_type(4)));
constexpr int BM = 256, BK = 64, HALF = 128, HTB = HALF * BK * 2  , STAGE_BYTES = 8 * HTB, NXCD = 8, WGM = 8;

__host__ __device__ __forceinline__ int lds_byte(int r, int c) { const int st = (r >> 4) * 2 + (c >> 5), rr = r & 15, cc = c & 31, ob = rr * 64 + cc * 2; return st * 1024 + (ob ^ (((ob >> 9) & 1) << 5)); }
__host__ __device__ __forceinline__ void stage_rc(int b, int& R, int& C) { const int st = b / 1024, sb = b % 1024, swz = sb ^ (((sb >> 9) & 1) << 5); R = (st >> 1) * 16 + swz / 64; C = (st & 1) * 32 + (swz % 64) / 2; }
__host__ __device__ __forceinline__ int perm32(int rho) { const int n = rho >> 4, i = rho & 15; return 8 * (i >> 2) + 4 * n + (i & 3); }

struct Unit { int pm, pn; };
struct Gemm { const bf16_t* A; const bf16_t* Bt; int M, N, K, lda; };

struct StaticOrder {
    int nM, nN, nwg, G, c;
    __host__ __device__ void init(int M, int N, int G_, int c_) { nM = M / BM; nN = N / BM; nwg = nM * nN; G = G_; c = c_; }
    __host__ __device__ bool next(int i, Unit& u) const {
        const long L = (long)i * G + c; if (L >= nwg) return false;
        int wgid = (int)L; { const int q = nwg / NXCD, r = nwg % NXCD, xcd = wgid % NXCD, off = wgid / NXCD; wgid = (xcd < r ? xcd * (q + 1) : r * (q + 1) + (xcd - r) * q) + off; }
        const int nig = WGM * nN, gid = wgid / nig, fm = gid * WGM, gsz = (nM - fm) < WGM ? (nM - fm) : WGM;
        u.pm = fm + ((wgid % nig) % gsz); u.pn = (wgid % nig) / gsz; return true;
    }
    __device__ __forceinline__ void a_ready(const Unit&) const {}
    __device__ __forceinline__ void done(const Unit&) const {}
};
__device__ __forceinline__ unsigned cvt_pk_bf16(float lo, float hi) { unsigned r; asm volatile("v_cvt_pk_bf16_f32 %0, %1, %2" : "=v"(r) : "v"(lo), "v"(hi)); return r; }
template <class Epi, class Sched, bool ALIGN_EPI = false, bool SP2 = false>
__device__ __forceinline__ void gemm_body(PG8_LAS unsigned char* lds, const Gemm g, const Sched& S, const Epi& E, f32x4 (&acc)[2][2][4][2], const bool zero_init) {
    const int tid = otid(), wid = __builtin_amdgcn_readfirstlane(tid >> 6), lane = tid & 63, wr = wid >> 2, wc = wid & 3, fr = lane & 15, fq = lane >> 4;
    const int K = g.K, nt = K / BK;
    unsigned voffA[2], voffB[2];
#pragma unroll
    for (int i = 0; i < 2; ++i) { int R, C; stage_rc(tid * 16 + i * 8192, R, C); const int Rb = Epi::PERM ? ((R & ~31) + perm32(R & 31)) : R;
        voffA[i] = (unsigned)(R * g.lda + C) * 2u; voffB[i] = (unsigned)(Rb * K + C) * 2u; }
    const size_t kstep = (size_t)(BK * 2);
    const size_t hstepA = (size_t)HALF * g.lda * 2, hstepB = (size_t)HALF * K * 2;
    const size_t tstepA = 2 * hstepA, tstepB = 2 * hstepB;
    const unsigned ldsw = (unsigned)wid * 1024u;
    const int aoff = lds_byte(wr * 64 + fr, fq * 8), boff = lds_byte(wc * 32 + fr, fq * 8);
#define PG8_SA(b, h) (((b) * 2 + (h)) * HTB)
#define PG8_SB(b, h) ((4 + (b) * 2 + (h)) * HTB)
#define PG8_STAGE(bufoff, gbase, voff) do { _Pragma("unroll") for (int _i = 0; _i < 2; ++_i) \
        __builtin_amdgcn_global_load_lds((const unsigned*)((const char*)(gbase) + (voff)[_i]), (PG8_LAS unsigned*)(lds + (bufoff) + ldsw + _i * 8192), 16, 0, 0); } while (0)
#define PG8_LDA(dst, b, h) do { _Pragma("unroll") for (int m = 0; m < 4; ++m) _Pragma("unroll") for (int k = 0; k < 2; ++k) dst[m][k] = *(const PG8_LAS bf16x8*)(lds + PG8_SA(b, h) + aoff + m * 2048 + k * 1024); } while (0)
#define PG8_LDB(dst, b, h) do { _Pragma("unroll") for (int n = 0; n < 2; ++n) _Pragma("unroll") for (int k = 0; k < 2; ++k) dst[n][k] = *(const PG8_LAS bf16x8*)(lds + PG8_SB(b, h) + boff + n * 2048 + k * 1024); } while (0)
#define PG8_MMA(ai, bj, At, Bt) do { __builtin_amdgcn_s_setprio(1); _Pragma("unroll") for (int m = 0; m < 4; ++m) _Pragma("unroll") for (int n = 0; n < 2; ++n) _Pragma("unroll") for (int k = 0; k < 2; ++k) \
        acc[ai][bj][m][n] = __builtin_amdgcn_mfma_f32_16x16x32_bf16(Bt[n][k], At[m][k], acc[ai][bj][m][n], 0, 0, 0); __builtin_amdgcn_s_setprio(0); } while (0)
#define PG8_WAIT_V(n) asm volatile("s_waitcnt vmcnt(" #n ")" ::: "memory")
#define PG8_WAIT_L(n) asm volatile("s_waitcnt lgkmcnt(" #n ")" ::: "memory")
#define PG8_BAR __builtin_amdgcn_s_barrier()
#define PG8_SCHED __builtin_amdgcn_sched_barrier(0)
    Unit cur, nxt; int ui = 0;
    if (!S.next(0, cur)) return;
    if (zero_init) {
#pragma unroll
    for (int a = 0; a < 2; ++a)
#pragma unroll
        for (int b = 0; b < 2; ++b)
#pragma unroll
            for (int m = 0; m < 4; ++m)
#pragma unroll
                for (int n = 0; n < 2; ++n) acc[a][b][m][n] = (f32x4){0.f, 0.f, 0.f, 0.f};
    }
    bf16x8 At[4][2], B0[2][2], B1[2][2];
    const char* cA = (const char*)g.A + (size_t)cur.pm * tstepA; const char* cB = (const char*)g.Bt + (size_t)cur.pn * tstepB;
    S.a_ready(cur);
    if constexpr (SP2) {
        PG8_STAGE(PG8_SB(0, 0), cB, voffB); PG8_STAGE(PG8_SB(0, 1), cB + hstepB, voffB); PG8_STAGE(PG8_SA(0, 0), cA, voffA); PG8_STAGE(PG8_SA(0, 1), cA + hstepA, voffA);
        if (wr == 1) PG8_BAR;
        PG8_WAIT_V(2); PG8_BAR;
        PG8_STAGE(PG8_SB(1, 0), cB + kstep, voffB); PG8_STAGE(PG8_SA(1, 0), cA + kstep, voffA); PG8_STAGE(PG8_SB(1, 1), cB + hstepB + kstep, voffB);
        PG8_WAIT_V(6); PG8_BAR;
    } else {
        PG8_STAGE(PG8_SB(0, 0), cB, voffB); PG8_STAGE(PG8_SA(0, 0), cA, voffA); PG8_STAGE(PG8_SB(0, 1), cB + hstepB, voffB); PG8_STAGE(PG8_SA(0, 1), cA + hstepA, voffA);
        if (wr == 1) PG8_BAR;
        PG8_WAIT_V(4); PG8_BAR;
        PG8_STAGE(PG8_SB(1, 0), cB + kstep, voffB); PG8_STAGE(PG8_SA(1, 0), cA + kstep, voffA); PG8_STAGE(PG8_SB(1, 1), cB + hstepB + kstep, voffB);
        PG8_WAIT_V(6); PG8_BAR;
    }
    for (;;) {
        const bool has_next = S.next(ui + 1, nxt);
        const char* nA = has_next ? (const char*)g.A + (size_t)nxt.pm * tstepA : cA; const char* nB = has_next ? (const char*)g.Bt + (size_t)nxt.pn * tstepB : cB;
#pragma unroll 1
        for (int t = 0; t < nt; t += 2) {
            if constexpr (Epi::CHAIN) { if (t == Epi::T1 || t == Epi::T2) E.mid(acc, cur, t, wr, wc, fr, fq); }
            const bool last = (t == nt - 2);
            const char* a1 = cA + (size_t)(t + 1) * kstep;
            const char* a2 = last ? nA : cA + (size_t)(t + 2) * kstep; const char* b2 = last ? nB : cB + (size_t)(t + 2) * kstep;
            const char* a3 = a2 + kstep; const char* b3 = b2 + kstep;
            if (last && has_next) S.a_ready(nxt);
            if constexpr (SP2) {
            PG8_LDB(B0, 0, 0); PG8_LDB(B1, 0, 1); PG8_SCHED; PG8_LDA(At, 0, 0); PG8_STAGE(PG8_SA(1, 1), a1 + hstepA, voffA);
            PG8_WAIT_V(8); PG8_WAIT_L(0); PG8_BAR; PG8_MMA(0, 0, At, B0); PG8_MMA(0, 1, At, B1); PG8_BAR; PG8_SCHED;
            PG8_LDA(At, 0, 1); PG8_STAGE(PG8_SB(0, 0), b2, voffB); PG8_STAGE(PG8_SB(0, 1), b2 + hstepB, voffB); PG8_STAGE(PG8_SA(0, 0), a2, voffA);
            PG8_WAIT_V(8); PG8_WAIT_L(0); PG8_BAR; PG8_MMA(1, 0, At, B0); PG8_MMA(1, 1, At, B1); PG8_BAR; PG8_SCHED;
            PG8_LDB(B0, 1, 0); PG8_LDB(B1, 1, 1); PG8_SCHED; PG8_LDA(At, 1, 0); PG8_STAGE(PG8_SA(0, 1), a2 + hstepA, voffA);
            PG8_WAIT_V(8); PG8_WAIT_L(0); PG8_BAR; PG8_MMA(0, 0, At, B0); PG8_MMA(0, 1, At, B1); PG8_BAR; PG8_SCHED;
            PG8_LDA(At, 1, 1); PG8_STAGE(PG8_SB(1, 0), b3, voffB); PG8_STAGE(PG8_SB(1, 1), b3 + hstepB, voffB); PG8_STAGE(PG8_SA(1, 0), a3, voffA);
            PG8_WAIT_V(8); PG8_WAIT_L(0); PG8_BAR; PG8_MMA(1, 0, At, B0); PG8_MMA(1, 1, At, B1); PG8_BAR; PG8_SCHED;
            } else {
            PG8_LDB(B0, 0, 0); PG8_SCHED; PG8_LDA(At, 0, 0); PG8_STAGE(PG8_SA(1, 1), a1 + hstepA, voffA);
            PG8_WAIT_L(8); PG8_BAR; PG8_WAIT_L(0); PG8_MMA(0, 0, At, B0); PG8_BAR; PG8_SCHED;
            PG8_LDB(B1, 0, 1); PG8_STAGE(PG8_SB(0, 0), b2, voffB);
            PG8_BAR; PG8_WAIT_L(0); PG8_MMA(0, 1, At, B1); PG8_BAR;
            PG8_LDA(At, 0, 1); PG8_STAGE(PG8_SA(0, 0), a2, voffA);
            PG8_BAR; PG8_WAIT_L(0); PG8_MMA(1, 0, At, B0); PG8_BAR; PG8_SCHED;
            PG8_STAGE(PG8_SB(0, 1), b2 + hstepB, voffB);
            PG8_WAIT_V(6); PG8_BAR; PG8_MMA(1, 1, At, B1); PG8_BAR;
            PG8_LDB(B0, 1, 0); PG8_SCHED; PG8_LDA(At, 1, 0); PG8_STAGE(PG8_SA(0, 1), a2 + hstepA, voffA);
            PG8_WAIT_L(8); PG8_BAR; PG8_WAIT_L(0); PG8_MMA(0, 0, At, B0); PG8_BAR; PG8_SCHED;
            PG8_LDB(B1, 1, 1); PG8_STAGE(PG8_SB(1, 0), b3, voffB);
            PG8_BAR; PG8_WAIT_L(0); PG8_MMA(0, 1, At, B1); PG8_BAR;
            PG8_LDA(At, 1, 1); PG8_STAGE(PG8_SA(1, 0), a3, voffA);
            PG8_BAR; PG8_WAIT_L(0); PG8_MMA(1, 0, At, B0); PG8_BAR; PG8_SCHED;
            PG8_STAGE(PG8_SB(1, 1), b3 + hstepB, voffB);
            PG8_WAIT_V(6); PG8_BAR; PG8_MMA(1, 1, At, B1); PG8_BAR;
            }
        }
        if constexpr (ALIGN_EPI) { if (wr == 0) PG8_BAR; }
        if constexpr (!Epi::AFTER_DRAIN) { E(acc, cur, wr, wc, fr, fq); S.done(cur); }
        if (!has_next) break;
#pragma unroll
        for (int a = 0; a < 2; ++a)
#pragma unroll
            for (int b = 0; b < 2; ++b)
#pragma unroll
                for (int m = 0; m < 4; ++m)
#pragma unroll
                    for (int n = 0; n < 2; ++n) acc[a][b][m][n] = (f32x4){0.f, 0.f, 0.f, 0.f};
        cur = nxt; cA = nA; cB = nB; ++ui;
        if constexpr (ALIGN_EPI) { if (wr == 1) PG8_BAR; }
    }
    PG8_WAIT_V(0);
    if constexpr (!ALIGN_EPI) { if (wr == 0) PG8_BAR; }
    PG8_BAR;
    if constexpr (Epi::AFTER_DRAIN) { E.fused(acc, cur, wr, wc, fr, fq, lds, wid, lane); S.done(cur); }
#undef PG8_SA
#undef PG8_SB
#undef PG8_STAGE
#undef PG8_LDA
#undef PG8_LDB
#undef PG8_MMA
#undef PG8_WAIT_V
#undef PG8_WAIT_L
#undef PG8_BAR
#undef PG8_SCHED
}
template <class Epi, class Sched, bool ALIGN_EPI = false, bool SP2 = false>
__device__ __forceinline__ void gemm_phase(PG8_LAS unsigned char* lds, const Gemm g, const Sched& S, const Epi& E) {
    f32x4 acc[2][2][4][2];
    gemm_body<Epi, Sched, ALIGN_EPI, SP2>(lds, g, S, E, acc, true);
}
struct OneUnit { Unit u;
    __device__ __forceinline__ bool next(int i, Unit& o) const { if (i) return false; o = u; return true; }
    __device__ __forceinline__ void a_ready(const Unit&) const {}
    __device__ __forceinline__ void done(const Unit&) const {} };
}

typedef unsigned short bf16_t;
using pg8::bf16x8; using pg8::f32x4; using pg8::u32x4;
typedef float f32x16 __attribute__((ext_vector_type(16)));
typedef unsigned u32x2 __attribute__((ext_vector_type(2)));
#define DI __device__ __forceinline__
#define MFMA32(a, b, c) __builtin_amdgcn_mfma_f32_32x32x16_bf16((a), (b), (c), 0, 0, 0)

constexpr int SEQ = 4096, BATCH = 8, DM = 1024, DEPTH = 2;
constexpr int NB = 4, TC = NB * SEQ, NCHUNK = BATCH / NB;
constexpr int INW = 11168, LDZ = 11168, NZP = 11264;
constexpr int C_LRUX = 0, C_LRUG = 1024, C_MLAG = 2048, C_DILG = 2560, C_DQ = 3072, C_DK = 4608, C_DV = 6144, C_MERGE = 7680, C_CQ = 10752, C_CKV = 11008, C_KR = 11136;
constexpr float EPS = 1e-6f, LOG2E = 1.4426950408889634f, LN2 = 0.6931471805599453f, LOG2_THETA = 13.287712379549449f;
constexpr int NUP = 1792, KUP = 384;

constexpr size_t W_IN_B = (size_t)NZP * DM * 2, W_UP_B = (size_t)NUP * KUP * 2, W_SQ_B = (size_t)DM * DM * 2, W_HF_B = (size_t)DM * 512 * 2, W_G_B = (size_t)8 * 128 * 128 * 2;
constexpr size_t WL_IN = 0, WL_UP = WL_IN + W_IN_B, WL_PCAT = WL_UP + W_UP_B  , WL_OUT = WL_PCAT + W_SQ_B + 2 * W_HF_B,
                 WL_GX = WL_OUT + W_SQ_B, WL_GA = WL_GX + W_G_B, WL_SIZE = WL_GA + W_G_B;
constexpr size_t WS_W = 0, WS_Z = WS_W + 2 * WL_SIZE, WS_S = WS_Z + (size_t)TC * LDZ * 2;
constexpr size_t S_XN = 0;
constexpr int LDQ = 1792;
constexpr size_t S_QF = 0, S_KF = S_QF + (size_t)TC * LDQ * 2, S_AGG = S_KF + (size_t)TC * 768 * 2,
                 S_LSE = S_AGG + (size_t)(TC / 64) * 1024 * 8, S_P23_END = S_LSE + (size_t)3 * TC * 8 * 4;
constexpr size_t S_MRG = 0, S_MB = S_MRG + (size_t)TC * DM * 4, S_END = S_MB + (size_t)TC * DM * 2;
static_assert(S_P23_END <= S_END, "scratch");
constexpr size_t WS_CTL = WS_S + S_END;
constexpr size_t WS_NEED = WS_CTL + 256 * 258;
static_assert(WS_NEED <= 536870912ull, "workspace");
static_assert(WS_Z % 256 == 0 && WS_S % 256 == 0 && WL_SIZE % 256 == 0, "align");
constexpr int LDS_BYTES = 139264;

DI float bflo(unsigned w) { return __uint_as_float(w << 16); }
DI float bfhi(unsigned w) { return __uint_as_float(w & 0xffff0000u); }
DI unsigned pk2(float lo, float hi) { typedef float f2_t __attribute__((ext_vector_type(2))); typedef __bf16 b2_t __attribute__((ext_vector_type(2)));
    f2_t v = {lo, hi}; b2_t b = __builtin_convertvector(v, b2_t); return __builtin_bit_cast(unsigned, b); }
DI float sigmoidf_(float x) { return __builtin_amdgcn_rcpf(1.f + __builtin_amdgcn_exp2f(-LOG2E * x)); }
DI float siluf_(float x) { return x * sigmoidf_(x); }
DI float fexp_(float x) { return __builtin_amdgcn_exp2f(LOG2E * x); }
DI float wave_sum(float v) {
#pragma unroll
    for (int m = 1; m < 64; m <<= 1) v += __shfl_xor(v, m);
    return v; }
DI void lds_barrier() { asm volatile("s_waitcnt lgkmcnt(0)\n\ts_barrier" ::: "memory"); }
DI int crow(int i, int h) { return (i & 3) + 8 * (i >> 2) + 4 * h; }
DI void sincos_rev(float ang, float& s, float& c) { float rev = ang * 0.15915494309189535f; rev = rev - floorf(rev); s = __builtin_amdgcn_sinf(rev); c = __builtin_amdgcn_cosf(rev); }

struct Args { const float* in[24]; float* out; unsigned char* ws; };
#ifndef PROBE_K
#define PROBE_K (-1)
#endif
#define PSTAMP(k) do { if (PROBE_K >= 0) { const unsigned long long now_ = __builtin_amdgcn_s_memrealtime(); if ((k) == PROBE_K) tacc += now_ - tprev; tprev = now_; } } while (0)

DI void wconv_job(float* tl, const float* __restrict__ src, int lds_, int n0s, int nrows, int ncols, bf16_t* dst, int ldd, int n0d, int k0d, const float* __restrict__ scale, int& base) {
    const int tid = otid(), ntn = (ncols + 127) / 128, ntk = nrows / 64, nt = ntn * ntk;
    f32x4 pv[4];
#define WC_LOAD(T) { const int tn_ = (T) % ntn, k0_ = ((T) / ntn) * 64, n4_ = tn_ * 128 + (tid & 31) * 4; _Pragma("unroll") for (int i = 0; i < 4; ++i) { const int kk = i * 16 + (tid >> 5); \
        f32x4 v = (f32x4){0.f, 0.f, 0.f, 0.f}; if (n4_ < ncols) v = *(const f32x4*)(src + (size_t)(k0_ + kk) * lds_ + n0s + n4_); if (scale) v *= scale[k0_ + kk]; pv[i] = v; } }
    const int G_ = gridDim.x; int t = (obid() + G_ - base % G_) % G_; base += nt;
    if (t < nt) WC_LOAD(t)
    for (; t < nt; t += gridDim.x) {
        const int tn = t % ntn, k0 = (t / ntn) * 64;
#pragma unroll
        for (int i = 0; i < 4; ++i) *(f32x4*)(tl + (i * 16 + (tid >> 5)) * 132 + (tid & 31) * 4) = pv[i];
        __syncthreads();
        if (t + (int)gridDim.x < nt) WC_LOAD(t + gridDim.x)
        { const int n = tid >> 2, kq = tid & 3; const float* tp = tl + (kq * 16) * 132 + n;
          if (tn * 128 + n < ncols) { u32x4 w0, w1;
            w0.x = pk2(tp[0 * 132], tp[1 * 132]); w0.y = pk2(tp[2 * 132], tp[3 * 132]); w0.z = pk2(tp[4 * 132], tp[5 * 132]); w0.w = pk2(tp[6 * 132], tp[7 * 132]);
            w1.x = pk2(tp[8 * 132], tp[9 * 132]); w1.y = pk2(tp[10 * 132], tp[11 * 132]); w1.z = pk2(tp[12 * 132], tp[13 * 132]); w1.w = pk2(tp[14 * 132], tp[15 * 132]);
            bf16_t* dp = dst + (size_t)(n0d + tn * 128 + n) * ldd + k0d + k0 + kq * 16; *(u32x4*)dp = w0; *(u32x4*)(dp + 8) = w1; } }
        lds_barrier();
    }
#undef WC_LOAD
}
DI void zero_rect(bf16_t* dst, int ldd, int n0, int nn, int k0, int nk) {
    const int per = nk / 8, tot = nn * per;
    for (int i = obid() * 512 + otid(); i < tot; i += gridDim.x * 512) { const int n = i / per, c = i % per;
        *(u32x4*)(dst + (size_t)(n0 + n) * ldd + k0 + c * 8) = (u32x4){0u, 0u, 0u, 0u}; }
}
DI void prologue_weights(const Args& a, unsigned char* lds) {
    float* tl = (float*)lds; int base = 0;
    for (int l = 0; l < DEPTH; ++l) {
        unsigned char* wl = a.ws + WS_W + (size_t)l * WL_SIZE;
        bf16_t* win = (bf16_t*)(wl + WL_IN); const float* w_in = a.in[3] + (size_t)l * DM * INW;
        wconv_job(tl, w_in, INW, 0,    1024, 2048, win, DM, C_LRUX, 0, nullptr, base);
        wconv_job(tl, w_in, INW, 2464, 1024, 512,  win, DM, C_MLAG, 0, nullptr, base);
        wconv_job(tl, w_in, INW, 7584, 1024, 512,  win, DM, C_DILG, 0, nullptr, base);
        wconv_job(tl, w_in, INW, 2976, 1024, 4608, win, DM, C_DQ, 0, nullptr, base);
        wconv_job(tl, w_in, INW, 8096, 1024, 3072, win, DM, C_MERGE, 0, nullptr, base);
        wconv_job(tl, w_in, INW, 2048, 1024, 416,  win, DM, C_CQ, 0, nullptr, base);
        zero_rect(win, DM, INW, NZP - INW, 0, DM);
        bf16_t* wup = (bf16_t*)(wl + WL_UP);
        wconv_job(tl, a.in[14] + (size_t)l * 256 * 768, 768, 0, 256, 768, wup, KUP, 0, 0, a.in[12] + l * 256, base);
        wconv_job(tl, a.in[15] + (size_t)l * 128 * 1024, 1024, 0, 128, 1024, wup, KUP, 768, 256, a.in[13] + l * 128, base);
        zero_rect(wup, KUP, 0, 768, 256, 128); zero_rect(wup, KUP, 768, 1024, 0, 256);
        wconv_job(tl, a.in[11] + (size_t)l * DM * DM, DM, 0, 1024, 1024, (bf16_t*)(wl + WL_PCAT), 2048, 0, 0, nullptr, base);
        wconv_job(tl, a.in[18] + (size_t)l * 512 * DM, DM, 0, 512, 1024, (bf16_t*)(wl + WL_PCAT), 2048, 0, 1024, nullptr, base);
        wconv_job(tl, a.in[21] + (size_t)l * 512 * DM, DM, 0, 512, 1024, (bf16_t*)(wl + WL_PCAT), 2048, 0, 1536, nullptr, base);
        wconv_job(tl, a.in[23] + (size_t)l * DM * DM, DM, 0, 1024, 1024, (bf16_t*)(wl + WL_OUT), 1024, 0, 0, nullptr, base);
        for (int nb = 0; nb < 8; ++nb) {
            wconv_job(tl, a.in[6] + ((size_t)l * 8 + nb) * 128 * 128, 128, 0, 128, 128, (bf16_t*)(wl + WL_GX) + nb * 128 * 128, 128, 0, 0, nullptr, base);
            wconv_job(tl, a.in[8] + ((size_t)l * 8 + nb) * 128 * 128, 128, 0, 128, 128, (bf16_t*)(wl + WL_GA) + nb * 128 * 128, 128, 0, 0, nullptr, base);
        }
    }
}

DI void p0_rmsnorm(const float* __restrict__ x, const float* __restrict__ g, bf16_t* xn) {
    const int tid = otid(), lane = tid & 63, gw = obid() * 8 + (tid >> 6), nw = gridDim.x * 8;
    f32x4 gv[4];
#pragma unroll
    for (int i = 0; i < 4; ++i) gv[i] = *(const f32x4*)(g + i * 256 + lane * 4);
    for (int row = gw; row < TC; row += nw) {
        const float* xr = x + (size_t)row * DM; f32x4 v[4]; float ss = 0.f;
#pragma unroll
        for (int i = 0; i < 4; ++i) { v[i] = *(const f32x4*)(xr + i * 256 + lane * 4); ss += v[i][0] * v[i][0] + v[i][1] * v[i][1] + v[i][2] * v[i][2] + v[i][3] * v[i][3]; }
        ss = wave_sum(ss); const float rs = rsqrtf(ss * (1.f / DM) + EPS);
#pragma unroll
        for (int i = 0; i < 4; ++i) { u32x2 w; w.x = pk2(v[i][0] * rs * gv[i][0], v[i][1] * rs * gv[i][1]); w.y = pk2(v[i][2] * rs * gv[i][2], v[i][3] * rs * gv[i][3]);
            *(u32x2*)(xn + (size_t)row * DM + i * 256 + lane * 4) = w; }
    }
}

struct EpiZ {
    static constexpr bool PERM = true, AFTER_DRAIN = false, CHAIN = false;
    bf16_t* O; int ldc; int ncols;
    DI void operator()(const f32x4 (&acc)[2][2][4][2], const pg8::Unit& u, int wr, int wc, int fr, int fq) const {
        const int row0 = u.pm * 256 + wr * 64 + fr, col0 = u.pn * 256 + wc * 32 + 8 * fq;
#pragma unroll
        for (int ai = 0; ai < 2; ++ai)
#pragma unroll
            for (int m = 0; m < 4; ++m) { bf16_t* rowp = O + (size_t)(row0 + ai * 128 + m * 16) * ldc;
#pragma unroll
                for (int bj = 0; bj < 2; ++bj) { const int c = col0 + bj * 128; if (c < ncols) { const f32x4 v0 = acc[ai][bj][m][0], v1 = acc[ai][bj][m][1];
                    u32x4 w; w.x = pk2(v0[0], v0[1]); w.y = pk2(v0[2], v0[3]); w.z = pk2(v1[0], v1[1]); w.w = pk2(v1[2], v1[3]); *(u32x4*)(rowp + c) = w; } } }
    }
};
struct EpiChain {
    static constexpr bool PERM = true, AFTER_DRAIN = false, CHAIN = true; static constexpr int T1 = 16, T2 = 24;
    const bf16_t* Z; const float* bm; bf16_t* MB;
    template <bool FIN> DI void run(f32x4 (&acc)[2][2][4][2], const pg8::Unit& u, int br, int wr, int wc, int fr_, int fq_) const {
        int fr = fr_, fq = fq_; asm volatile("" : "+v"(fr), "+v"(fq));
        const int row0 = u.pm * 256 + wr * 64 + fr, col0 = u.pn * 256 + wc * 32 + 8 * fq;
        const float* bmb = bm + br * 1024; const bf16_t* zb = Z + C_MERGE + br * 1024;
#pragma unroll
        for (int bj = 0; bj < 2; ++bj)
#pragma unroll
            for (int n = 0; n < 2; ++n) { const int c = col0 + bj * 128 + 4 * n;
                f32x4 b = *(const f32x4*)(bmb + c) * (-LOG2E), d = b; if (!FIN) d = *(const f32x4*)(bmb + 1024 + c) * (-LOG2E);
                u32x2 gz[8], hz[8];
#pragma unroll
                for (int q = 0; q < 8; ++q) { const bf16_t* zp = zb + (size_t)(row0 + (q >> 2) * 128 + (q & 3) * 16) * LDZ + c; gz[q] = *(const u32x2*)zp; if (!FIN) hz[q] = *(const u32x2*)(zp + 1024); }
#pragma unroll
                for (int q = 0; q < 8; ++q) { const int ai = q >> 2, m = q & 3; const size_t row = (size_t)(row0 + ai * 128 + m * 16);
                    f32x4 sc;
                    sc[0] = __builtin_amdgcn_rcpf(1.f + __builtin_amdgcn_exp2f(bflo(gz[q].x) * (-LOG2E) + b[0])); sc[1] = __builtin_amdgcn_rcpf(1.f + __builtin_amdgcn_exp2f(bfhi(gz[q].x) * (-LOG2E) + b[1]));
                    sc[2] = __builtin_amdgcn_rcpf(1.f + __builtin_amdgcn_exp2f(bflo(gz[q].y) * (-LOG2E) + b[2])); sc[3] = __builtin_amdgcn_rcpf(1.f + __builtin_amdgcn_exp2f(bfhi(gz[q].y) * (-LOG2E) + b[3]));
                    if (!FIN) {
                        sc[0] *= 1.f + __builtin_amdgcn_exp2f(bflo(hz[q].x) * (-LOG2E) + d[0]); sc[1] *= 1.f + __builtin_amdgcn_exp2f(bfhi(hz[q].x) * (-LOG2E) + d[1]);
                        sc[2] *= 1.f + __builtin_amdgcn_exp2f(bflo(hz[q].y) * (-LOG2E) + d[2]); sc[3] *= 1.f + __builtin_amdgcn_exp2f(bfhi(hz[q].y) * (-LOG2E) + d[3]);
                        acc[ai][bj][m][n] *= sc; asm volatile("" : "+v"(acc[ai][bj][m][n]));
                    } else {
                        const f32x4 v = acc[ai][bj][m][n] * sc; u32x2 w; w.x = pk2(v[0], v[1]); w.y = pk2(v[2], v[3]); *(u32x2*)(MB + row * DM + c) = w; } }
                asm volatile("" ::: "memory"); }
    }
    DI void mid(f32x4 (&acc)[2][2][4][2], const pg8::Unit& u, int t, int wr, int wc, int fr, int fq) const { run<false>(acc, u, t == T1 ? 0 : 1, wr, wc, fr, fq); }
    DI void operator()(f32x4 (&acc)[2][2][4][2], const pg8::Unit& u, int wr, int wc, int fr, int fq) const { run<true>(acc, u, 2, wr, wc, fr, fq); }
};
struct EpiOut {
    static constexpr bool PERM = false, AFTER_DRAIN = false, CHAIN = false;
    const float* X; float* O;
    DI void operator()(const f32x4 (&acc)[2][2][4][2], const pg8::Unit& u, int wr, int wc, int fr, int fq) const {
        const int row0 = u.pm * 256 + wr * 64 + fr, col0 = u.pn * 256 + wc * 32 + 4 * fq;
#pragma unroll
        for (int ai = 0; ai < 2; ++ai)
#pragma unroll
            for (int mp = 0; mp < 2; ++mp) {
                f32x4 xv[2][2][2];
#pragma unroll
                for (int mm = 0; mm < 2; ++mm) { const size_t ro = (size_t)(row0 + ai * 128 + (mp * 2 + mm) * 16) * DM + col0;
#pragma unroll
                    for (int bj = 0; bj < 2; ++bj)
#pragma unroll
                        for (int n = 0; n < 2; ++n) xv[mm][bj][n] = *(const f32x4*)(X + ro + bj * 128 + n * 16); }
#pragma unroll
                for (int mm = 0; mm < 2; ++mm) { const size_t ro = (size_t)(row0 + ai * 128 + (mp * 2 + mm) * 16) * DM + col0;
#pragma unroll
                    for (int bj = 0; bj < 2; ++bj)
#pragma unroll
                        for (int n = 0; n < 2; ++n) *(f32x4*)(O + ro + bj * 128 + n * 16) = xv[mm][bj][n] + acc[ai][bj][mp * 2 + mm][n]; }
                asm volatile("" ::: "memory"); }
    }
};

#define UNPK8(W_, d, o, sc_) { const u32x4 w_ = (W_); d[o + 0] = bflo(w_.x) * (sc_); d[o + 1] = bfhi(w_.x) * (sc_); d[o + 2] = bflo(w_.y) * (sc_); d[o + 3] = bfhi(w_.y) * (sc_); d[o + 4] = bflo(w_.z) * (sc_); d[o + 5] = bfhi(w_.z) * (sc_); d[o + 6] = bflo(w_.w) * (sc_); d[o + 7] = bfhi(w_.w) * (sc_); }
DI void dil_prep(bf16_t* z, const int* __restrict__ pos, const float* __restrict__ gq, const float* __restrict__ gk) {
    const int tid = otid(), lane = tid & 63, gw = obid() * 8 + (tid >> 6), nw = gridDim.x * 8, j = lane & 7, hsub = lane >> 3;
    float inv[8], gqo[8], gqp[8], gko[8], gkp[8];
#pragma unroll
    for (int e = 0; e < 8; ++e) { inv[e] = __builtin_amdgcn_exp2f(-(float)(8 * (j & 3) + e) * (LOG2_THETA / 32.f));
        gqo[e] = gq[j * 8 + e]; gqp[e] = gq[(j ^ 4) * 8 + e]; gko[e] = gk[j * 8 + e]; gkp[e] = gk[(j ^ 4) * 8 + e]; }
    const float sgn = (j < 4) ? -1.f : 1.f;
    for (int wi0 = gw; wi0 < TC * 6; wi0 += 8 * nw) {
        u32x4 wv[8];
#pragma unroll
        for (int b = 0; b < 8; ++b) { const int wi = wi0 + b * nw; wv[b] = (u32x4){0u, 0u, 0u, 0u};
            if (wi < TC * 6) { const int tok = wi / 6, grp = wi - tok * 6; wv[b] = *(const u32x4*)(z + (size_t)tok * LDZ + (grp < 3 ? C_DQ + grp * 512 : C_DK + (grp - 3) * 512) + hsub * 64 + j * 8); } }
#pragma unroll
        for (int b = 0; b < 8; ++b) { const int wi = wi0 + b * nw; if (wi < TC * 6) {
            const int tok = wi / 6, grp = wi - tok * 6; const bool isq = grp < 3;
            bf16_t* p = z + (size_t)tok * LDZ + (isq ? C_DQ + grp * 512 : C_DK + (grp - 3) * 512) + hsub * 64 + j * 8;
            const u32x4 w = wv[b]; u32x4 q;
            q.x = __shfl_xor(w.x, 4); q.y = __shfl_xor(w.y, 4); q.z = __shfl_xor(w.z, 4); q.w = __shfl_xor(w.w, 4);
            float v[8], u[8]; UNPK8(w, v, 0, 1.f) UNPK8(q, u, 0, 1.f)
            float ss = 0.f;
#pragma unroll
            for (int e = 0; e < 8; ++e) ss += v[e] * v[e];
            ss += __shfl_xor(ss, 1); ss += __shfl_xor(ss, 2); ss += __shfl_xor(ss, 4);
            const float rs = rsqrtf(ss * (1.f / 64.f) + EPS) * (isq ? 0.125f * LOG2E : 1.f);
            const float fp = (float)pos[tok];
            float o[8];
#pragma unroll
            for (int e = 0; e < 8; ++e) { float sn, cs; sincos_rev(fp * inv[e], sn, cs);
                const float a = v[e] * rs * (isq ? gqo[e] : gko[e]), bb = u[e] * rs * (isq ? gqp[e] : gkp[e]); o[e] = a * cs + sgn * bb * sn; }
            u32x4 r; r.x = pk2(o[0], o[1]); r.y = pk2(o[2], o[3]); r.z = pk2(o[4], o[5]); r.w = pk2(o[6], o[7]);
            *(u32x4*)p = r; } }
    }
}

DI float ssq8(u32x4 w) { return bflo(w.x) * bflo(w.x) + bfhi(w.x) * bfhi(w.x) + bflo(w.y) * bflo(w.y) + bfhi(w.y) * bfhi(w.y) + bflo(w.z) * bflo(w.z) + bfhi(w.z) * bfhi(w.z) + bflo(w.w) * bflo(w.w) + bfhi(w.w) * bfhi(w.w); }
DI u32x4 scale8(u32x4 w, float s, const float* __restrict__ g) { u32x4 o; o.x = pk2(bflo(w.x) * s * g[0], bfhi(w.x) * s * g[1]); o.y = pk2(bflo(w.y) * s * g[2], bfhi(w.y) * s * g[3]);
    o.z = pk2(bflo(w.z) * s * g[4], bfhi(w.z) * s * g[5]); o.w = pk2(bflo(w.w) * s * g[6], bfhi(w.w) * s * g[7]); return o; }
DI void rope16(float (&v)[32], const float* __restrict__ g, float fp) {
#pragma unroll
    for (int i = 0; i < 16; ++i) { const float inv = exp2f(-(float)i * (LOG2_THETA / 16.f)); float sn, cs; sincos_rev(fp * inv, sn, cs);
        const float x1 = v[i] * g[i], x2 = v[16 + i] * g[16 + i]; v[i] = x1 * cs - x2 * sn; v[16 + i] = x2 * cs + x1 * sn; }
}
DI void mla_finalize(unsigned char* lds, const bf16_t* z, bf16_t* qf, bf16_t* kvr, bf16_t* kf, const int* __restrict__ pos, const float* __restrict__ gqn_g, const float* __restrict__ gkn_g) {
    float* rst = (float*)lds;
    float* gl = rst + 128; const float* gqn = gl; const float* gkn = gl + 96;
    for (int grp = obid(); grp < TC / 64; grp += gridDim.x) {
        const int tid = otid(), lane = tid & 63, wid = tid >> 6;
        const int t0 = grp * 64;
        const int tl_ = tid >> 3, hd = tid & 7, tok = t0 + tl_;
        bf16_t* pq = qf + (size_t)tok * LDQ + hd * 96; bf16_t* pkv = kvr + (size_t)tok * LDQ + hd * 128; const bf16_t* pkr = z + (size_t)tok * LDZ + C_KR; bf16_t* pk = kf + (size_t)tok * 768 + hd * 96;
        u32x4 rq[12];
#pragma unroll
        for (int c = 0; c < 12; ++c) rq[c] = *(const u32x4*)(pq + c * 8);
        const float fp = (float)pos[tok];
        if (tid < 192) gl[tid] = (tid < 96) ? gqn_g[tid] : gkn_g[tid - 96];
        u32x2 la[8]; unsigned lb[8];
#pragma unroll
        for (int i = 0; i < 8; ++i) { const bf16_t* zr = z + (size_t)(t0 + wid * 8 + i) * LDZ; la[i] = *(const u32x2*)(zr + C_CQ + lane * 4); lb[i] = *(const unsigned*)(zr + C_CKV + lane * 2); }
        __syncthreads();
#pragma unroll
        for (int i = 0; i < 8; ++i) {
            float s1 = bflo(la[i].x) * bflo(la[i].x) + bfhi(la[i].x) * bfhi(la[i].x) + bflo(la[i].y) * bflo(la[i].y) + bfhi(la[i].y) * bfhi(la[i].y), s2 = bflo(lb[i]) * bflo(lb[i]) + bfhi(lb[i]) * bfhi(lb[i]);
            s1 = wave_sum(s1); s2 = wave_sum(s2);
            if (lane == 0) { rst[(wid * 8 + i) * 2] = rsqrtf(s1 * (1.f / 256.f) + EPS); rst[(wid * 8 + i) * 2 + 1] = rsqrtf(s2 * (1.f / 128.f) + EPS); } }
        __syncthreads();
        const float rcq = rst[tl_ * 2], rckv = rst[tl_ * 2 + 1];
        {
            float ss = 0.f;
#pragma unroll
            for (int c = 0; c < 12; ++c) ss += ssq8(rq[c]);
            ss *= rcq * rcq;
            const float rs = rsqrtf(ss * (1.f / 96.f) + EPS) * rcq * (0.10206207261596575f * LOG2E);
#pragma unroll
            for (int c = 0; c < 8; ++c) *(u32x4*)(pq + c * 8) = scale8(rq[c], rs, gqn + c * 8);
            float v[32];
#pragma unroll
            for (int c = 0; c < 4; ++c) { UNPK8(rq[8 + c], v, c * 8, rs) }
            rope16(v, gqn + 64, fp);
#pragma unroll
            for (int c = 0; c < 4; ++c) { u32x4 w; w.x = pk2(v[c * 8 + 0], v[c * 8 + 1]); w.y = pk2(v[c * 8 + 2], v[c * 8 + 3]); w.z = pk2(v[c * 8 + 4], v[c * 8 + 5]); w.w = pk2(v[c * 8 + 6], v[c * 8 + 7]);
                *(u32x4*)(pq + 64 + c * 8) = w; }
        }
        asm volatile("" ::: "memory");
        {
            u32x4 rk[8], rv[8], rr[4];
#pragma unroll
            for (int c = 0; c < 8; ++c) { rk[c] = *(const u32x4*)(pkv + c * 8); rv[c] = *(const u32x4*)(pkv + 64 + c * 8); }
#pragma unroll
            for (int c = 0; c < 4; ++c) rr[c] = *(const u32x4*)(pkr + c * 8);
            float ss = 0.f, sr = 0.f;
#pragma unroll
            for (int c = 0; c < 8; ++c) ss += ssq8(rk[c]);
#pragma unroll
            for (int c = 0; c < 4; ++c) sr += ssq8(rr[c]);
            ss = ss * rckv * rckv + sr;
            const float rs = rsqrtf(ss * (1.f / 96.f) + EPS);
#pragma unroll
            for (int c = 0; c < 8; ++c) *(u32x4*)(pk + c * 8) = scale8(rk[c], rs * rckv, gkn + c * 8);
            float v[32];
#pragma unroll
            for (int c = 0; c < 4; ++c) { UNPK8(rr[c], v, c * 8, rs) }
            rope16(v, gkn + 64, fp);
#pragma unroll
            for (int c = 0; c < 4; ++c) { u32x4 w; w.x = pk2(v[c * 8 + 0], v[c * 8 + 1]); w.y = pk2(v[c * 8 + 2], v[c * 8 + 3]); w.z = pk2(v[c * 8 + 4], v[c * 8 + 5]); w.w = pk2(v[c * 8 + 6], v[c * 8 + 7]);
                *(u32x4*)(pk + 64 + c * 8) = w; }
#pragma unroll
            for (int c = 0; c < 8; ++c) { u32x4 w = rv[c];
                w.x = pk2(bflo(w.x) * rckv, bfhi(w.x) * rckv); w.y = pk2(bflo(w.y) * rckv, bfhi(w.y) * rckv); w.z = pk2(bflo(w.z) * rckv, bfhi(w.z) * rckv); w.w = pk2(bflo(w.w) * rckv, bfhi(w.w) * rckv);
                *(u32x4*)(pkv + 64 + c * 8) = w; }
        }
    }
}

DI void dil_combine(bf16_t* z, const float* __restrict__ lse) {
    const int tot = TC * 64, stride = gridDim.x * 512;
    for (int it0 = obid() * 512 + otid(); it0 < tot; it0 += 2 * stride) {
        u32x4 A[2], B[2], C[2], Gt[2]; float L0[2], L1[2], L2[2];
#pragma unroll
        for (int b = 0; b < 2; ++b) { const int it = it0 + b * stride; if (it < tot) { const int tok = it >> 6, hd = (it >> 3) & 7, dc = it & 7; const bf16_t* zr = z + (size_t)tok * LDZ;
            L0[b] = lse[(size_t)tok * 8 + hd]; L1[b] = lse[(size_t)TC * 8 + (size_t)tok * 8 + hd]; L2[b] = lse[(size_t)2 * TC * 8 + (size_t)tok * 8 + hd];
            A[b] = *(const u32x4*)(zr + C_DQ + (0 * 8 + hd) * 64 + dc * 8); B[b] = *(const u32x4*)(zr + C_DQ + (1 * 8 + hd) * 64 + dc * 8); C[b] = *(const u32x4*)(zr + C_DQ + (2 * 8 + hd) * 64 + dc * 8);
            Gt[b] = *(const u32x4*)(zr + C_DILG + hd * 64 + dc * 8); } }
#pragma unroll
        for (int b = 0; b < 2; ++b) { const int it = it0 + b * stride; if (it < tot) { const int tok = it >> 6, hd = (it >> 3) & 7, dc = it & 7;
            const float l0 = L0[b], l1 = L1[b], l2 = L2[b];
            const float mx = fmaxf(l0, fmaxf(l1, l2)); float w0 = fexp_(l0 - mx), w1 = fexp_(l1 - mx), w2 = fexp_(l2 - mx); const float iw = __builtin_amdgcn_rcpf(w0 + w1 + w2); w0 *= iw; w1 *= iw; w2 *= iw;
            const u32x4 a = A[b], bq = B[b], c = C[b], g = Gt[b]; u32x4 o;
#define CMB(F) { const float e0 = (w0 * bflo(a.F) + w1 * bflo(bq.F) + w2 * bflo(c.F)) * siluf_(bflo(g.F)), e1 = (w0 * bfhi(a.F) + w1 * bfhi(bq.F) + w2 * bfhi(c.F)) * siluf_(bfhi(g.F)); o.F = pk2(e0, e1); }
            CMB(x) CMB(y) CMB(z) CMB(w)
#undef CMB
            *(u32x4*)(z + (size_t)tok * LDZ + C_DILG + hd * 64 + dc * 8) = o; } }
    }
}

struct LruP { const float* conv_w; const float* conv_b; const float* b_gx; const float* b_ga; const float* lam; const bf16_t* wgx; const bf16_t* wga; };
constexpr int L_XS = 0, L_XCB = 18432, L_XC = L_XCB + 17408, L_HB = L_XC + 32768, L_CW = L_HB + 32768, L_EX = L_CW + 5 * 128 * 4, L_END = L_EX + 2 * 128 * 8;
static_assert(L_END <= LDS_BYTES, "lru lds");
template <bool FINAL> DI void lru_unit(unsigned char* lds, bf16_t* z, float* agg, const LruP& P, int bl, int n, int grp) {
    const int tid0 = otid();
    bf16_t* xs = (bf16_t*)(lds + L_XS); bf16_t* xcb = (bf16_t*)(lds + L_XCB); float* xc = (float*)(lds + L_XC); float* hb = (float*)(lds + L_HB);
    float* cw = (float*)(lds + L_CW); float2* ex = (float2*)(lds + L_EX);
    __syncthreads();
    const int tid = tid0, lane = tid & 63, wid = tid >> 6, r = lane & 31, h = lane >> 5, ct = wid & 3, rt = wid >> 2;
    for (int i = tid; i < 640; i += 512) cw[i] = (i < 512) ? P.conv_w[(i >> 7) * 1024 + n * 128 + (i & 127)] : P.conv_b[n * 128 + (i & 127)];
    bf16x8 bx[8], ba[8];
    { const bf16_t* wx = P.wgx + (size_t)n * 16384 + (size_t)(ct * 32 + r) * 128 + 8 * h; const bf16_t* wa = P.wga + (size_t)n * 16384 + (size_t)(ct * 32 + r) * 128 + 8 * h;
#pragma unroll
      for (int s = 0; s < 8; ++s) { bx[s] = *(const bf16x8*)(wx + 16 * s); ba[s] = *(const bf16x8*)(wa + 16 * s); } }
    const int ch = ct * 32 + r, chg = n * 128 + ch; const float bgx = P.b_gx[chg], bga = P.b_ga[chg]; const float sp = __logf(1.f + __expf(-P.lam[chg]));
    float hrun = 0.f, Arun = 1.f;
    if (FINAL) {
#pragma unroll
        for (int g2 = 0; g2 < 7; ++g2) if (g2 < grp) { const float2 ab = *(const float2*)(agg + ((size_t)(bl * 8 + g2) * 1024 + chg) * 2); hrun = ab.x * hrun + ab.y; } }
    const size_t rowb = (size_t)bl * SEQ;
    u32x4 xr[3], gr[2];
#define LRU_XLOAD(J) { _Pragma("unroll") for (int q = 0; q < 3; ++q) { const int c = tid + q * 512; const int i = c >> 4, cc = c & 15; const int p = (J) * 64 - 3 + i; \
        xr[q] = (u32x4){0u, 0u, 0u, 0u}; if (c < 67 * 16 && p >= 0) xr[q] = *(const u32x4*)(z + (rowb + p) * LDZ + C_LRUX + n * 128 + cc * 8); } }
#pragma unroll
    for (int s = 0; s < 8; ++s) asm volatile("" :: "v"(bx[s]), "v"(ba[s]));
    asm volatile("" :: "v"(bgx), "v"(bga), "v"(sp), "v"(hrun));
    LRU_XLOAD(grp * 8)
    __syncthreads();
#pragma unroll 1
    for (int jt = 0; jt < 8; ++jt) {
        int tq = tid0; asm volatile("" : "+v"(tq));
        const int tid = tq, lane = tid & 63, wid = tid >> 6, r = lane & 31, h = lane >> 5, ct = wid & 3, rt = wid >> 2, ch = ct * 32 + r;
        const int j = grp * 8 + jt; const size_t row0 = rowb + (size_t)j * 64;
#pragma unroll
        for (int q = 0; q < 3; ++q) { const int c = tid + q * 512; if (c < 67 * 16) *(u32x4*)(xs + (c >> 4) * 136 + (c & 15) * 8) = xr[q]; }
        lds_barrier();
        if (jt + 1 < 8) LRU_XLOAD(j + 1)
        if (FINAL) {
#pragma unroll
            for (int q = 0; q < 2; ++q) { const int c = tid + q * 512; gr[q] = *(const u32x4*)(z + (row0 + (c >> 4)) * LDZ + C_LRUG + n * 128 + (c & 15) * 8); } }
        {
            const int i = tid >> 3, c0 = (tid & 7) * 16; float acc[16];
#pragma unroll
            for (int q = 0; q < 4; ++q) { const f32x4 b = *(const f32x4*)(cw + 512 + c0 + q * 4); acc[q * 4] = b[0]; acc[q * 4 + 1] = b[1]; acc[q * 4 + 2] = b[2]; acc[q * 4 + 3] = b[3]; }
#pragma unroll
            for (int k = 0; k < 4; ++k) {
                const u32x4 xa = *(const u32x4*)(xs + (i + k) * 136 + c0), xb = *(const u32x4*)(xs + (i + k) * 136 + c0 + 8);
                const float xv[16] = {bflo(xa.x), bfhi(xa.x), bflo(xa.y), bfhi(xa.y), bflo(xa.z), bfhi(xa.z), bflo(xa.w), bfhi(xa.w), bflo(xb.x), bfhi(xb.x), bflo(xb.y), bfhi(xb.y), bflo(xb.z), bfhi(xb.z), bflo(xb.w), bfhi(xb.w)};
#pragma unroll
                for (int q = 0; q < 4; ++q) { const f32x4 w = *(const f32x4*)(cw + k * 128 + c0 + q * 4);
                    acc[q * 4] += w[0] * xv[q * 4]; acc[q * 4 + 1] += w[1] * xv[q * 4 + 1]; acc[q * 4 + 2] += w[2] * xv[q * 4 + 2]; acc[q * 4 + 3] += w[3] * xv[q * 4 + 3]; } }
#pragma unroll
            for (int q = 0; q < 4; ++q) *(f32x4*)(xc + i * 128 + c0 + q * 4) = (f32x4){acc[q * 4], acc[q * 4 + 1], acc[q * 4 + 2], acc[q * 4 + 3]};
            u32x4 w0, w1; w0.x = pk2(acc[0], acc[1]); w0.y = pk2(acc[2], acc[3]); w0.z = pk2(acc[4], acc[5]); w0.w = pk2(acc[6], acc[7]);
            w1.x = pk2(acc[8], acc[9]); w1.y = pk2(acc[10], acc[11]); w1.z = pk2(acc[12], acc[13]); w1.w = pk2(acc[14], acc[15]);
            *(u32x4*)(xcb + i * 136 + c0) = w0; *(u32x4*)(xcb + i * 136 + c0 + 8) = w1;
        }
        lds_barrier();
        float av[16], bv[16], Ao[4], Ho[4], Ap[4], Hp[4];
        {
            f32x16 gx, ga;
#pragma unroll
            for (int i = 0; i < 16; ++i) { gx[i] = 0.f; ga[i] = 0.f; }
#pragma unroll
            for (int s = 0; s < 8; ++s) { const bf16x8 a = *(const bf16x8*)(xcb + (rt * 32 + r) * 136 + 16 * s + 8 * h); gx = MFMA32(a, bx[s], gx); ga = MFMA32(a, ba[s], ga); }
#pragma unroll
            for (int i = 0; i < 16; ++i) { const int tk = rt * 32 + crow(i, h);
                const float vgx = sigmoidf_(gx[i] + bgx), vga = sigmoidf_(ga[i] + bga); const float la = -8.f * vga * sp; av[i] = fexp_(la);
                const float mult = __builtin_amdgcn_sqrtf(fmaxf(1.f - av[i] * av[i], 0.f));
                bv[i] = mult * vgx * xc[tk * 128 + ch]; }
        }
#pragma unroll
        for (int g = 0; g < 4; ++g) { float H = 0.f, A = 1.f;
#pragma unroll
            for (int k = 0; k < 4; ++k) { H = av[4 * g + k] * H + bv[4 * g + k]; A *= av[4 * g + k]; }
            Ao[g] = A; Ho[g] = H; Ap[g] = __shfl_xor(A, 32); Hp[g] = __shfl_xor(H, 32); }
        {   float c = 0.f, At = 1.f;
#pragma unroll
            for (int g = 0; g < 4; ++g) { const float A1 = h ? Ap[g] : Ao[g], H1 = h ? Hp[g] : Ho[g], A2 = h ? Ao[g] : Ap[g], H2 = h ? Ho[g] : Hp[g]; c = A1 * c + H1; c = A2 * c + H2; At *= A1 * A2; }
            if (h == 0) ex[rt * 128 + ch] = make_float2(At, c); }
        lds_barrier();
        {   const float2 e0 = ex[ch], e1 = ex[128 + ch]; const float hmid = e0.x * hrun + e0.y;
            float c = rt ? hmid : hrun;
            hrun = e1.x * hmid + e1.y; Arun *= e0.x * e1.x;
            if (FINAL) {
#pragma unroll
                for (int g = 0; g < 4; ++g) { const float A1 = h ? Ap[g] : Ao[g], H1 = h ? Hp[g] : Ho[g], A2 = h ? Ao[g] : Ap[g], H2 = h ? Ho[g] : Hp[g];
                    const float c1 = A1 * c + H1; float hh = h ? c1 : c; c = A2 * c1 + H2;
#pragma unroll
                    for (int k = 0; k < 4; ++k) { hh = av[4 * g + k] * hh + bv[4 * g + k]; hb[(rt * 32 + 8 * g + 4 * h + k) * 128 + ch] = hh; } } } }
        if (FINAL) {
            lds_barrier();
#pragma unroll
            for (int q = 0; q < 2; ++q) { const int c = tid + q * 512; const int i = c >> 4, cc = c & 15; bf16_t* gp = z + (row0 + i) * LDZ + C_LRUG + n * 128 + cc * 8; const u32x4 g = gr[q];
                const f32x4 h0 = *(const f32x4*)(hb + i * 128 + cc * 8), h1 = *(const f32x4*)(hb + i * 128 + cc * 8 + 4); u32x4 o;
                o.x = pk2(h0[0] * siluf_(bflo(g.x)), h0[1] * siluf_(bfhi(g.x))); o.y = pk2(h0[2] * siluf_(bflo(g.y)), h0[3] * siluf_(bfhi(g.y)));
                o.z = pk2(h1[0] * siluf_(bflo(g.z)), h1[1] * siluf_(bfhi(g.z))); o.w = pk2(h1[2] * siluf_(bflo(g.w)), h1[3] * siluf_(bfhi(g.w))); *(u32x4*)gp = o; }
        }
    }
#undef LRU_XLOAD
    if (!FINAL && h == 0 && rt == 0) *(float2*)(agg + ((size_t)(bl * 8 + grp) * 1024 + chg) * 2) = make_float2(Arun, hrun);
}

typedef short s16x4 __attribute__((ext_vector_type(4)));
DI s16x4 vtr(const bf16_t* p) { return __builtin_amdgcn_ds_read_tr16_b64_v4i16((__attribute__((address_space(3))) s16x4*)p); }
template <int DK, bool WIN, bool MLA>
DI void attn_unit(unsigned char* lds, const bf16_t* Qb, size_t qs, const bf16_t* Kb, size_t ks, const bf16_t* Vb, size_t vs, int q0, bf16_t* Ob, size_t os, float* lsep, size_t lses, const float CS) {
    constexpr int KLD = DK + 8, VLD = 96, KC = DK / 8, NKR = (128 * KC) / 512, KBYTES = 128 * KLD * 2, BUFB = KBYTES + 128 * VLD * 2;
    static_assert((128 * KC) % 512 == 0 && 2 * BUFB <= LDS_BYTES, "attention staging");
    const int tid = otid(), lane = tid & 63, wid = tid >> 6, r = lane & 31, h = lane >> 5;
    const int qw = q0 + 32 * wid;
    bf16x8 qf[DK / 16];
    { const bf16_t* qrow = Qb + (size_t)(qw + r) * qs + 8 * h;
#pragma unroll
      for (int s = 0; s < DK / 16; ++s) qf[s] = *(const bf16x8*)(qrow + 16 * s); }
    f32x16 o[2];
#pragma unroll
    for (int i = 0; i < 16; ++i) { o[0][i] = 0.f; o[1][i] = 0.f; }
    float lrow = 0.f;
    const int kt_lo = WIN ? (q0 >= 128 ? (q0 - 128) / 128 : 0) : 0, kt_hi = (q0 + 255) / 128, ntile = kt_hi - kt_lo + 1;
    const int kfrag = r * KLD + 8 * h, vfrag = (4 * h + ((lane & 15) >> 2)) * VLD + 16 * ((lane >> 4) & 1) + 4 * (lane & 3);
    u32x4 kreg[NKR], vreg[2];
#define ATT_GLOAD(KT) { const size_t kb = (size_t)(KT) * 128; \
        _Pragma("unroll") for (int q_ = 0; q_ < NKR; ++q_) { const int c_ = tid + q_ * 512; kreg[q_] = *(const u32x4*)(Kb + (kb + c_ / KC) * ks + (c_ % KC) * 8); } \
        _Pragma("unroll") for (int q_ = 0; q_ < 2; ++q_) { const int c_ = tid + q_ * 512; vreg[q_] = *(const u32x4*)(Vb + (kb + (c_ >> 3)) * vs + (c_ & 7) * 8); } }
#define ATT_LWRITE(SLOT) { bf16_t* kp_ = (bf16_t*)(lds + (SLOT) * BUFB); bf16_t* vp_ = (bf16_t*)(lds + (SLOT) * BUFB + KBYTES); \
        _Pragma("unroll") for (int q_ = 0; q_ < NKR; ++q_) { const int c_ = tid + q_ * 512; *(u32x4*)(kp_ + (c_ / KC) * KLD + (c_ % KC) * 8) = kreg[q_]; } \
        _Pragma("unroll") for (int q_ = 0; q_ < 2; ++q_) { const int c_ = tid + q_ * 512; *(u32x4*)(vp_ + (c_ >> 3) * VLD + (c_ & 7) * 8) = vreg[q_]; } }
    ATT_GLOAD(kt_lo)
#pragma unroll
    for (int s = 0; s < DK / 16; ++s) asm volatile("" :: "v"(qf[s]));
    __syncthreads();
    ATT_LWRITE(0)
    if (ntile > 1) ATT_GLOAD(kt_lo + 1)
#pragma unroll 1
    for (int it = 0; it < ntile; ++it) {
        const int kbase = (kt_lo + it) * 128;
        lds_barrier();
        if (it + 1 < ntile) { ATT_LWRITE((it + 1) & 1) if (it + 2 < ntile) ATT_GLOAD(kt_lo + it + 2) }
        const bf16_t* Ks = (const bf16_t*)(lds + (it & 1) * BUFB) + kfrag; const bf16_t* Vs = (const bf16_t*)(lds + (it & 1) * BUFB + KBYTES) + vfrag;
        const int qi = qw + r;
#pragma unroll
        for (int hp = 0; hp < 2; ++hp) {
            const int kb = kbase + 64 * hp;
            const bool active = (kb <= qw + 31) && (!WIN || kb + 63 >= qw - 128);
            if (active) {
                f32x16 x[2];
#pragma unroll
                for (int i = 0; i < 16; ++i) { x[0][i] = -CS; x[1][i] = -CS; }
#pragma unroll
                for (int s = 0; s < DK / 16; ++s) { const bf16x8 a0 = *(const bf16x8*)(Ks + (hp * 64) * KLD + 16 * s), a1 = *(const bf16x8*)(Ks + (hp * 64 + 32) * KLD + 16 * s);
                    x[0] = MFMA32(a0, qf[s], x[0]); x[1] = MFMA32(a1, qf[s], x[1]); }
                const bool need_mask = (kb + 63 > qw) || (WIN && kb < qw + 31 - 128);
                if (need_mask) {
#pragma unroll
                    for (int kt2 = 0; kt2 < 2; ++kt2)
#pragma unroll
                        for (int i = 0; i < 16; ++i) { const int key = kb + kt2 * 32 + crow(i, h); const bool ok = (key <= qi) && (!WIN || key >= qi - 128); x[kt2][i] = ok ? x[kt2][i] : -INFINITY; } }
#pragma unroll
                for (int kt2 = 0; kt2 < 2; ++kt2)
#pragma unroll
                    for (int i = 0; i < 16; ++i) { const float p = __builtin_amdgcn_exp2f(x[kt2][i]); x[kt2][i] = p; lrow += p; }
#pragma unroll
                for (int kt2 = 0; kt2 < 2; ++kt2)
#pragma unroll
                    for (int s = 0; s < 2; ++s) {
                        u32x4 pw; pw.x = pk2(x[kt2][8 * s + 0], x[kt2][8 * s + 1]); pw.y = pk2(x[kt2][8 * s + 2], x[kt2][8 * s + 3]); pw.z = pk2(x[kt2][8 * s + 4], x[kt2][8 * s + 5]); pw.w = pk2(x[kt2][8 * s + 6], x[kt2][8 * s + 7]);
                        const bf16x8 pb = __builtin_bit_cast(bf16x8, pw);
#pragma unroll
                        for (int n = 0; n < 2; ++n) { const bf16_t* vp = Vs + (hp * 64 + kt2 * 32 + 16 * s) * VLD + 32 * n;
                            const s16x4 lo = vtr(vp), hi = vtr(vp + 8 * VLD);
                            const bf16x8 av = __builtin_shufflevector(lo, hi, 0, 1, 2, 3, 4, 5, 6, 7);
                            o[n] = MFMA32(av, pb, o[n]); } }
            }
        }
    }
#undef ATT_GLOAD
#undef ATT_LWRITE
    lrow += __shfl_xor(lrow, 32);
    const float inv = __builtin_amdgcn_rcpf(lrow); const size_t orow = (size_t)(qw + r) * os;
    u32x2 gv[2][4];
    if (MLA) {
#pragma unroll
        for (int n = 0; n < 2; ++n)
#pragma unroll
            for (int g4 = 0; g4 < 4; ++g4) gv[n][g4] = *(const u32x2*)(Ob + orow + n * 32 + g4 * 8 + 4 * h); }
#pragma unroll
    for (int n = 0; n < 2; ++n)
#pragma unroll
        for (int g4 = 0; g4 < 4; ++g4) { const int dv = n * 32 + g4 * 8 + 4 * h; bf16_t* op = Ob + orow + dv;
            float e0 = o[n][g4 * 4] * inv, e1 = o[n][g4 * 4 + 1] * inv, e2 = o[n][g4 * 4 + 2] * inv, e3 = o[n][g4 * 4 + 3] * inv;
            if (MLA) { const u32x2 g = gv[n][g4]; e0 *= siluf_(bflo(g.x)); e1 *= siluf_(bfhi(g.x)); e2 *= siluf_(bflo(g.y)); e3 *= siluf_(bfhi(g.y)); }
            u32x2 w; w.x = pk2(e0, e1); w.y = pk2(e2, e3); *(u32x2*)op = w; }
    if (!MLA) { if (h == 0) lsep[(size_t)(qw + r) * lses] = (CS + __log2f(lrow)) * LN2; }
}

DI void gsync(unsigned* ctr, unsigned& target) {
    asm volatile("s_waitcnt vmcnt(0)" ::: "memory");
    __syncthreads();
    target += gridDim.x;
    if (threadIdx.x == 0) {
        unsigned* gen = ctr + 64 * 257; const unsigned epoch = target / gridDim.x;
        __builtin_amdgcn_fence(__ATOMIC_RELEASE, "agent");
        asm volatile("s_waitcnt vmcnt(0)" ::: "memory");
        const unsigned old = __hip_atomic_fetch_add(ctr, 1u, __ATOMIC_RELAXED, __HIP_MEMORY_SCOPE_AGENT);
        if (old + 1u == target) __hip_atomic_store(gen, epoch, __ATOMIC_RELAXED, __HIP_MEMORY_SCOPE_AGENT);
        else while (__hip_atomic_load(gen, __ATOMIC_RELAXED, __HIP_MEMORY_SCOPE_AGENT) < epoch) __builtin_amdgcn_s_sleep(32);
        __builtin_amdgcn_fence(__ATOMIC_ACQUIRE, "agent");
        asm volatile("s_waitcnt vmcnt(0)" ::: "memory");
    }
    __syncthreads();
}

DI void panel_signal(unsigned* cnt, unsigned target) {
    if (threadIdx.x == 0) {
        __builtin_amdgcn_fence(__ATOMIC_RELEASE, "agent"); asm volatile("s_waitcnt vmcnt(0)" ::: "memory");
        const unsigned old = __hip_atomic_fetch_add(cnt, 1u, __ATOMIC_RELAXED, __HIP_MEMORY_SCOPE_AGENT);
        if (old + 1u == target) __hip_atomic_store(cnt + 64 * 128, target, __ATOMIC_RELAXED, __HIP_MEMORY_SCOPE_AGENT); }
}
DI void panel_wait(unsigned* cnt, unsigned target) {
    if (threadIdx.x == 0) { while (__hip_atomic_load(cnt + 64 * 128, __ATOMIC_RELAXED, __HIP_MEMORY_SCOPE_AGENT) < target) __builtin_amdgcn_s_sleep(16);
        __builtin_amdgcn_fence(__ATOMIC_ACQUIRE, "agent"); asm volatile("s_waitcnt vmcnt(0)" ::: "memory"); }
    __syncthreads();
}

__global__ void __launch_bounds__(512, 2) hybrid_fwd(Args a) {
    extern __shared__ __attribute__((aligned(16))) unsigned char lds_raw[];
    cg::grid_group grid = cg::this_grid();
    unsigned char* lds = lds_raw; PG8_LAS unsigned char* ldsl = (PG8_LAS unsigned char*)lds_raw;
    const int G = gridDim.x;
#define bx obid()
    unsigned char* ws = a.ws;
    bf16_t* z = (bf16_t*)(ws + WS_Z); unsigned char* sc = ws + WS_S;
    bf16_t* xn = (bf16_t*)(sc + S_XN); bf16_t* qf = (bf16_t*)(sc + S_QF); bf16_t* kvr = qf + 768; bf16_t* kf = (bf16_t*)(sc + S_KF);
    float* agg = (float*)(sc + S_AGG); float* lse = (float*)(sc + S_LSE); float* mrg = (float*)(sc + S_MRG); bf16_t* mb = (bf16_t*)(sc + S_MB);
    const int* positions = (const int*)a.in[1];

    unsigned* gctr = (unsigned*)(ws + WS_CTL); unsigned gtarget = 0;
    if (blockIdx.x == 0 && threadIdx.x < 258) __hip_atomic_store(gctr + 64 * threadIdx.x, 0u, __ATOMIC_RELAXED, __HIP_MEMORY_SCOPE_AGENT);
    unsigned* cntA = gctr + 64; unsigned* cntB = gctr + 64 * 65; const bool fullgrid = (G == 256);
    unsigned long long tacc = 0, tprev = 0; if (PROBE_K >= 0) tprev = __builtin_amdgcn_s_memrealtime();
    prologue_weights(a, lds);
    if (PROBE_K == 0) { grid.sync(); PSTAMP(0); }
#pragma unroll 1
    for (int l = 0; l < DEPTH; ++l) {
#pragma unroll 1
        for (int c = 0; c < NCHUNK; ++c) {
            int lo = l; asm volatile("" : "+s"(lo));
            const unsigned char* wl = ws + WS_W + (size_t)lo * WL_SIZE;
            const size_t roff = (size_t)c * TC;
            const float* xin = (l == 0 ? a.in[0] : a.out) + roff * DM; float* xout = a.out + roff * DM; const int* pos = positions + roff;
            p0_rmsnorm(xin, a.in[2] + lo * DM, xn);
            if (l == 0 && c == 0) grid.sync(); else gsync(gctr, gtarget);
            PSTAMP(1);
            { pg8::Gemm g; g.A = xn; g.Bt = (const bf16_t*)(wl + WL_IN); g.M = TC; g.N = NZP; g.K = DM; g.lda = DM;
              pg8::StaticOrder S; S.init(TC, NZP, G, bx); EpiZ E; E.O = z; E.ldc = LDZ; E.ncols = INW;
              pg8::gemm_phase<EpiZ, pg8::StaticOrder, true, true>(ldsl, g, S, E); }
            gsync(gctr, gtarget); PSTAMP(2);
            { pg8::Gemm g; g.A = z + C_CQ; g.Bt = (const bf16_t*)(wl + WL_UP); g.M = TC; g.N = NUP; g.K = KUP; g.lda = LDZ;
              pg8::StaticOrder S; S.init(TC, NUP, G, bx); EpiZ E; E.O = qf; E.ldc = LDQ; E.ncols = NUP;
              pg8::gemm_phase<EpiZ, pg8::StaticOrder, true, true>(ldsl, g, S, E);
              if (fullgrid) { pg8::Unit uu; for (int i = 0; S.next(i, uu); ++i) panel_signal(cntB + 64 * uu.pm, 7u * (unsigned)(l * NCHUNK + c + 1)); } }
            __syncthreads();
            LruP lp; lp.conv_w = a.in[4] + (size_t)lo * 4 * 1024; lp.conv_b = a.in[5] + lo * 1024; lp.b_gx = a.in[7] + lo * 1024; lp.b_ga = a.in[9] + lo * 1024; lp.lam = a.in[10] + lo * 1024;
            lp.wgx = (const bf16_t*)(wl + WL_GX); lp.wga = (const bf16_t*)(wl + WL_GA);
#pragma unroll 1
            for (int k3 = 0; k3 < 3; ++k3) {
                int stg = (k3 + bx % 3) % 3; asm volatile("" : "+s"(stg));
                if (stg == 0) dil_prep(z, pos, a.in[19] + lo * 64, a.in[20] + lo * 64);
                else if (stg == 1) { for (int u = bx; u < NB * 64; u += G) lru_unit<false>(lds, z, agg, lp, u >> 6, (u >> 3) & 7, u & 7); }
                else {
                    if (fullgrid) panel_wait(cntB + 64 * (bx >> 2), 7u * (unsigned)(l * NCHUNK + c + 1)); else gsync(gctr, gtarget);
                    mla_finalize(lds, z, qf, kvr, kf, pos, a.in[16] + lo * 96, a.in[17] + lo * 96); }
                __syncthreads();
            }
            PSTAMP(3);
            gsync(gctr, gtarget); PSTAMP(4);
            float cs_mla, cs_dil;
            { float mq = 0.f, mk = 0.f, dq_ = 0.f, dk_ = 0.f; const float* g1 = a.in[16] + lo * 96; const float* g2 = a.in[17] + lo * 96; const float* g3 = a.in[19] + lo * 64; const float* g4 = a.in[20] + lo * 64;
              for (int i = 0; i < 96; ++i) { mq = fmaxf(mq, fabsf(g1[i])); mk = fmaxf(mk, fabsf(g2[i])); }
              for (int i = 0; i < 64; ++i) { dq_ = fmaxf(dq_, fabsf(g3[i])); dk_ = fmaxf(dk_, fabsf(g4[i])); }
              cs_mla = 96.f * 0.10206207261596575f * LOG2E * mq * mk; cs_dil = 64.f * 0.125f * LOG2E * dq_ * dk_; }
            const int nrnd = (512 + NB * 384 + G - 1) / G, rot = (bx & 1) ? 2 : 0;
#pragma unroll 1
            for (int k8 = 0; k8 < nrnd; ++k8) {
                const int u = bx + G * ((k8 + rot) % nrnd); if (u >= 512 + NB * 384) continue;
                if (u < 512) {
                    int qb, bh; if (u < 256) { qb = 15 - (u >> 5); bh = u & 31; } else { qb = (u - 256) >> 5; bh = (u - 256) & 31; }
                    const int bl = bh >> 3, hd = bh & 7; const size_t t0 = (size_t)bl * SEQ;
                    attn_unit<96, false, true>(lds, qf + t0 * LDQ + hd * 96, LDQ, kf + t0 * 768 + hd * 96, 768, kvr + t0 * LDQ + hd * 128 + 64, LDQ, qb * 256,
                                               z + t0 * LDZ + C_MLAG + hd * 64, LDZ, nullptr, 0, cs_mla);
                } else {
                    const int v = u - 512, bl = v / 384, w = v % 384, gi = w >> 7, w2 = w & 127, hd = w2 >> 4, rem = w2 & 15;
                    const int d = 1 << (2 * gi), npairs = 16 >> (2 * gi), r = rem / npairs, pair = rem % npairs, head = gi * 8 + hd;
                    const size_t brow = (size_t)bl * SEQ + r; bf16_t* zb = z + brow * LDZ + head * 64; const size_t st = (size_t)d * LDZ;
                    attn_unit<64, true, false>(lds, zb + C_DQ, st, zb + C_DK, st, zb + C_DV, st, pair * 256, zb + C_DQ, st, lse + (size_t)gi * TC * 8 + brow * 8 + hd, (size_t)d * 8, cs_dil);
                }
            }
            gsync(gctr, gtarget); PSTAMP(5);
            dil_combine(z, lse);
            for (int u = bx; u < NB * 64; u += G) lru_unit<true>(lds, z, agg, lp, u >> 6, (u >> 3) & 7, u & 7);
            gsync(gctr, gtarget); PSTAMP(6);
            { pg8::Gemm g; g.A = z + C_LRUG; g.Bt = (const bf16_t*)(wl + WL_PCAT); g.M = TC; g.N = DM; g.K = 2048; g.lda = LDZ;
              pg8::StaticOrder S; S.init(TC, DM, G, bx); EpiChain E; E.Z = z; E.bm = a.in[22] + (size_t)lo * 3072; E.MB = mb;
              pg8::gemm_phase<EpiChain, pg8::StaticOrder, true, true>(ldsl, g, S, E);
              if (fullgrid) { pg8::Unit uu; S.next(0, uu); panel_signal(cntA + 64 * uu.pm, 4u * (unsigned)(l * NCHUNK + c + 1)); panel_wait(cntA + 64 * uu.pm, 4u * (unsigned)(l * NCHUNK + c + 1)); } }
            if (!fullgrid) gsync(gctr, gtarget);
            PSTAMP(7);
            { pg8::Gemm g; g.A = mb; g.Bt = (const bf16_t*)(wl + WL_OUT); g.M = TC; g.N = DM; g.K = DM; g.lda = DM;
              pg8::StaticOrder S; S.init(TC, DM, G, bx); EpiOut E; E.X = xin; E.O = xout;
              pg8::gemm_phase<EpiOut, pg8::StaticOrder, true, true>(ldsl, g, S, E); }
            __syncthreads();
            if (PROBE_K == 8) { grid.sync(); PSTAMP(8); }
        }
    }
    if (PROBE_K >= 0 && blockIdx.x == 0 && threadIdx.x == 0) { const unsigned long long t0 = __builtin_amdgcn_s_memrealtime(); while (__builtin_amdgcn_s_memrealtime() - t0 < tacc) __builtin_amdgcn_s_sleep(8); }
}

extern "C" void kernel_launch(void* const* d_in, const int* in_sizes, int n_in, void* d_out, int out_size, void* d_ws, size_t ws_size, hipStream_t stream) {
    static int grid_blocks = 0;
    if (!grid_blocks) {
        int dev = 0, cus = 0, per_cu = 0;
        (void)hipGetDevice(&dev);
        (void)hipDeviceGetAttribute(&cus, hipDeviceAttributeMultiprocessorCount, dev);
        if (hipFuncSetAttribute((const void*)hybrid_fwd, hipFuncAttributeMaxDynamicSharedMemorySize, LDS_BYTES) != hipSuccess) fprintf(stderr, "hipFuncSetAttribute failed\n");
        if (hipOccupancyMaxActiveBlocksPerMultiprocessor(&per_cu, (const void*)hybrid_fwd, 512, LDS_BYTES) != hipSuccess || per_cu < 1) per_cu = 1;
        grid_blocks = cus * 1;
        if (ws_size < WS_NEED) fprintf(stderr, "workspace too small: %zu < %zu\n", ws_size, (size_t)WS_NEED);
    }
    if (ws_size < WS_NEED || n_in < 24) return;
    Args a{};
    for (int i = 0; i < 24; ++i) a.in[i] = (const float*)d_in[i];
    a.out = (float*)d_out; a.ws = (unsigned char*)d_ws;
    void* args[] = {&a};
    hipError_t e = hipLaunchCooperativeKernel((const void*)hybrid_fwd, dim3(grid_blocks), dim3(512), args, LDS_BYTES, stream);
    if (e != hipSuccess) fprintf(stderr, "cooperative launch failed: %s (grid %d)\n", hipGetErrorString(e), grid_blocks);
}
```
